# Optimizing an MI355X kernel written in HIP

```python
import jax, jax.numpy as jnp
from jax import lax
import numpy as np

D_MODEL = 4096
BATCH = 2
SEQ = 4096
DEPTH = 1

N_META = 16
D_MIX = D_MODEL
HGRN_WIDTH = D_MIX // 2
LRU_WIDTH = D_MIX - HGRN_WIDTH
HGRN_HEAD_DIM = 128
HGRN_HEADS = HGRN_WIDTH // HGRN_HEAD_DIM
LRU_BLOCK = 256
LRU_HEADS = LRU_WIDTH // LRU_BLOCK
CONV_WIDTH = 4
RG_C = 8.0
CHUNK = 64
D_FF = ((8 * D_MODEL // 3 + 255) // 256) * 256
EPS = 1e-6
IN_COLS = 4 * HGRN_WIDTH + 2 * LRU_WIDTH

kernel_name = "hymba_hgrn2_rglru_macaron_block"


def rms_norm(x, gain, group=None):
    shp = x.shape
    xf = x.astype(jnp.float32)
    if group is not None:
        xf = xf.reshape(*shp[:-1], shp[-1] // group, group)
    y = xf * lax.rsqrt(jnp.mean(xf * xf, axis=-1, keepdims=True) + EPS)
    y = y.reshape(shp) * gain.astype(jnp.float32)
    return y.astype(x.dtype)


def swiglu(u, w_gate, w_up, w_down):
    return (jax.nn.silu(u @ w_gate) * (u @ w_up)) @ w_down


def _hgrn2_chunk(state, inp):
    q, k, v, log_f = inp
    c = q.shape[2]
    cum = jnp.cumsum(log_f, axis=2)
    o_inter = jnp.einsum('bhck,bhkv->bhcv', q * jnp.exp(cum), state)
    causal = jnp.tril(jnp.ones((c, c), dtype=bool))[None, None, :, :, None]
    diff = cum[:, :, :, None, :] - cum[:, :, None, :, :]
    decay = jnp.exp(jnp.where(causal, diff, -jnp.inf))
    scores = jnp.einsum('bhik,bhjk,bhijk->bhij', q, k, decay)
    o_intra = jnp.einsum('bhij,bhjv->bhiv', scores, v)
    last = cum[:, :, -1:, :]
    k_dec = k * jnp.exp(last - cum)
    new_state = jnp.exp(last[:, :, 0, :])[..., None] * state + jnp.einsum('bhck,bhcv->bhkv', k_dec, v)
    return new_state, o_inter + o_intra


def hgrn2_group(q, f_logit, i_in, g_out, lb, out_norm):
    b, t, _ = q.shape
    q = jax.nn.silu(q)
    log_f = jnp.log(lb + (1.0 - lb) * jax.nn.sigmoid(f_logit))
    k = (1.0 - lb) * jax.nn.sigmoid(-f_logit)

    def heads(a):
        return a.reshape(b, t, HGRN_HEADS, HGRN_HEAD_DIM).transpose(0, 2, 1, 3)

    q, k, v, log_f = heads(q), heads(k), heads(i_in), heads(log_f)
    state0 = jnp.zeros((b, HGRN_HEADS, HGRN_HEAD_DIM, HGRN_HEAD_DIM), dtype=v.dtype)
    state, o_meta = _hgrn2_chunk(state0, (q[:, :, :N_META], k[:, :, :N_META],
                                          v[:, :, :N_META], log_f[:, :, :N_META]))
    n_chunks = (t - N_META) // CHUNK

    def to_chunks(a):
        return a[:, :, N_META:].reshape(b, HGRN_HEADS, n_chunks, CHUNK, HGRN_HEAD_DIM).transpose(2, 0, 1, 3, 4)

    _, o_real = lax.scan(_hgrn2_chunk, state, (to_chunks(q), to_chunks(k), to_chunks(v), to_chunks(log_f)))
    o_real = o_real.transpose(1, 2, 0, 3, 4).reshape(b, HGRN_HEADS, n_chunks * CHUNK, HGRN_HEAD_DIM)
    o = jnp.concatenate([o_meta, o_real], axis=2).transpose(0, 2, 1, 3).reshape(b, t, HGRN_WIDTH)
    return rms_norm(o, out_norm, group=HGRN_HEAD_DIM) * jax.nn.silu(g_out)


def _linear_combine(left, right):
    a_l, b_l = left
    a_r, b_r = right
    return a_l * a_r, a_r * b_l + b_r


def rglru_group(x_br, g_br, conv_w, conv_b, w_a, b_a, w_x, b_x, lam, out_norm):
    b, t, _ = x_br.shape
    xc = lax.conv_general_dilated(
        x_br, conv_w[:, None, :].astype(x_br.dtype), window_strides=(1,),
        padding=[(CONV_WIDTH - 1, 0)], dimension_numbers=('NWC', 'WIO', 'NWC'),
        feature_group_count=LRU_WIDTH) + conv_b
    xh = xc.reshape(b, t, LRU_HEADS, LRU_BLOCK)
    r = jax.nn.sigmoid(jnp.einsum('bthi,hij->bthj', xh, w_a).reshape(b, t, LRU_WIDTH) + b_a)
    i = jax.nn.sigmoid(jnp.einsum('bthi,hij->bthj', xh, w_x).reshape(b, t, LRU_WIDTH) + b_x)
    log_a = -RG_C * r * jax.nn.softplus(-lam)
    a = jnp.exp(log_a)
    drive = jnp.sqrt(-jnp.expm1(2.0 * log_a)) * (i * xc)
    _, h = lax.associative_scan(_linear_combine, (a, drive), axis=1)
    return rms_norm(h, out_norm) * jax.nn.gelu(g_br)


def token_mixer(u, w_in, lb, hgrn_out_norm, conv_w, conv_b, w_a, b_a, w_x, b_x, lam, lru_out_norm, w_out):
    proj = u @ w_in
    splits = (HGRN_WIDTH, 2 * HGRN_WIDTH, 3 * HGRN_WIDTH, 4 * HGRN_WIDTH, 4 * HGRN_WIDTH + LRU_WIDTH)
    q, f_logit, i_in, g_out, x_br, g_br = jnp.split(proj, splits, axis=-1)
    y_hgrn = hgrn2_group(q, f_logit, i_in, g_out, lb.astype(u.dtype), hgrn_out_norm)
    y_lru = rglru_group(x_br, g_br, conv_w, conv_b, w_a, b_a, w_x, b_x, lam, lru_out_norm)
    return jnp.concatenate([y_hgrn, y_lru], axis=-1) @ w_out


def setup_inputs(seed: int = 0) -> dict:
    key = jax.random.key(seed)
    ks = jax.random.split(key, 26)
    f32 = jnp.float32

    def nrm(k, shape, scale):
        return jax.random.normal(k, shape, f32) * scale

    def gain(k, shape):
        return 1.0 + 0.02 * jax.random.normal(k, shape, f32)

    u = jax.random.uniform(ks[20], (DEPTH, LRU_WIDTH), f32, 0.9, 0.999)
    a_base = u ** (1.0 / RG_C)
    lam = jnp.log(a_base) - jnp.log1p(-a_base)
    return {
        "x": nrm(ks[0], (BATCH, SEQ, D_MODEL), 1.0),
        "meta_tokens": nrm(ks[1], (N_META, D_MODEL), 1.0),
        "ffn1_pre_norm": gain(ks[2], (DEPTH, D_MODEL)),
        "ffn1_w_gate": nrm(ks[3], (DEPTH, D_MODEL, D_FF), D_MODEL ** -0.5),
        "ffn1_w_up": nrm(ks[4], (DEPTH, D_MODEL, D_FF), D_MODEL ** -0.5),
        "ffn1_w_down": nrm(ks[5], (DEPTH, D_FF, D_MODEL), D_FF ** -0.5),
        "ffn1_post_norm": gain(ks[6], (DEPTH, D_MODEL)),
        "mix_pre_norm": gain(ks[7], (DEPTH, D_MODEL)),
        "w_in": nrm(ks[8], (DEPTH, D_MODEL, IN_COLS), D_MODEL ** -0.5),
        "hgrn_lb_logits": nrm(ks[9], (DEPTH + 1, HGRN_WIDTH), 0.5),
        "hgrn_out_norm": gain(ks[10], (DEPTH, HGRN_WIDTH)),
        "lru_conv_w": nrm(ks[11], (DEPTH, CONV_WIDTH, LRU_WIDTH), CONV_WIDTH ** -0.5),
        "lru_conv_b": nrm(ks[12], (DEPTH, LRU_WIDTH), 0.01),
        "lru_w_a": nrm(ks[13], (DEPTH, LRU_HEADS, LRU_BLOCK, LRU_BLOCK), LRU_BLOCK ** -0.5),
        "lru_b_a": nrm(ks[14], (DEPTH, LRU_WIDTH), 0.01),
        "lru_w_x": nrm(ks[15], (DEPTH, LRU_HEADS, LRU_BLOCK, LRU_BLOCK), LRU_BLOCK ** -0.5),
        "lru_b_x": nrm(ks[16], (DEPTH, LRU_WIDTH), 0.01),
        "lru_lambda": lam,
        "lru_out_norm": gain(ks[17], (DEPTH, LRU_WIDTH)),
        "w_out": nrm(ks[18], (DEPTH, D_MIX, D_MODEL), D_MIX ** -0.5),
        "mix_post_norm": gain(ks[19], (DEPTH, D_MODEL)),
        "ffn2_pre_norm": gain(ks[21], (DEPTH, D_MODEL)),
        "ffn2_w_gate": nrm(ks[22], (DEPTH, D_MODEL, D_FF), D_MODEL ** -0.5),
        "ffn2_w_up": nrm(ks[23], (DEPTH, D_MODEL, D_FF), D_MODEL ** -0.5),
        "ffn2_w_down": nrm(ks[24], (DEPTH, D_FF, D_MODEL), D_FF ** -0.5),
        "ffn2_post_norm": gain(ks[25], (DEPTH, D_MODEL)),
    }


def reference(x, meta_tokens, ffn1_pre_norm, ffn1_w_gate, ffn1_w_up, ffn1_w_down, ffn1_post_norm,
              mix_pre_norm, w_in, hgrn_lb_logits, hgrn_out_norm, lru_conv_w, lru_conv_b,
              lru_w_a, lru_b_a, lru_w_x, lru_b_x, lru_lambda, lru_out_norm, w_out, mix_post_norm,
              ffn2_pre_norm, ffn2_w_gate, ffn2_w_up, ffn2_w_down, ffn2_post_norm):
    b = x.shape[0]
    meta = jnp.broadcast_to(meta_tokens[None].astype(x.dtype), (b, N_META, D_MODEL))
    h = jnp.concatenate([meta, x], axis=1)
    lb_all = jnp.cumsum(jax.nn.softmax(hgrn_lb_logits.astype(jnp.float32), axis=0), axis=0)
    for l in range(DEPTH):
        f1 = swiglu(rms_norm(h, ffn1_pre_norm[l]), ffn1_w_gate[l], ffn1_w_up[l], ffn1_w_down[l])
        h = h + 0.5 * rms_norm(f1, ffn1_post_norm[l])
        m = token_mixer(rms_norm(h, mix_pre_norm[l]), w_in[l], lb_all[l], hgrn_out_norm[l],
                        lru_conv_w[l], lru_conv_b[l], lru_w_a[l], lru_b_a[l], lru_w_x[l], lru_b_x[l],
                        lru_lambda[l], lru_out_norm[l], w_out[l])
        h = h + rms_norm(m, mix_post_norm[l])
        f2 = swiglu(rms_norm(h, ffn2_pre_norm[l]), ffn2_w_gate[l], ffn2_w_up[l], ffn2_w_down[l])
        h = h + 0.5 * rms_norm(f2, ffn2_post_norm[l])
    return h[:, N_META:]
```

```cpp
#include <hip/hip_runtime.h>
#include <cstdio>
#include <cstdint>

namespace pg8 {
#define PG8_LAS __attribute__((address_space(3)))
typedef unsigned short bf16_t;
typedef short bf16x8 __attribute__((ext_vector_type(8)));
typedef float f32x4 __attribute__((ext_vector_type(4)));
typedef float f32x2 __attribute__((ext_vector_type(2)));
typedef unsigned u32x4 __attribute__((ext_vector_type(4)));
typedef unsigned u32x2 __attribute__((ext_vector_type(2)));
constexpr int BM = 256, BK = 64, HALF = 128, HTB = HALF * BK * 2, STAGE_BYTES = 8 * HTB, NXCD = 8, WGM = 8;

__host__ __device__ __forceinline__ int lds_byte(int r, int c) { const int st = (r >> 4) * 2 + (c >> 5), rr = r & 15, cc = c & 31, ob = rr * 64 + cc * 2; return st * 1024 + (ob ^ (((ob >> 9) & 1) << 5)); }
__host__ __device__ __forceinline__ void stage_rc(int b, int& R, int& C) { const int st = b / 1024, sb = b % 1024, swz = sb ^ (((sb >> 9) & 1) << 5); R = (st >> 1) * 16 + swz / 64; C = (st & 1) * 32 + (swz % 64) / 2; }
__host__ __device__ __forceinline__ int perm32(int rho) { const int n = rho >> 4, i = rho & 15; return 8 * (i >> 2) + 4 * n + (i & 3); }

struct Unit { int pm, pn; };
struct Gemm { const bf16_t* A; const bf16_t* Bt; int M, N, K, lda, ldb, agrp, ablk; };

struct StaticOrder {
    int nM, nN, nwg, G, c;
    __host__ __device__ void init(int M, int N, int G_, int c_) { nM = M / BM; nN = N / BM; nwg = nM * nN; G = G_; c = c_; }
    __host__ __device__ bool next(int i, Unit& u) const {
        const long L = (long)i * G + c; if (L >= nwg) return false;
        int wgid = (int)L; { const int q = nwg / NXCD, r = nwg % NXCD, xcd = wgid % NXCD, off = wgid / NXCD; wgid = (xcd < r ? xcd * (q + 1) : r * (q + 1) + (xcd - r) * q) + off; }
        const int nig = WGM * nN, gid = wgid / nig, fm = gid * WGM, gsz = (nM - fm) < WGM ? (nM - fm) : WGM;
        u.pm = fm + ((wgid % nig) % gsz); u.pn = (wgid % nig) / gsz; return true;
    }
    __device__ __forceinline__ void a_ready(const Unit&) const {}
    __device__ __forceinline__ void done(const Unit&) const {}
};

__device__ __forceinline__ unsigned cvt_pk_bf16(float lo, float hi) { unsigned r; asm volatile("v_cvt_pk_bf16_f32 %0, %1, %2" : "=v"(r) : "v"(lo), "v"(hi)); return r; }
__device__ __forceinline__ float fast_sigmoid(float x) { return __builtin_amdgcn_rcpf(1.0f + __builtin_amdgcn_exp2f(-1.44269504089f * x)); }
__device__ __forceinline__ float fast_silu(float x) { return x * fast_sigmoid(x); }

struct EpiF32 {
    static constexpr bool PERM = false, AFTER_DRAIN = false;
    float* C; int ldc;
    __device__ __forceinline__ void operator()(const f32x4 (&acc)[2][2][4][2], const Unit& u, int wr, int wc, int fr, int fq) const {
        const int row0 = u.pm * BM + wr * 64 + fr, col0 = u.pn * BM + wc * 32 + 4 * fq;
#pragma unroll
        for (int ai = 0; ai < 2; ++ai)
#pragma unroll
            for (int m = 0; m < 4; ++m) { float* rowp = C + (size_t)(row0 + ai * HALF + m * 16) * ldc + col0;
#pragma unroll
                for (int bj = 0; bj < 2; ++bj)
#pragma unroll
                    for (int n = 0; n < 2; ++n) *(f32x4*)(rowp + bj * HALF + n * 16) = acc[ai][bj][m][n]; }
    }
};
struct EpiBf16 {
    static constexpr bool PERM = true, AFTER_DRAIN = false;
    bf16_t* O; int ldc;
    __device__ __forceinline__ void operator()(const f32x4 (&acc)[2][2][4][2], const Unit& u, int wr, int wc, int fr, int fq) const {
        const int row0 = u.pm * BM + wr * 64 + fr, col0 = u.pn * BM + wc * 32 + 8 * fq;
#pragma unroll
        for (int ai = 0; ai < 2; ++ai)
#pragma unroll
            for (int m = 0; m < 4; ++m) { bf16_t* rowp = O + (size_t)(row0 + ai * HALF + m * 16) * ldc + col0;
#pragma unroll
                for (int bj = 0; bj < 2; ++bj) { const f32x4 v0 = acc[ai][bj][m][0], v1 = acc[ai][bj][m][1];
                    u32x4 w; w.x = cvt_pk_bf16(v0[0], v0[1]); w.y = cvt_pk_bf16(v0[2], v0[3]); w.z = cvt_pk_bf16(v1[0], v1[1]); w.w = cvt_pk_bf16(v1[2], v1[3]);
                    *(u32x4*)(rowp + bj * HALF) = w; } }
    }
};
struct EpiSwiGLU {
    static constexpr bool PERM = true, AFTER_DRAIN = false;
    bf16_t* O; int ldc;
    __device__ __forceinline__ void operator()(const f32x4 (&acc)[2][2][4][2], const Unit& u, int wr, int wc, int fr, int fq) const {
#pragma unroll
        for (int ai = 0; ai < 2; ++ai)
#pragma unroll
            for (int m = 0; m < 4; ++m) { bf16_t* rowp = O + ((((size_t)(u.pm * 16 + ai * 8 + wr * 4 + m)) * (ldc >> 5) + u.pn * 4 + wc) << 9) + fr * 32 + 8 * fq;
                const f32x4 g0 = acc[ai][0][m][0], g1 = acc[ai][0][m][1], u0 = acc[ai][1][m][0], u1 = acc[ai][1][m][1];
                f32x4 v0, v1;
#pragma unroll
                for (int e = 0; e < 4; ++e) { v0[e] = fast_silu(g0[e]) * u0[e]; v1[e] = fast_silu(g1[e]) * u1[e]; }
                u32x4 w; w.x = cvt_pk_bf16(v0[0], v0[1]); w.y = cvt_pk_bf16(v0[2], v0[3]); w.z = cvt_pk_bf16(v1[0], v1[1]); w.w = cvt_pk_bf16(v1[2], v1[3]);
                *(u32x4*)rowp = w; }
    }
};
__device__ __forceinline__ float softplus_neg(float lam) { const float y = __expf(-lam); return y < 0.05f ? y * (1.0f - y * (0.5f - y * (0.33333334f - y * 0.25f))) : __logf(1.0f + y); }
__device__ __forceinline__ float neg_expm1(float x) { const float s = -x * (1.0f + x * (0.5f + x * (0.16666667f + x * (0.041666668f + x * 0.0083333338f)))); return x > -0.1f ? s : 1.0f - __expf(x); }
__device__ __forceinline__ void lru_gate_math(float rp, float ip, float ba, float bx, float sp, float xcv, float& a, float& d) {
    const float r = fast_sigmoid(rp + ba), ig = fast_sigmoid(ip + bx);
    const float la = -8.0f * r * sp; a = __expf(la); const float x2 = 2.0f * la;
    const float ser = -x2 * (1.0f + x2 * (0.5f + x2 * (0.16666667f + x2 * (0.041666668f + x2 * 0.0083333338f))));
    d = __builtin_amdgcn_sqrtf(x2 > -0.1f ? ser : 1.0f - a * a) * (ig * xcv);
}
struct EpiLru {
    static constexpr bool PERM = false, AFTER_DRAIN = false;
    float* Aout; float* Dout; const bf16_t* XC; const float* b_a; const float* b_x; const float* lam;
    __device__ __forceinline__ void operator()(const f32x4 (&acc)[2][2][4][2], const Unit& u, int wr, int wc, int fr, int fq) const {
        const int chu = (u.pn >> 1) * 256 + (u.pn & 1) * 128 + wc * 32;
        const size_t rowu = (size_t)(u.pm * BM + wr * 64);
        const unsigned lo = (unsigned)(fr * 2048 + 4 * fq);
#pragma unroll
        for (int n = 0; n < 2; ++n) { const int ch = chu + n * 16 + 4 * fq;
            const f32x4 ba = *(const f32x4*)(b_a + ch), bx = *(const f32x4*)(b_x + ch), l = *(const f32x4*)(lam + ch); f32x4 sp;
#pragma unroll
            for (int e = 0; e < 4; ++e) sp[e] = softplus_neg(l[e]);
#pragma unroll
            for (int ai = 0; ai < 2; ++ai)
#pragma unroll
                for (int m = 0; m < 4; ++m) { const size_t ub = (rowu + ai * HALF + m * 16) * 2048 + chu + n * 16;
                    const u32x2 xw = *(const u32x2*)((const char*)(XC + ub) + lo * 2u);
                    const float xv[4] = {__uint_as_float(xw.x << 16), __uint_as_float(xw.x & 0xffff0000u), __uint_as_float(xw.y << 16), __uint_as_float(xw.y & 0xffff0000u)};
                    f32x4 av, dv;
#pragma unroll
                    for (int e = 0; e < 4; ++e) { float a, d; lru_gate_math(acc[ai][0][m][n][e], acc[ai][1][m][n][e], ba[e], bx[e], sp[e], xv[e], a, d); av[e] = a; dv[e] = d; }
                    *(f32x4*)((char*)(Aout + ub) + lo * 4u) = av; *(f32x4*)((char*)(Dout + ub) + lo * 4u) = dv;
                    asm volatile("" ::: "memory"); } }
    }
};

template <class Epi, class Sched, bool ALIGN_EPI = false, bool SP2 = false>
__device__ __forceinline__ void gemm_phase(PG8_LAS unsigned char* lds, const Gemm g, const Sched& S, const Epi& E, int wave_id) {
    int lane_; asm volatile("v_mbcnt_lo_u32_b32 %0, -1, 0\n\tv_mbcnt_hi_u32_b32 %0, -1, %0" : "=v"(lane_));
    const int wid = wave_id, lane = lane_, tid = wid * 64 + lane, wr = wid >> 2, wc = wid & 3, fr = lane & 15, fq = lane >> 4;
    const int K = g.K, nt = K / BK;
    unsigned voffA[2], voffB[2];
#pragma unroll
    for (int i = 0; i < 2; ++i) { int R, C; stage_rc(wid * 2048 + i * 1024 + lane * 16, R, C);
        voffB[i] = (unsigned)((((R >> 4) * (g.K >> 5) + (C >> 5)) << 10) + (R & 15) * 64 + (C & 31) * 2); voffA[i] = g.ablk ? voffB[i] : (unsigned)(R * g.lda + C) * 2u; }
    static_assert(Epi::PERM, "the blocked weight layout stores the rows in the PERM order");
    const size_t kstep = g.ablk ? (size_t)2048 : (size_t)(BK * 2), kstepB = 2048;
    const size_t hsA = (size_t)HALF * g.lda * 2, hsB = (size_t)HALF * g.K * 2;
    const size_t tsA = 2 * hsA, tsB = 2 * hsB;
    const size_t agb = g.agrp ? (size_t)K * 2 : 0;
    const unsigned ldsw = (unsigned)wid * 2048u;
    const int aoff = lds_byte(wr * 64 + fr, fq * 8), boff = lds_byte(wc * 32 + fr, fq * 8);
#define PG8_SA(b, h) (((b) * 2 + (h)) * HTB)
#define PG8_SB(b, h) ((4 + (b) * 2 + (h)) * HTB)
#define PG8_STAGE(bufoff, gbase, voff) do { _Pragma("unroll") for (int _i = 0; _i < 2; ++_i) \
        __builtin_amdgcn_global_load_lds((const unsigned*)((const char*)(gbase) + (voff)[_i]), (PG8_LAS unsigned*)(lds + (bufoff) + ldsw + _i * 1024), 16, 0, 0); } while (0)
#define PG8_LDA(dst, b, h) do { _Pragma("unroll") for (int m = 0; m < 4; ++m) _Pragma("unroll") for (int k = 0; k < 2; ++k) dst[m][k] = *(const PG8_LAS bf16x8*)(lds + PG8_SA(b, h) + aoff + m * 2048 + k * 1024); } while (0)
#define PG8_LDB(dst, b, h) do { _Pragma("unroll") for (int n = 0; n < 2; ++n) _Pragma("unroll") for (int k = 0; k < 2; ++k) dst[n][k] = *(const PG8_LAS bf16x8*)(lds + PG8_SB(b, h) + boff + n * 2048 + k * 1024); } while (0)
#define PG8_MMA(ai, bj, At, Bt) do { __builtin_amdgcn_s_setprio(1); _Pragma("unroll") for (int m = 0; m < 4; ++m) _Pragma("unroll") for (int n = 0; n < 2; ++n) _Pragma("unroll") for (int k = 0; k < 2; ++k) \
        acc[ai][bj][m][n] = __builtin_amdgcn_mfma_f32_16x16x32_bf16(Bt[n][k], At[m][k], acc[ai][bj][m][n], 0, 0, 0); __builtin_amdgcn_s_setprio(0); } while (0)
#define PG8_WAIT_V(n) asm volatile("s_waitcnt vmcnt(" #n ")" ::: "memory")
#define PG8_WAIT_L(n) asm volatile("s_waitcnt lgkmcnt(" #n ")" ::: "memory")
#define PG8_BAR __builtin_amdgcn_s_barrier()
#define PG8_SCHED __builtin_amdgcn_sched_barrier(0)
    Unit cur, nxt; int ui = 0;
    if (!S.next(0, cur)) return;
    f32x4 acc[2][2][4][2];
#pragma unroll
    for (int a = 0; a < 2; ++a)
#pragma unroll
        for (int b = 0; b < 2; ++b)
#pragma unroll
            for (int m = 0; m < 4; ++m)
#pragma unroll
                for (int n = 0; n < 2; ++n) acc[a][b][m][n] = (f32x4){0.f, 0.f, 0.f, 0.f};
    bf16x8 At[4][2], B0[2][2], B1[2][2];
    const char* cA = (const char*)g.A + (size_t)cur.pm * tsA + (size_t)(cur.pn >> 1) * agb; const char* cB = (const char*)g.Bt + (size_t)cur.pn * tsB;
    S.a_ready(cur);
    if constexpr (SP2) {
        PG8_STAGE(PG8_SB(0, 0), cB, voffB); PG8_STAGE(PG8_SB(0, 1), cB + hsB, voffB); PG8_STAGE(PG8_SA(0, 0), cA, voffA); PG8_STAGE(PG8_SA(0, 1), cA + hsA, voffA);
        if (wr == 1) PG8_BAR;
        PG8_WAIT_V(2); PG8_BAR;
        PG8_STAGE(PG8_SB(1, 0), cB + kstepB, voffB); PG8_STAGE(PG8_SA(1, 0), cA + kstep, voffA); PG8_STAGE(PG8_SB(1, 1), cB + hsB + kstepB, voffB);
        PG8_WAIT_V(6); PG8_BAR;
    } else {
        PG8_STAGE(PG8_SB(0, 0), cB, voffB); PG8_STAGE(PG8_SA(0, 0), cA, voffA); PG8_STAGE(PG8_SB(0, 1), cB + hsB, voffB); PG8_STAGE(PG8_SA(0, 1), cA + hsA, voffA);
        if (wr == 1) PG8_BAR;
        PG8_WAIT_V(4); PG8_BAR;
        PG8_STAGE(PG8_SB(1, 0), cB + kstepB, voffB); PG8_STAGE(PG8_SA(1, 0), cA + kstep, voffA); PG8_STAGE(PG8_SB(1, 1), cB + hsB + kstepB, voffB);
        PG8_WAIT_V(6); PG8_BAR;
    }
    for (;;) {
        const bool has_next = S.next(ui + 1, nxt);
        const char* nA = has_next ? (const char*)g.A + (size_t)nxt.pm * tsA + (size_t)(nxt.pn >> 1) * agb : cA; const char* nB = has_next ? (const char*)g.Bt + (size_t)nxt.pn * tsB : cB;
        for (int t = 0; t < nt; t += 2) {
            const bool last = (t == nt - 2);
            const char* a1 = cA + (size_t)(t + 1) * kstep;
            const char* a2 = last ? nA : cA + (size_t)(t + 2) * kstep; const char* b2 = last ? nB : cB + (size_t)(t + 2) * kstepB;
            const char* a3 = a2 + kstep; const char* b3 = b2 + kstepB;
            if (last && has_next) S.a_ready(nxt);
            if constexpr (SP2) {
            PG8_LDB(B0, 0, 0); PG8_LDB(B1, 0, 1); PG8_SCHED; PG8_LDA(At, 0, 0); PG8_STAGE(PG8_SA(1, 1), a1 + hsA, voffA);
            PG8_WAIT_V(8); PG8_WAIT_L(0); PG8_BAR; PG8_MMA(0, 0, At, B0); PG8_MMA(0, 1, At, B1); PG8_BAR; PG8_SCHED;
            PG8_LDA(At, 0, 1); PG8_STAGE(PG8_SB(0, 0), b2, voffB); PG8_STAGE(PG8_SB(0, 1), b2 + hsB, voffB); PG8_STAGE(PG8_SA(0, 0), a2, voffA);
            PG8_WAIT_V(8); PG8_WAIT_L(0); PG8_BAR; PG8_MMA(1, 0, At, B0); PG8_MMA(1, 1, At, B1); PG8_BAR; PG8_SCHED;
            PG8_LDB(B0, 1, 0); PG8_LDB(B1, 1, 1); PG8_SCHED; PG8_LDA(At, 1, 0); PG8_STAGE(PG8_SA(0, 1), a2 + hsA, voffA);
            PG8_WAIT_V(8); PG8_WAIT_L(0); PG8_BAR; PG8_MMA(0, 0, At, B0); PG8_MMA(0, 1, At, B1); PG8_BAR; PG8_SCHED;
            PG8_LDA(At, 1, 1); PG8_STAGE(PG8_SB(1, 0), b3, voffB); PG8_STAGE(PG8_SB(1, 1), b3 + hsB, voffB); PG8_STAGE(PG8_SA(1, 0), a3, voffA);
            PG8_WAIT_V(8); PG8_WAIT_L(0); PG8_BAR; PG8_MMA(1, 0, At, B0); PG8_MMA(1, 1, At, B1); PG8_BAR; PG8_SCHED;
            } else {
            PG8_LDB(B0, 0, 0); PG8_SCHED; PG8_LDA(At, 0, 0); PG8_STAGE(PG8_SA(1, 1), a1 + hsA, voffA);
            PG8_WAIT_L(8); PG8_BAR; PG8_WAIT_L(0); PG8_MMA(0, 0, At, B0); PG8_BAR; PG8_SCHED;
            PG8_LDB(B1, 0, 1); PG8_STAGE(PG8_SB(0, 0), b2, voffB);
            PG8_BAR; PG8_WAIT_L(0); PG8_MMA(0, 1, At, B1); PG8_BAR;
            PG8_LDA(At, 0, 1); PG8_STAGE(PG8_SA(0, 0), a2, voffA);
            PG8_BAR; PG8_WAIT_L(0); PG8_MMA(1, 0, At, B0); PG8_BAR; PG8_SCHED;
            PG8_STAGE(PG8_SB(0, 1), b2 + hsB, voffB);
            PG8_WAIT_V(6); PG8_BAR; PG8_MMA(1, 1, At, B1); PG8_BAR;
            PG8_LDB(B0, 1, 0); PG8_SCHED; PG8_LDA(At, 1, 0); PG8_STAGE(PG8_SA(0, 1), a2 + hsA, voffA);
            PG8_WAIT_L(8); PG8_BAR; PG8_WAIT_L(0); PG8_MMA(0, 0, At, B0); PG8_BAR; PG8_SCHED;
            PG8_LDB(B1, 1, 1); PG8_STAGE(PG8_SB(1, 0), b3, voffB);
            PG8_BAR; PG8_WAIT_L(0); PG8_MMA(0, 1, At, B1); PG8_BAR;
            PG8_LDA(At, 1, 1); PG8_STAGE(PG8_SA(1, 0), a3, voffA);
            PG8_BAR; PG8_WAIT_L(0); PG8_MMA(1, 0, At, B0); PG8_BAR; PG8_SCHED;
            PG8_STAGE(PG8_SB(1, 1), b3 + hsB, voffB);
            PG8_WAIT_V(6); PG8_BAR; PG8_MMA(1, 1, At, B1); PG8_BAR;
            }
        }
        if constexpr (ALIGN_EPI) { if (wr == 0) PG8_BAR; }
        if constexpr (!Epi::AFTER_DRAIN) { E(acc, cur, wr, wc, fr, fq); S.done(cur); }
        if (!has_next) break;
#pragma unroll
        for (int a = 0; a < 2; ++a)
#pragma unroll
            for (int b = 0; b < 2; ++b)
#pragma unroll
                for (int m = 0; m < 4; ++m)
#pragma unroll
                    for (int n = 0; n < 2; ++n) acc[a][b][m][n] = (f32x4){0.f, 0.f, 0.f, 0.f};
        cur = nxt; cA = nA; cB = nB; ++ui;
        if constexpr (ALIGN_EPI) { if (wr == 1) PG8_BAR; }
    }
    PG8_WAIT_V(0);
    if constexpr (!ALIGN_EPI) { if (wr == 0) PG8_BAR; }
    PG8_BAR;
#undef PG8_SA
#undef PG8_SB
#undef PG8_STAGE
#undef PG8_LDA
#undef PG8_LDB
#undef PG8_MMA
#undef PG8_WAIT_V
#undef PG8_WAIT_L
#undef PG8_BAR
#undef PG8_SCHED
}
}

constexpr int NWAVES = 8;
constexpr int D = 4096, SEQ = 4096, NB = 2, NMETA = 16, FF = 11008, INC = 12288, HW = 2048, LW = 2048;
constexpr int MR = NB * SEQ;
constexpr int MT = MR + NMETA;
constexpr float EPS = 1e-6f;

constexpr size_t MiB = 1u << 20;
constexpr size_t WS_CTL = 0, CTL_ZERO_BYTES = 32768;
constexpr size_t WS_WGU1 = 1 * MiB;
constexpr size_t WS_WD1  = WS_WGU1 + 172 * MiB;
constexpr size_t WS_WIN  = WS_WD1 + 86 * MiB;
constexpr size_t WS_WOUT = WS_WIN + 96 * MiB;
constexpr size_t WS_WGU2 = WS_WOUT + 32 * MiB;
constexpr size_t WS_WD2  = WS_WGU2 + 172 * MiB;
constexpr size_t WS_WLRU = WS_WD2 + 86 * MiB;
constexpr size_t WS_U    = WS_WLRU + 2 * MiB;
constexpr size_t WS_BIG  = WS_U + 65 * MiB;
constexpr size_t WS_F    = WS_BIG + 193 * MiB;
constexpr size_t WS_HG   = WS_F + 130 * MiB;
constexpr size_t WS_HG2  = WS_HG + 32 * MiB;
constexpr size_t WS_HD   = WS_HG2 + 32 * MiB;
constexpr size_t WS_LC   = WS_HD + 1 * MiB;
constexpr size_t WS_HLOC = WS_LC + 1 * MiB;
constexpr size_t WS_ACUM = WS_HLOC + 32 * MiB;
constexpr size_t WS_Y    = WS_ACUM + 32 * MiB;
constexpr size_t WS_HB   = WS_Y + 64 * MiB;
constexpr size_t WS_END  = WS_HB + 64 * MiB;
static_assert((size_t)MT * INC * 2 <= 193 * MiB && (size_t)MT * D * 4 <= 130 * MiB && (size_t)MT * D * 2 <= 65 * MiB, "ws map");
constexpr int CW_BAR = 4096;

constexpr int RING_OFF = 0, RING_BYTES = 131072;
constexpr int LDS_BYTES = 163840;
constexpr int LDSCTL_OFF = LDS_BYTES - 1024, MISC_OFF = LDSCTL_OFF + 320;

#define GAS __attribute__((address_space(1)))
#define LAS __attribute__((address_space(3)))
typedef unsigned short bf16;
typedef unsigned v4u __attribute__((ext_vector_type(4)));
typedef unsigned v2u __attribute__((ext_vector_type(2)));
typedef float f32x4 __attribute__((ext_vector_type(4)));
typedef short bf16x8 __attribute__((ext_vector_type(8)));
typedef GAS unsigned gu32;
#define RLX_AGENT __ATOMIC_RELAXED, __HIP_MEMORY_SCOPE_AGENT
#define LDS_WAIT() asm volatile("s_waitcnt lgkmcnt(0)" ::: "memory")
#define VM_WAIT() asm volatile("s_waitcnt vmcnt(0)" ::: "memory")
__device__ __forceinline__ unsigned f2bf(float f) { unsigned u = __builtin_bit_cast(unsigned, f); return (u + 0x7fffu + ((u >> 16) & 1u)) >> 16; }
typedef float f32x2_t __attribute__((ext_vector_type(2)));
typedef __bf16 bf16x2_t __attribute__((ext_vector_type(2)));
__device__ __forceinline__ unsigned pk2(float lo, float hi) { const f32x2_t v = {lo, hi}; const bf16x2_t b = __builtin_convertvector(v, bf16x2_t); return __builtin_bit_cast(unsigned, b); }
__device__ __forceinline__ bf16 f2bf16(float x) { return (bf16)(pk2(x, x) & 0xffffu); }
__device__ __forceinline__ float bflo(unsigned w) { return __uint_as_float(w << 16); }
__device__ __forceinline__ float bfhi(unsigned w) { return __uint_as_float(w & 0xffff0000u); }
__device__ __forceinline__ float bf2f(bf16 v) { return __uint_as_float(((unsigned)v) << 16); }

#define XB_TMO      128
#define XB_XCNT(j)  (256  + 64 * (j))
#define XB_XSUB(j)  (1280 + 64 * (j))
#define XB_XGEN(j)  (2304 + 64 * (j))
#define XB_TOP      3328
#define XB_TOPGEN   3392
#define XCD_BAR_WORDS 3456
#define XB_SPIN_CAP (1u << 18)

__device__ __forceinline__ unsigned xb_ld(unsigned* p)              { return __hip_atomic_load(p, __ATOMIC_RELAXED, __HIP_MEMORY_SCOPE_AGENT); }
__device__ __forceinline__ unsigned xb_add(unsigned* p, unsigned v) { return __hip_atomic_fetch_add(p, v, __ATOMIC_RELAXED, __HIP_MEMORY_SCOPE_AGENT); }
__device__ __forceinline__ unsigned xb_xcc_id() { return (unsigned)__builtin_amdgcn_s_getreg((3 << 11) | 20) & 0xFu; }
#define XB_SPIN(cond, bar) do { unsigned _sp = 0; while (cond) { __builtin_amdgcn_s_sleep(1); \
    if ((++_sp & 255u) == 0u) { if (xb_ld(&(bar)[XB_TMO])) break; if (_sp > XB_SPIN_CAP) { atomicAdd(&(bar)[XB_TMO], 1u); break; } } } } while (0)

struct XcdBarrier {
    unsigned* bar; unsigned x;
    volatile LAS unsigned* st;
};
__device__ __forceinline__ XcdBarrier xcd_barrier_post(unsigned* bar, volatile LAS unsigned* st) {
    XcdBarrier b; b.bar = bar; b.x = xb_xcc_id(); b.st = st;
    if (threadIdx.x == 0) (void)xb_add(&bar[XB_XCNT(b.x)], 1u);
    return b;
}
__device__ __forceinline__ void xcd_barrier_complete(unsigned* bar, unsigned x, unsigned& nloc, unsigned& nx) {
    const unsigned G = gridDim.x * gridDim.y * gridDim.z;
    unsigned sum, cnt, mine, sp = 0u;
    for (;;) {
        sum = 0u; cnt = 0u; mine = 0u;
#pragma unroll
        for (unsigned j = 0; j < 16; ++j) { const unsigned c = xb_ld(&bar[XB_XCNT(j)]); sum += c; cnt += (c > 0u) ? 1u : 0u; mine = (j == x) ? c : mine; }
        if (sum == G) break;
        __builtin_amdgcn_s_sleep(1);
        if ((++sp & 255u) == 0u) { if (xb_ld(&bar[XB_TMO])) break; if (sp > XB_SPIN_CAP) { atomicAdd(&bar[XB_TMO], 1u); break; } }
    }
    nloc = mine > 0u ? mine : 1u; nx = cnt > 0u ? cnt : 1u;
}
__device__ __forceinline__ void xcd_barrier(const XcdBarrier& b) {
    asm volatile("s_waitcnt vmcnt(0)" ::: "memory");
    __syncthreads();
    if (threadIdx.x == 0) {
        unsigned* bar = b.bar;
        __builtin_amdgcn_s_waitcnt(0);
        unsigned nloc = b.st[0], nx = b.st[1];
        if (nloc == 0u) { xcd_barrier_complete(bar, b.x, nloc, nx); b.st[0] = nloc; b.st[1] = nx; }
        const unsigned old = xb_add(&bar[XB_XSUB(b.x)], 1u);
        const unsigned gen = old / nloc;
        if (old + 1u == (gen + 1u) * nloc) {
            __builtin_amdgcn_fence(__ATOMIC_RELEASE, "agent");
            asm volatile("s_waitcnt vmcnt(0)" ::: "memory");
            const unsigned og = xb_add(&bar[XB_TOP], 1u);
            const unsigned tg = og / nx;
            if (og + 1u == (tg + 1u) * nx) xb_add(&bar[XB_TOPGEN], 1u);
            else XB_SPIN(xb_ld(&bar[XB_TOPGEN]) == tg, bar);
            __builtin_amdgcn_fence(__ATOMIC_ACQUIRE, "agent");
            xb_add(&bar[XB_XGEN(b.x)], 1u);
            asm volatile("s_waitcnt vmcnt(0)" ::: "memory");
        } else {
            XB_SPIN(xb_ld(&bar[XB_XGEN(b.x)]) == gen, bar);
            __builtin_amdgcn_fence(__ATOMIC_ACQUIRE, "agent");
            asm volatile("s_waitcnt vmcnt(0)" ::: "memory");
        }
    }
    __syncthreads();
}


struct Frame {
    LAS unsigned char* lds;
    volatile LAS unsigned* MISC;
    gu32* ctl;
    int tid, lane, wave;
    int vcu, G;
};

__device__ __forceinline__ int opaque_lane() { int l; asm volatile("v_mbcnt_lo_u32_b32 %0, -1, 0\n\tv_mbcnt_hi_u32_b32 %0, -1, %0" : "=v"(l)); return l; }
#define opaque_tid() ((F.wave << 6) + opaque_lane())
__device__ __forceinline__ float wave_sum(float v) {
#pragma unroll
    for (int o = 1; o < 64; o <<= 1) v += __shfl_xor(v, o);
    return v;
}
__device__ __forceinline__ float sigmoidf_(float x) { return __builtin_amdgcn_rcpf(1.0f + __builtin_amdgcn_exp2f(-1.44269504089f * x)); }
__device__ __forceinline__ float siluf_(float x) { return x * sigmoidf_(x); }
__device__ __forceinline__ float gelu_tanh(float x) { const float z = 0.7978845608028654f * (x + 0.044715f * x * x * x); const float t = __builtin_amdgcn_exp2f(2.88539008178f * z); return x * (1.0f - __builtin_amdgcn_rcpf(t + 1.0f)); }

constexpr int TP = 65;
__device__ __forceinline__ void p0_item_load(f32x4 (&v)[16], const float* W, int N, int k0, int n0, int lane) {
    const int rq = lane >> 4, cq = 4 * (lane & 15);
#pragma unroll
    for (int i = 0; i < 16; ++i) v[i] = __builtin_nontemporal_load((const GAS f32x4*)(W + (size_t)(k0 + 4 * i + rq) * N + n0 + cq));
}
__device__ __forceinline__ void p0_item_store(const f32x4 (&v)[16], bf16* WT, int ldo, int out_row0, int k0, LAS float* scr, int lane) {
    const int rq = lane >> 4, cq = 4 * (lane & 15);
#pragma unroll
    for (int i = 0; i < 16; ++i) { LAS float* d = scr + (4 * i + rq) * TP + cq; d[0] = v[i].x; d[1] = v[i].y; d[2] = v[i].z; d[3] = v[i].w; }
    LDS_WAIT(); asm volatile("" ::: "memory");
    const int c = lane & 7;
#pragma unroll
    for (int j = 0; j < 8; ++j) { const int n = (lane >> 3) + 8 * j; const LAS float* sp = scr + (8 * c) * TP + n;
        v4u o; o.x = pk2(sp[0 * TP], sp[1 * TP]); o.y = pk2(sp[2 * TP], sp[3 * TP]); o.z = pk2(sp[4 * TP], sp[5 * TP]); o.w = pk2(sp[6 * TP], sp[7 * TP]);
        __builtin_nontemporal_store(o, (GAS v4u*)(WT + (size_t)(out_row0 + n) * ldo + k0 + 8 * c)); }
    LDS_WAIT(); asm volatile("" ::: "memory");
}
__device__ __forceinline__ void p0_item_store_blk(const f32x4 (&v)[16], bf16* WT, int K, int out_row0, int k0, LAS float* scr, int lane) {
    const int rq = lane >> 4, cq = 4 * (lane & 15);
#pragma unroll
    for (int i = 0; i < 16; ++i) { LAS float* d = scr + (4 * i + rq) * TP + cq; d[0] = v[i].x; d[1] = v[i].y; d[2] = v[i].z; d[3] = v[i].w; }
    LDS_WAIT(); asm volatile("" ::: "memory");
    const int bi = lane >> 2, ch = lane & 3;
#pragma unroll
    for (int s8 = 0; s8 < 8; ++s8) { const int rbl = s8 >> 1, kbl = s8 & 1; const int n = 32 * (rbl >> 1) + 8 * (bi >> 2) + 4 * (rbl & 1) + (bi & 3);
        const LAS float* sa = scr + (32 * kbl + 8 * ch + 4 * (ch & 1)) * TP + n; const LAS float* sb = scr + (32 * kbl + 8 * ch + 4 - 4 * (ch & 1)) * TP + n;
        const unsigned p0 = pk2(sa[0 * TP], sa[1 * TP]), p1 = pk2(sa[2 * TP], sa[3 * TP]), p2 = pk2(sb[0 * TP], sb[1 * TP]), p3 = pk2(sb[2 * TP], sb[3 * TP]);
        const bool od = ch & 1; v4u o; o.x = od ? p2 : p0; o.y = od ? p3 : p1; o.z = od ? p0 : p2; o.w = od ? p1 : p3;
        *(GAS v4u*)(WT + ((size_t)((out_row0 >> 4) + rbl) * (K >> 5) + (k0 >> 5) + kbl) * 512 + bi * 32 + 8 * ch) = o; }
    LDS_WAIT(); asm volatile("" ::: "memory");
}
__device__ __forceinline__ void p0_transpose_matrix(const float* W, int K, int N, bf16* WT, int mode, int row_base, LAS float* scr, int gw, int NGW, int lane) {
    const int nblk = N / 64, nitems = (K / 64) * nblk;
    int it = gw; if (it >= nitems) return;
    f32x4 v[16], w[16];
    p0_item_load(v, W, N, 64 * (it / nblk), 64 * (it % nblk), lane);
    for (;;) {
        const int nx = it + NGW; const bool more = nx < nitems;
        if (more) p0_item_load(w, W, N, 64 * (nx / nblk), 64 * (nx % nblk), lane);
        { const int n0 = 64 * (it % nblk); const int r0 = row_base + (mode == 0 ? n0 : (256 * (n0 >> 7) + (n0 & 127) + (mode == 2 ? 128 : 0)));
          p0_item_store(v, WT, K, r0, 64 * (it / nblk), scr, lane); }
        if (!more) break;
#pragma unroll
        for (int i = 0; i < 16; ++i) v[i] = w[i];
        it = nx;
    }
}

struct Args { const float* in[26]; float* out; unsigned char* ws; };
struct P0Item { const float* W; bf16* WT; int K, N, mode, row_base, local; };
constexpr int P0_FFN = (D / 64) * (FF / 64), P0_IN = (D / 64) * (INC / 64), P0_OUT = (D / 64) * (D / 64), P0_LRU = 16 * 16;
constexpr int P0_TOTAL = 6 * P0_FFN + P0_IN + P0_OUT + P0_LRU;
__device__ __forceinline__ P0Item p0_decode(int g, const Args& args, bf16* WGU1, bf16* WD1, bf16* WIN, bf16* WOUT, bf16* WGU2, bf16* WD2, bf16* WLRU) {
    P0Item t;
    if (g < P0_FFN)               { t.W = args.in[3];  t.WT = WGU1; t.K = D;  t.N = FF;  t.mode = 1; t.row_base = 0; t.local = g; return t; } g -= P0_FFN;
    if (g < P0_FFN)               { t.W = args.in[4];  t.WT = WGU1; t.K = D;  t.N = FF;  t.mode = 2; t.row_base = 0; t.local = g; return t; } g -= P0_FFN;
    if (g < P0_FFN)               { t.W = args.in[5];  t.WT = WD1;  t.K = FF; t.N = D;   t.mode = 0; t.row_base = 0; t.local = g; return t; } g -= P0_FFN;
    if (g < P0_IN)                { t.W = args.in[8];  t.WT = WIN;  t.K = D;  t.N = INC; t.mode = 0; t.row_base = 0; t.local = g; return t; } g -= P0_IN;
    if (g < P0_OUT)               { t.W = args.in[19]; t.WT = WOUT; t.K = D;  t.N = D;   t.mode = 0; t.row_base = 0; t.local = g; return t; } g -= P0_OUT;
    if (g < P0_FFN)               { t.W = args.in[22]; t.WT = WGU2; t.K = D;  t.N = FF;  t.mode = 1; t.row_base = 0; t.local = g; return t; } g -= P0_FFN;
    if (g < P0_FFN)               { t.W = args.in[23]; t.WT = WGU2; t.K = D;  t.N = FF;  t.mode = 2; t.row_base = 0; t.local = g; return t; } g -= P0_FFN;
    if (g < P0_FFN)               { t.W = args.in[24]; t.WT = WD2;  t.K = FF; t.N = D;   t.mode = 0; t.row_base = 0; t.local = g; return t; } g -= P0_FFN;
    { const int hd = g >> 5, which = (g >> 4) & 1; t.W = (which ? args.in[15] : args.in[13]) + (size_t)hd * 65536; t.WT = WLRU; t.K = 256; t.N = 256; t.mode = 1 + which; t.row_base = 512 * hd; t.local = g & 15; return t; }
}
__device__ __forceinline__ void p0_convert_all(const Args& args, bf16* WGU1, bf16* WD1, bf16* WIN, bf16* WOUT, bf16* WGU2, bf16* WD2, bf16* WLRU, LAS float* scr, int gw, int NGW, int lane) {
    int it = gw; if (it >= P0_TOTAL) return;
    f32x4 v[16], w[16];
    P0Item cur = p0_decode(it, args, WGU1, WD1, WIN, WOUT, WGU2, WD2, WLRU), nxt = cur;
    { const int nnb = cur.N / 64; p0_item_load(v, cur.W, cur.N, 64 * (cur.local / nnb), 64 * (cur.local % nnb), lane); }
    for (;;) {
        const int nx = it + NGW; const bool more = nx < P0_TOTAL;
        if (more) { nxt = p0_decode(nx, args, WGU1, WD1, WIN, WOUT, WGU2, WD2, WLRU); const int nnb = nxt.N / 64; p0_item_load(w, nxt.W, nxt.N, 64 * (nxt.local / nnb), 64 * (nxt.local % nnb), lane); }
        { const int nnb = cur.N / 64, n0 = 64 * (cur.local % nnb); const int r0 = cur.row_base + (cur.mode == 0 ? n0 : (256 * (n0 >> 7) + (n0 & 127) + (cur.mode == 2 ? 128 : 0)));
          if (cur.K == 256) p0_item_store(v, cur.WT, cur.K, r0, 64 * (cur.local / nnb), scr, lane);
          else p0_item_store_blk(v, cur.WT, cur.K, r0, 64 * (cur.local / nnb), scr, lane); }
        if (!more) break;
#pragma unroll
        for (int i = 0; i < 16; ++i) v[i] = w[i];
        cur = nxt; it = nx;
    }
}

__device__ __forceinline__ size_t blk_off(int m, int c, int Kd) { return (((size_t)(m >> 4) * (Kd >> 5) + (c >> 5)) << 9) + ((m & 15) << 5) + (c & 31); }
__device__ __forceinline__ void rms_row_to_bf16(const float* xrow, const float* gain, bf16* Ub, int m, int lane) {
    f32x4 v[16]; float s = 0.f;
#pragma unroll
    for (int j = 0; j < 8; ++j) { const GAS f32x4* xp = (const GAS f32x4*)(xrow + 8 * (lane + 64 * j)); v[2 * j] = xp[0]; v[2 * j + 1] = xp[1]; }
#pragma unroll
    for (int j = 0; j < 16; ++j) s += (v[j].x * v[j].x + v[j].y * v[j].y) + (v[j].z * v[j].z + v[j].w * v[j].w);
    const float rs = __builtin_amdgcn_rsqf(wave_sum(s) * (1.f / D) + EPS);
#pragma unroll
    for (int j = 0; j < 8; ++j) { const GAS f32x4* gp = (const GAS f32x4*)(gain + 8 * (lane + 64 * j)); const f32x4 g0 = gp[0], g1 = gp[1], a = v[2 * j], b = v[2 * j + 1];
        v4u w; w.x = pk2(a.x * rs * g0.x, a.y * rs * g0.y); w.y = pk2(a.z * rs * g0.z, a.w * rs * g0.w); w.z = pk2(b.x * rs * g1.x, b.y * rs * g1.y); w.w = pk2(b.z * rs * g1.z, b.w * rs * g1.w);
        *(GAS v4u*)(Ub + (size_t)m * D + 8 * (lane + 64 * j)) = w; }
}

__device__ __forceinline__ void unpack8(const v4u w, f32x4& a, f32x4& b) { a = (f32x4){bflo(w.x), bfhi(w.x), bflo(w.y), bfhi(w.y)}; b = (f32x4){bflo(w.z), bfhi(w.z), bflo(w.w), bfhi(w.w)}; }
template <int HMODE>
__device__ __forceinline__ void norm_rows(const bf16* f, const float* hin_real, const float* hin_meta, const bf16* hin_b, bf16* hout_b, float* hout_f, bf16* uout, const float* gpost, const float* gpre, float coef, int nrows, int gw, int NGW) {
    int lane = opaque_lane();
    for (int row = gw; row < nrows; row += NGW) {
        asm volatile("" : "+v"(lane));
        const size_t ro = (size_t)row * D + 8 * lane;
        f32x4 v[16]; float s = 0.f;
#pragma unroll
        for (int j = 0; j < 8; ++j) { const v4u w = *(const GAS v4u*)(f + ro + 512 * j); unpack8(w, v[2 * j], v[2 * j + 1]); }
#pragma unroll
        for (int j = 0; j < 16; ++j) s += (v[j].x * v[j].x + v[j].y * v[j].y) + (v[j].z * v[j].z + v[j].w * v[j].w);
        const float rs = coef * __builtin_amdgcn_rsqf(wave_sum(s) * (1.f / D) + EPS);
        float s2 = 0.f;
#pragma unroll
        for (int j = 0; j < 8; ++j) { const GAS f32x4* gp = (const GAS f32x4*)(gpost + 8 * lane + 512 * j); const f32x4 g0 = gp[0], g1 = gp[1]; f32x4 h0, h1;
            if (HMODE == 0) { const GAS f32x4* hp = (const GAS f32x4*)((row < MR ? hin_real + (size_t)row * D : hin_meta + (size_t)(row - MR) * D) + 8 * lane + 512 * j); h0 = hp[0]; h1 = hp[1]; }
            else { const v4u hw = *(const GAS v4u*)(hin_b + ro + 512 * j); unpack8(hw, h0, h1); }
            v[2 * j] = h0 + v[2 * j] * rs * g0; v[2 * j + 1] = h1 + v[2 * j + 1] * rs * g1; }
#pragma unroll
        for (int j = 0; j < 16; ++j) s2 += (v[j].x * v[j].x + v[j].y * v[j].y) + (v[j].z * v[j].z + v[j].w * v[j].w);
        if (HMODE == 2) {
#pragma unroll
            for (int j = 0; j < 8; ++j) { GAS f32x4* op = (GAS f32x4*)(hout_f + ro + 512 * j); op[0] = v[2 * j]; op[1] = v[2 * j + 1]; }
        } else if (row < MR) {
#pragma unroll
            for (int j = 0; j < 8; ++j) { const f32x4 a = v[2 * j], b = v[2 * j + 1]; v4u w; w.x = pk2(a.x, a.y); w.y = pk2(a.z, a.w); w.z = pk2(b.x, b.y); w.w = pk2(b.z, b.w); *(GAS v4u*)(hout_b + ro + 512 * j) = w; } }
        if (uout != nullptr) { const float rs2 = __builtin_amdgcn_rsqf(wave_sum(s2) * (1.f / D) + EPS);
#pragma unroll
            for (int j = 0; j < 8; ++j) { const GAS f32x4* gp = (const GAS f32x4*)(gpre + 8 * lane + 512 * j); const f32x4 g0 = gp[0], g1 = gp[1], a = v[2 * j], b = v[2 * j + 1];
                v4u w; w.x = pk2(a.x * rs2 * g0.x, a.y * rs2 * g0.y); w.y = pk2(a.z * rs2 * g0.z, a.w * rs2 * g0.w); w.z = pk2(b.x * rs2 * g1.x, b.y * rs2 * g1.y); w.w = pk2(b.z * rs2 * g1.z, b.w * rs2 * g1.w);
                *(GAS v4u*)(uout + ro + 512 * j) = w; } }
    }
}

#define MFMA_SETTLE1(a) asm volatile("s_nop 7\n\ts_nop 7" : "+v"(a))
#define MFMA_SETTLE2(a, b) asm volatile("s_nop 7\n\ts_nop 7" : "+v"(a), "+v"(b))
#define MFMA_SETTLE4(a, b, c, d) asm volatile("s_nop 7\n\ts_nop 7" : "+v"(a), "+v"(b), "+v"(c), "+v"(d))
#define MFMA_SETTLE8(a, b, c, d, e, f, g, h) asm volatile("s_nop 7\n\ts_nop 7" : "+v"(a), "+v"(b), "+v"(c), "+v"(d), "+v"(e), "+v"(f), "+v"(g), "+v"(h))
template <int NACC, int T, class Map, class Epi>
__device__ __forceinline__ void skinny_phase(Frame& F, const bf16* A, int lda, const bf16* Bt, int ldb, int K, int ntiles, const Map& mp, const Epi& epi) {
    LAS f32x4* red = (LAS f32x4*)(F.lds + RING_OFF);
    const int lane = opaque_lane();
    const int ks = K / 8, k_lo = F.wave * ks, r = lane & 15, q = lane >> 4;
    const int rot = 32 * (int)((blockIdx.x * 7u + F.wave * 3u) % (unsigned)(ks / 32));
    for (int t0 = blockIdx.x; t0 < ntiles; t0 += F.G * T) {
        int brow[T][NACC], acol = 0; bool valid[T];
#pragma unroll
        for (int j = 0; j < T; ++j) { const int tj = t0 + j * F.G; valid[j] = tj < ntiles; mp(valid[j] ? tj : t0, brow[j], acol); }
        f32x4 acc[T][NACC];
#pragma unroll
        for (int j = 0; j < T; ++j)
#pragma unroll
            for (int i = 0; i < NACC; ++i) acc[j][i] = (f32x4){0.f, 0.f, 0.f, 0.f};
        const bf16* ap = lda == 0 ? A + (((size_t)(MR >> 4) * (K >> 5) + (k_lo >> 5)) << 9) + r * 32 + 8 * q : A + (size_t)(MR + r) * lda + k_lo + 8 * q;
        const int astep = lda == 0 ? 16 : 1;
        const bf16* bp[T][NACC];
#pragma unroll
        for (int j = 0; j < T; ++j)
#pragma unroll
            for (int i = 0; i < NACC; ++i) bp[j][i] = Bt + ((size_t)brow[j][i] * (K >> 5) + (k_lo >> 5)) * 512 + r * 32 + 8 * q;
        constexpr int UNR = (NACC * T <= 3) ? 8 : 4;
#pragma unroll UNR
        for (int k0 = 0; k0 < ks; k0 += 32) {
            int k = k0 + rot; k = k >= ks ? k - ks : k;
            const bf16x8 a = *(const GAS bf16x8*)(ap + k * astep);
#pragma unroll
            for (int j = 0; j < T; ++j)
#pragma unroll
                for (int i = 0; i < NACC; ++i) { const bf16x8 b = *(const GAS bf16x8*)(bp[j][i] + k * 16); acc[j][i] = __builtin_amdgcn_mfma_f32_16x16x32_bf16(b, a, acc[j][i], 0, 0, 0); }
        }
#pragma unroll
        for (int j = 0; j < T; ++j)
#pragma unroll
            for (int i = 0; i < NACC; ++i) MFMA_SETTLE1(acc[j][i]);
#pragma unroll
        for (int j = 0; j < T; ++j)
#pragma unroll
            for (int i = 0; i < NACC; ++i) red[((F.wave * T + j) * NACC + i) * 64 + lane] = acc[j][i];
        LDS_WAIT(); __syncthreads();
#pragma unroll
        for (int j = 0; j < T; ++j) if (F.wave == j && valid[j]) {
            f32x4 sred[NACC];
#pragma unroll
            for (int i = 0; i < NACC; ++i) { sred[i] = red[(j * NACC + i) * 64 + lane];
#pragma unroll
                for (int w = 1; w < 8; ++w) sred[i] += red[((w * T + j) * NACC + i) * 64 + lane]; }
            epi(t0 + j * F.G, r, q, sred);
        }
        __syncthreads();
    }
}
struct MapPlain { __device__ __forceinline__ void operator()(int tile, int (&brow)[1], int& acol) const { brow[0] = tile; acol = 0; } };
struct MapGateUp { __device__ __forceinline__ void operator()(int tile, int (&brow)[2], int& acol) const { const int j0 = 32 * (tile >> 1); brow[0] = ((256 * (j0 >> 7) + (j0 & 127)) >> 4) + (tile & 1); brow[1] = brow[0] + 8; acol = 0; } };
struct MapLru { __device__ __forceinline__ void operator()(int tile, int (&brow)[2], int& acol) const { const int c0 = 16 * tile, head = c0 >> 8, w = c0 & 255; brow[0] = 256 * (2 * head + (w >> 7)) + (w & 127); brow[1] = brow[0] + 128; acol = head * 256; } };
struct SkEpiSwiGLU { bf16* O; __device__ __forceinline__ void operator()(int tile, int r, int q, const f32x4 (&s)[2]) const {
    v2u w; w.x = pk2(siluf_(s[0][0]) * s[1][0], siluf_(s[0][1]) * s[1][1]); w.y = pk2(siluf_(s[0][2]) * s[1][2], siluf_(s[0][3]) * s[1][3]);
    *(GAS v2u*)(O + ((((size_t)(MR >> 4)) * (FF >> 5) + (tile >> 1)) << 9) + r * 32 + 8 * q + 4 * (tile & 1)) = w; } };
struct SkEpiF32 { float* C; int ldc; __device__ __forceinline__ void operator()(int tile, int r, int q, const f32x4 (&s)[1]) const { *(GAS f32x4*)(C + (size_t)(MR + r) * ldc + 16 * tile + 4 * q) = s[0]; } };
struct SkEpiBf16 { bf16* O; int ldc; __device__ __forceinline__ void operator()(int tile, int r, int q, const f32x4 (&s)[1]) const {
    v2u w; w.x = pk2(s[0][0], s[0][1]); w.y = pk2(s[0][2], s[0][3]); *(GAS v2u*)(O + (size_t)(MR + r) * ldc + 32 * (tile >> 1) + 8 * q + 4 * (tile & 1)) = w; } };
struct SkEpiLru { float* Aout; float* Dout; const bf16* XC; const float* b_a; const float* b_x; const float* lam;
    __device__ __forceinline__ void operator()(int tile, int r, int q, const f32x4 (&s)[2]) const {
        const int ch = 16 * tile + 4 * q; const size_t ro = (size_t)(MR + r) * LW + ch; const v2u xw = *(const GAS v2u*)(XC + ro);
        const float xv[4] = {bflo(xw.x), bfhi(xw.x), bflo(xw.y), bfhi(xw.y)}; f32x4 av, dv;
#pragma unroll
        for (int e = 0; e < 4; ++e) { float a, d; pg8::lru_gate_math(s[0][e], s[1][e], b_a[ch + e], b_x[ch + e], pg8::softplus_neg(lam[ch + e]), xv[e], a, d); av[e] = a; dv[e] = d; }
        *(GAS f32x4*)(Aout + ro) = av; *(GAS f32x4*)(Dout + ro) = dv; } };

constexpr int HG_PQ = 136, HG_PT = 72;
constexpr int HG_Q = 0, HG_Q0 = HG_Q + 64 * HG_PQ * 2, HG_K = HG_Q0 + 64 * HG_PQ * 2, HG_KT = HG_K + 64 * HG_PQ * 2, HG_VT = HG_KT + 128 * HG_PT * 2,
              HG_P = HG_VT + 128 * HG_PT * 2, HG_ST = HG_P + 64 * HG_PT * 2, HG_PART = HG_ST + 128 * HG_PQ * 2, HG_EL = HG_PART + 8 * 128 * 4, HG_RS = HG_EL + 128 * 4, HG_END = HG_RS + 8 * 64 * 4;
static_assert(HG_END <= LDSCTL_OFF, "HGRN LDS map");
#define WG_SYNC() do { asm volatile("s_waitcnt vmcnt(0) lgkmcnt(0)" ::: "memory"); __builtin_amdgcn_s_barrier(); asm volatile("" ::: "memory"); } while (0)
#define LSYNC() do { asm volatile("s_waitcnt lgkmcnt(0)" ::: "memory"); __builtin_amdgcn_s_barrier(); asm volatile("" ::: "memory"); } while (0)
__device__ __forceinline__ void norm_meta_row(Frame& F, int m, const bf16* f, const float* meta, bf16* uout, const float* gpost, const float* gpre, float coef) {
    const int tid = opaque_tid(); LAS float* red = (LAS float*)F.lds;
    const size_t ro = (size_t)(MR + m) * D + 8 * tid;
    const v4u fw = *(const GAS v4u*)(f + ro);
    const f32x4 h0 = *(const GAS f32x4*)(meta + (size_t)m * D + 8 * tid), h1 = *(const GAS f32x4*)(meta + (size_t)m * D + 8 * tid + 4);
    const f32x4 g0 = *(const GAS f32x4*)(gpost + 8 * tid), g1 = *(const GAS f32x4*)(gpost + 8 * tid + 4), p0 = *(const GAS f32x4*)(gpre + 8 * tid), p1 = *(const GAS f32x4*)(gpre + 8 * tid + 4);
    float fv[8] = {bflo(fw.x), bfhi(fw.x), bflo(fw.y), bfhi(fw.y), bflo(fw.z), bfhi(fw.z), bflo(fw.w), bfhi(fw.w)};
    float s1 = 0.f;
#pragma unroll
    for (int e = 0; e < 8; ++e) s1 += fv[e] * fv[e];
    s1 = wave_sum(s1); if ((tid & 63) == 0) red[F.wave] = s1;
    WG_SYNC();
    float t1 = 0.f;
#pragma unroll
    for (int w = 0; w < 8; ++w) t1 += red[w];
    const float rs = coef * __builtin_amdgcn_rsqf(t1 * (1.f / D) + EPS);
    const float hv[8] = {h0.x + fv[0] * rs * g0.x, h0.y + fv[1] * rs * g0.y, h0.z + fv[2] * rs * g0.z, h0.w + fv[3] * rs * g0.w, h1.x + fv[4] * rs * g1.x, h1.y + fv[5] * rs * g1.y, h1.z + fv[6] * rs * g1.z, h1.w + fv[7] * rs * g1.w};
    float s2 = 0.f;
#pragma unroll
    for (int e = 0; e < 8; ++e) s2 += hv[e] * hv[e];
    s2 = wave_sum(s2); if ((tid & 63) == 0) red[8 + F.wave] = s2;
    WG_SYNC();
    float t2 = 0.f;
#pragma unroll
    for (int w = 0; w < 8; ++w) t2 += red[8 + w];
    const float rs2 = __builtin_amdgcn_rsqf(t2 * (1.f / D) + EPS);
    v4u o; o.x = pk2(hv[0] * rs2 * p0.x, hv[1] * rs2 * p0.y); o.y = pk2(hv[2] * rs2 * p0.z, hv[3] * rs2 * p0.w); o.z = pk2(hv[4] * rs2 * p1.x, hv[5] * rs2 * p1.y); o.w = pk2(hv[6] * rs2 * p1.z, hv[7] * rs2 * p1.w);
    *(GAS v4u*)(uout + ro) = o;
    WG_SYNC();
}

typedef LAS unsigned char* ldsp;
__device__ __forceinline__ bf16x8 lds_frag(ldsp base, int row, int pitch, int col) { return *(const LAS bf16x8*)(base + (row * pitch + col) * 2); }

template <bool PASS_C>
__device__ __forceinline__ void hgrn_unit(Frame& F, int unit, const bf16* proj, const float* lbl, const float* gn, float* HG, float* HD, bf16* Y) {
    const int tid = opaque_tid(), lane = tid & 63, w = F.wave, r = lane & 15, q = lane >> 4;
    const int b = unit >> 8, h = (unit >> 4) & 15, c = unit & 15;
    ldsp L = F.lds;
    const int ch0 = 2 * lane;
    const float lb0 = sigmoidf_(lbl[h * 128 + ch0] - lbl[HW + h * 128 + ch0]), lb1 = sigmoidf_(lbl[h * 128 + ch0 + 1] - lbl[HW + h * 128 + ch0 + 1]);
    f32x4 st[8];
    float* Gu = HG + (size_t)unit * 16384;
    if (PASS_C) {
#pragma unroll
        for (int tk = 0; tk < 8; ++tk)
#pragma unroll
            for (int e = 0; e < 4; ++e) st[tk][e] = Gu[(16 * w + 4 * q + e) * 128 + 16 * tk + r];
#pragma unroll
        for (int tk = 0; tk < 8; ++tk)
#pragma unroll
            for (int e = 0; e < 4; ++e) *(LAS bf16*)(L + HG_ST + ((16 * w + 4 * q + e) * HG_PQ + 16 * tk + r) * 2) = f2bf16(st[tk][e]);
    } else {
#pragma unroll
        for (int tk = 0; tk < 8; ++tk) st[tk] = (f32x4){0.f, 0.f, 0.f, 0.f};
    }
    float tl0 = 0.f, tl1 = 0.f;
    const int nch = (c == 0) ? 5 : 4;
    unsigned Lf[8], Lv[8], Lq[8];
#define HG_LOAD(cj) do { const bool mc_ = (c == 0 && (cj) == 0); const size_t r0_ = (size_t)b * SEQ + c * 256 + ((c == 0) ? (cj) - 1 : (cj)) * 64; \
        _Pragma("unroll") for (int i = 0; i < 8; ++i) { const int t = 8 * w + i; const size_t row = mc_ ? (size_t)(MR + (t < 48 ? 0 : t - 48)) : r0_ + t; const bf16* pr = proj + row * INC + h * 128 + ch0; \
            Lf[i] = *(const GAS unsigned*)(pr + HW); Lv[i] = *(const GAS unsigned*)(pr + 2 * HW); if (PASS_C) Lq[i] = *(const GAS unsigned*)pr; } } while (0)
    HG_LOAD(0);
    for (int ci = 0; ci < nch; ++ci) {
        const bool metac = (c == 0 && ci == 0);
        const int s = (c == 0) ? ci - 1 : ci;
        const size_t row0 = (size_t)b * SEQ + c * 256 + s * 64;
        float lc0[8], lc1[8], kk0[8], kk1[8], qa0[8], qa1[8]; unsigned vv[8];
        float run0 = 0.f, run1 = 0.f;
#pragma unroll
        for (int i = 0; i < 8; ++i) { const int t = 8 * w + i; const bool nul = metac && t < 48;
            const unsigned fw = Lf[i]; const unsigned vw = Lv[i];
            const float sg0 = sigmoidf_(bflo(fw)), sg1 = sigmoidf_(bfhi(fw));
            const float l0 = nul ? 0.f : __logf(lb0 + (1.f - lb0) * sg0), l1 = nul ? 0.f : __logf(lb1 + (1.f - lb1) * sg1);
            run0 += l0; run1 += l1; lc0[i] = run0; lc1[i] = run1;
            kk0[i] = nul ? 0.f : (1.f - lb0) * (1.f - sg0); kk1[i] = nul ? 0.f : (1.f - lb1) * (1.f - sg1); vv[i] = nul ? 0u : vw;
            if (PASS_C) { const unsigned qw = Lq[i]; qa0[i] = nul ? 0.f : siluf_(bflo(qw)); qa1[i] = nul ? 0.f : siluf_(bfhi(qw)); } }
        if (ci + 1 < nch) HG_LOAD(ci + 1);
        *(LAS float*)(L + HG_PART + (w * 128 + ch0) * 4) = run0; *(LAS float*)(L + HG_PART + (w * 128 + ch0 + 1) * 4) = run1;
        LSYNC();
        float pre0 = 0.f, pre1 = 0.f, mid0 = 0.f, mid1 = 0.f, last0 = 0.f, last1 = 0.f;
#pragma unroll
        for (int ww = 0; ww < 8; ++ww) { const float p0 = *(LAS float*)(L + HG_PART + (ww * 128 + ch0) * 4), p1 = *(LAS float*)(L + HG_PART + (ww * 128 + ch0 + 1) * 4);
            if (ww < w) { pre0 += p0; pre1 += p1; } if (ww < 4) { mid0 += p0; mid1 += p1; } last0 += p0; last1 += p1; }
        tl0 += last0; tl1 += last1;
        if (w == 0) { *(LAS float*)(L + HG_EL + ch0 * 4) = __expf(last0); *(LAS float*)(L + HG_EL + (ch0 + 1) * 4) = __expf(last1); }
        const float em0 = __expf(mid0), em1 = __expf(mid1), elm0 = __expf(last0 - mid0), elm1 = __expf(last1 - mid1);
        unsigned ktw0[4], ktw1[4], vtw0[4], vtw1[4];
#pragma unroll
        for (int i = 0; i < 8; i += 2) {
            float kl0[2], kl1[2];
#pragma unroll
            for (int j = 0; j < 2; ++j) { const int t = 8 * w + i + j; const float c0 = pre0 + lc0[i + j] - mid0, c1 = pre1 + lc1[i + j] - mid1;
                const float kt0 = kk0[i + j] * __expf(-c0), kt1 = kk1[i + j] * __expf(-c1);
                kl0[j] = kt0 * elm0; kl1[j] = kt1 * elm1;
                if (PASS_C) { const float qt0 = qa0[i + j] * __expf(c0), qt1 = qa1[i + j] * __expf(c1);
                    *(LAS unsigned*)(L + HG_Q + (t * HG_PQ + ch0) * 2) = pk2(qt0, qt1); *(LAS unsigned*)(L + HG_Q0 + (t * HG_PQ + ch0) * 2) = pk2(qt0 * em0, qt1 * em1);
                    *(LAS unsigned*)(L + HG_K + (t * HG_PQ + ch0) * 2) = pk2(kt0, kt1); } }
            ktw0[i >> 1] = pk2(kl0[0], kl0[1]); ktw1[i >> 1] = pk2(kl1[0], kl1[1]);
            vtw0[i >> 1] = (vv[i] & 0xffffu) | (vv[i + 1] << 16); vtw1[i >> 1] = (vv[i] >> 16) | (vv[i + 1] & 0xffff0000u); }
        *(LAS v4u*)(L + HG_KT + (ch0 * HG_PT + 8 * w) * 2) = (v4u){ktw0[0], ktw0[1], ktw0[2], ktw0[3]}; *(LAS v4u*)(L + HG_KT + ((ch0 + 1) * HG_PT + 8 * w) * 2) = (v4u){ktw1[0], ktw1[1], ktw1[2], ktw1[3]};
        *(LAS v4u*)(L + HG_VT + (ch0 * HG_PT + 8 * w) * 2) = (v4u){vtw0[0], vtw0[1], vtw0[2], vtw0[3]}; *(LAS v4u*)(L + HG_VT + ((ch0 + 1) * HG_PT + 8 * w) * 2) = (v4u){vtw1[0], vtw1[1], vtw1[2], vtw1[3]};
        LSYNC();
        const bool do_out = PASS_C && !metac;
        if (do_out) {
            v2u gwp[4];
#pragma unroll
            for (int ti2 = 0; ti2 < 4; ++ti2) gwp[ti2] = *(const GAS v2u*)(proj + (row0 + 16 * ti2 + r) * INC + 3 * HW + h * 128 + 16 * w + 4 * q);
            const int ti = w >> 1;
#pragma unroll
            for (int jj = 0; jj < 2; ++jj) { const int tj = 2 * (w & 1) + jj; f32x4 a4 = (f32x4){0.f, 0.f, 0.f, 0.f};
                if (tj <= ti) {
#pragma unroll
                    for (int ks = 0; ks < 4; ++ks) a4 = __builtin_amdgcn_mfma_f32_16x16x32_bf16(lds_frag(L + HG_K, 16 * tj + r, HG_PQ, 32 * ks + 8 * q), lds_frag(L + HG_Q, 16 * ti + r, HG_PQ, 32 * ks + 8 * q), a4, 0, 0, 0);
                    MFMA_SETTLE1(a4);
                    if (tj == ti) {
#pragma unroll
                        for (int e = 0; e < 4; ++e) a4[e] = (4 * q + e <= r) ? a4[e] : 0.f; } }
                *(LAS v2u*)(L + HG_P + ((16 * ti + r) * HG_PT + 16 * tj + 4 * q) * 2) = (v2u){pk2(a4[0], a4[1]), pk2(a4[2], a4[3])}; }
            LSYNC();
            f32x4 o[4];
#pragma unroll
            for (int ti2 = 0; ti2 < 4; ++ti2) o[ti2] = (f32x4){0.f, 0.f, 0.f, 0.f};
#pragma unroll
            for (int ks = 0; ks < 4; ++ks) { const bf16x8 a = lds_frag(L + HG_ST, 16 * w + r, HG_PQ, 32 * ks + 8 * q);
#pragma unroll
                for (int ti2 = 0; ti2 < 4; ++ti2) o[ti2] = __builtin_amdgcn_mfma_f32_16x16x32_bf16(a, lds_frag(L + HG_Q0, 16 * ti2 + r, HG_PQ, 32 * ks + 8 * q), o[ti2], 0, 0, 0); }
#pragma unroll
            for (int js = 0; js < 2; ++js) { const bf16x8 a = lds_frag(L + HG_VT, 16 * w + r, HG_PT, 32 * js + 8 * q);
#pragma unroll
                for (int ti2 = 0; ti2 < 4; ++ti2) o[ti2] = __builtin_amdgcn_mfma_f32_16x16x32_bf16(a, lds_frag(L + HG_P, 16 * ti2 + r, HG_PT, 32 * js + 8 * q), o[ti2], 0, 0, 0); }
            MFMA_SETTLE4(o[0], o[1], o[2], o[3]);
#pragma unroll
            for (int ti2 = 0; ti2 < 4; ++ti2) { float ss = (o[ti2][0] * o[ti2][0] + o[ti2][1] * o[ti2][1]) + (o[ti2][2] * o[ti2][2] + o[ti2][3] * o[ti2][3]);
                ss += __shfl_xor(ss, 16); ss += __shfl_xor(ss, 32);
                if (q == 0) *(LAS float*)(L + HG_RS + (w * 64 + 16 * ti2 + r) * 4) = ss; }
            LSYNC();
            const f32x4 g4 = *(const GAS f32x4*)(gn + h * 128 + 16 * w + 4 * q);
#pragma unroll
            for (int ti2 = 0; ti2 < 4; ++ti2) { float tot = 0.f;
#pragma unroll
                for (int ww = 0; ww < 8; ++ww) tot += *(LAS float*)(L + HG_RS + (ww * 64 + 16 * ti2 + r) * 4);
                const float rs = __builtin_amdgcn_rsqf(tot * (1.f / 128.f) + EPS);
                const size_t row = row0 + 16 * ti2 + r; const v2u gw = gwp[ti2];
                v2u yw; yw.x = pk2(o[ti2][0] * rs * g4[0] * siluf_(bflo(gw.x)), o[ti2][1] * rs * g4[1] * siluf_(bfhi(gw.x))); yw.y = pk2(o[ti2][2] * rs * g4[2] * siluf_(bflo(gw.y)), o[ti2][3] * rs * g4[3] * siluf_(bfhi(gw.y)));
                *(GAS v2u*)(Y + row * D + h * 128 + 16 * w + 4 * q) = yw; }
        }
        if (!(PASS_C && ci == nch - 1)) {
#pragma unroll
            for (int tk = 0; tk < 8; ++tk) { const float el = *(LAS float*)(L + HG_EL + (16 * tk + r) * 4); st[tk] = st[tk] * el; }
#pragma unroll
            for (int js = 0; js < 2; ++js) { const bf16x8 a = lds_frag(L + HG_VT, 16 * w + r, HG_PT, 32 * js + 8 * q);
#pragma unroll
                for (int tk = 0; tk < 8; ++tk) st[tk] = __builtin_amdgcn_mfma_f32_16x16x32_bf16(a, lds_frag(L + HG_KT, 16 * tk + r, HG_PT, 32 * js + 8 * q), st[tk], 0, 0, 0); }
            MFMA_SETTLE8(st[0], st[1], st[2], st[3], st[4], st[5], st[6], st[7]);
            if (PASS_C) {
#pragma unroll
                for (int tk = 0; tk < 8; ++tk)
#pragma unroll
                    for (int e = 0; e < 4; ++e) *(LAS bf16*)(L + HG_ST + ((16 * w + 4 * q + e) * HG_PQ + 16 * tk + r) * 2) = f2bf16(st[tk][e]);
            }
        }
    }
    if (!PASS_C) {
#pragma unroll
        for (int tk = 0; tk < 8; ++tk)
#pragma unroll
            for (int e = 0; e < 4; ++e) Gu[(16 * w + 4 * q + e) * 128 + 16 * tk + r] = st[tk][e];
        if (w == 0) { HD[unit * 128 + ch0] = __expf(tl0); HD[unit * 128 + ch0 + 1] = __expf(tl1); }
    }
    WG_SYNC();
}
__device__ __forceinline__ void hgrn_carry(Frame& F, const float* HG, float* HG2, const float* HD) {
    const int tid = opaque_tid();
    for (int idx = blockIdx.x * 512 + tid; idx < 32 * 16384; idx += F.G * 512) {
        const int bh = idx >> 14, e = idx & 16383, k = e & 127; float S = 0.f;
        float g[16], dk[16];
#pragma unroll
        for (int c = 0; c < 16; ++c) { g[c] = HG[(size_t)(bh * 16 + c) * 16384 + e]; dk[c] = HD[(bh * 16 + c) * 128 + k]; }
#pragma unroll
        for (int c = 0; c < 16; ++c) { HG2[(size_t)(bh * 16 + c) * 16384 + e] = S; S = dk[c] * S + g[c]; }
    }
}

constexpr int LR_P = 264;
constexpr int LR_XC = 0, LR_OH = LR_XC + 64 * LR_P * 2, LR_OA = LR_OH + 64 * LR_P * 2, LR_END = LR_OA + 64 * LR_P * 2;
static_assert(LR_END <= LDSCTL_OFF, "LRU LDS map");
__device__ __forceinline__ void lru_unit(Frame& F, int unit, const bf16* proj, const bf16* WL, const float* cw, const float* cb, const float* b_a, const float* b_x, const float* lam,
                                         bf16* HLOC, bf16* ACUM, float* LC) {
    const int tid = opaque_tid(), lane = tid & 63, w = F.wave, r = lane & 15, q = lane >> 4;
    const int b = unit >> 7, hd = (unit >> 4) & 7, c = unit & 15;
    ldsp L = F.lds;
    const int c8 = tid & 31, tg = tid >> 5;
    float ba[2], bx[2], sp[2], hc[2] = {0.f, 0.f}, pc[2] = {1.f, 1.f};
#pragma unroll
    for (int ct = 0; ct < 2; ++ct) { const int ch = hd * 256 + 32 * w + 16 * ct + r; ba[ct] = b_a[ch]; bx[ct] = b_x[ch]; sp[ct] = pg8::softplus_neg(lam[ch]); }
    const int nsc = (c == 0) ? 5 : 4;
    const int chg = hd * 256 + 8 * c8;
    float wv[4][8], bv[8];
#pragma unroll
    for (int e = 0; e < 8; ++e) { bv[e] = cb[chg + e];
#pragma unroll
        for (int k = 0; k < 4; ++k) wv[k][e] = cw[k * LW + chg + e]; }
    v4u xw[7];
#define LR_LOAD(sj) do { const bool mc_ = (c == 0 && (sj) == 0); const int p0_ = (mc_ ? 0 : NMETA + c * 256 + ((c == 0) ? (sj) - 1 : (sj)) * 64) + 4 * tg - 3; \
        if (tg < (mc_ ? 4 : 16)) { _Pragma("unroll") for (int d = 0; d < 7; ++d) { const int p = p0_ + d; \
            if (p >= 0) { const size_t row = p < NMETA ? (size_t)(MR + p) : (size_t)b * SEQ + p - NMETA; xw[d] = *(const GAS v4u*)(proj + row * INC + 4 * HW + chg); } \
            else xw[d] = (v4u){0u, 0u, 0u, 0u}; } } } while (0)
    LR_LOAD(0);
    const int r_outer = r, q_outer = q;
    for (int si = 0; si < nsc; ++si) {
        int r = r_outer, q = q_outer; asm volatile("" : "+v"(r), "+v"(q));
        const bool metac = (c == 0 && si == 0);
        const int ntt = metac ? 1 : 4;
        const int pos0 = metac ? 0 : NMETA + c * 256 + ((c == 0) ? si - 1 : si) * 64;
        if (tg < 4 * ntt) {
            float xr[7][8];
#pragma unroll
            for (int d = 0; d < 7; ++d) { xr[d][0] = bflo(xw[d].x); xr[d][1] = bfhi(xw[d].x); xr[d][2] = bflo(xw[d].y); xr[d][3] = bfhi(xw[d].y); xr[d][4] = bflo(xw[d].z); xr[d][5] = bfhi(xw[d].z); xr[d][6] = bflo(xw[d].w); xr[d][7] = bfhi(xw[d].w); }
#pragma unroll
            for (int i = 0; i < 4; ++i) { float xo[8];
#pragma unroll
                for (int e = 0; e < 8; ++e) xo[e] = bv[e] + xr[i][e] * wv[0][e] + xr[i + 1][e] * wv[1][e] + xr[i + 2][e] * wv[2][e] + xr[i + 3][e] * wv[3][e];
                *(LAS v4u*)(L + LR_XC + ((4 * tg + i) * LR_P + 8 * c8) * 2) = (v4u){pk2(xo[0], xo[1]), pk2(xo[2], xo[3]), pk2(xo[4], xo[5]), pk2(xo[6], xo[7])}; }
        }
        LSYNC();
        f32x4 ar[2][4], ai[2][4];
#pragma unroll
        for (int ct = 0; ct < 2; ++ct)
#pragma unroll
            for (int tt = 0; tt < 4; ++tt) { ar[ct][tt] = (f32x4){0.f, 0.f, 0.f, 0.f}; ai[ct][tt] = (f32x4){0.f, 0.f, 0.f, 0.f}; }
        const bf16* wrow = WL + (size_t)(512 * hd + 256 * (w >> 2) + 32 * (w & 3) + r) * 256 + 8 * q;
        bf16x8 fb[4][4];
        const char* wub = (const char*)(WL + (size_t)(512 * hd + 256 * (w >> 2) + 32 * (w & 3)) * 256); unsigned wlo = (unsigned)((r * 256 + 8 * q) * 2); asm volatile("" : "+v"(wlo));
#define LR_BLOAD(slot, ks_) do { _Pragma("unroll") for (int ct = 0; ct < 2; ++ct) { fb[slot][2 * ct] = *(const GAS bf16x8*)(wub + (size_t)(16 * ct) * 512 + 64 * (ks_) + wlo); fb[slot][2 * ct + 1] = *(const GAS bf16x8*)(wub + (size_t)(16 * ct + 128) * 512 + 64 * (ks_) + wlo); } } while (0)
        LR_BLOAD(0, 0); LR_BLOAD(1, 1); LR_BLOAD(2, 2);
#pragma unroll
        for (int ks = 0; ks < 8; ++ks) {
            asm volatile("" ::: "memory");
            if (ks + 3 < 8) LR_BLOAD((ks + 3) & 3, ks + 3);
            asm volatile("" ::: "memory");
#pragma unroll
            for (int tt = 0; tt < 4; ++tt) { const bf16x8 a = lds_frag(L + LR_XC, 16 * tt + r, LR_P, 32 * ks + 8 * q);
#pragma unroll
                for (int ct = 0; ct < 2; ++ct) { ar[ct][tt] = __builtin_amdgcn_mfma_f32_16x16x32_bf16(a, fb[ks & 3][2 * ct], ar[ct][tt], 0, 0, 0); ai[ct][tt] = __builtin_amdgcn_mfma_f32_16x16x32_bf16(a, fb[ks & 3][2 * ct + 1], ai[ct][tt], 0, 0, 0); } }
        }
        MFMA_SETTLE8(ar[0][0], ar[0][1], ar[0][2], ar[0][3], ar[1][0], ar[1][1], ar[1][2], ar[1][3]); MFMA_SETTLE8(ai[0][0], ai[0][1], ai[0][2], ai[0][3], ai[1][0], ai[1][1], ai[1][2], ai[1][3]);
        if (si + 1 < nsc) LR_LOAD(si + 1);
#pragma unroll
        for (int ct = 0; ct < 2; ++ct) {
#pragma unroll
            for (int tt = 0; tt < 4; ++tt) { if (tt < ntt) {
                float al[4], hl[4]; float P = 1.f, H = 0.f;
#pragma unroll
                for (int e = 0; e < 4; ++e) { const int t = 16 * tt + 4 * q + e; const float xcv = bf2f(*(LAS bf16*)(L + LR_XC + (t * LR_P + 32 * w + 16 * ct + r) * 2));
                    float a, d; pg8::lru_gate_math(ar[ct][tt][e], ai[ct][tt][e], ba[ct], bx[ct], sp[ct], xcv, a, d); H = a * H + d; P *= a; al[e] = P; hl[e] = H; }
                float Pi = P, Hi = H;
                { const float Pp = __shfl(Pi, lane - 16), Hp = __shfl(Hi, lane - 16); if (q >= 1) { Hi = Pi * Hp + Hi; Pi = Pp * Pi; } }
                { const float Pp = __shfl(Pi, lane - 32), Hp = __shfl(Hi, lane - 32); if (q >= 2) { Hi = Pi * Hp + Hi; Pi = Pp * Pi; } }
                float Pe = __shfl(Pi, lane - 16), He = __shfl(Hi, lane - 16); if (q == 0) { Pe = 1.f; He = 0.f; }
                const float Pt = __shfl(Pi, 48 + r), Ht = __shfl(Hi, 48 + r);
                const float hin = Pe * hc[ct] + He, pin = pc[ct] * Pe;
                if (!metac) {
#pragma unroll
                    for (int e = 0; e < 4; ++e) { const int t = 16 * tt + 4 * q + e; const int o = (t * LR_P + 32 * w + 16 * ct + r) * 2;
                        *(LAS bf16*)(L + LR_OH + o) = f2bf16(al[e] * hin + hl[e]); *(LAS bf16*)(L + LR_OA + o) = f2bf16(pin * al[e]); } }
                hc[ct] = Pt * hc[ct] + Ht; pc[ct] = pc[ct] * Pt; } }
        }
        LSYNC();
        if (!metac) {
            const size_t rowb = (size_t)b * SEQ + pos0 - NMETA;
#pragma unroll
            for (int i = 0; i < 4; ++i) { const int t = 4 * tg + i; const size_t go = (rowb + t) * LW + hd * 256 + 8 * c8;
                *(GAS v4u*)(HLOC + go) = *(LAS v4u*)(L + LR_OH + (t * LR_P + 8 * c8) * 2); *(GAS v4u*)(ACUM + go) = *(LAS v4u*)(L + LR_OA + (t * LR_P + 8 * c8) * 2); }
        }
    }
    const int lane_e = opaque_lane(), r_e = lane_e & 15;
    if ((lane_e >> 4) == 0) {
#pragma unroll
        for (int ct = 0; ct < 2; ++ct) { const int ch = hd * 256 + 32 * w + 16 * ct + r_e; LC[(size_t)((b * 16 + c) * 2 + 0) * LW + ch] = pc[ct]; LC[(size_t)((b * 16 + c) * 2 + 1) * LW + ch] = hc[ct]; }
    }
    WG_SYNC();
}
__device__ __forceinline__ void lru_finish(Frame& F, const bf16* HLOC, const bf16* ACUM, const float* LC, const bf16* proj, const float* ln, bf16* Y) {
    const int tid = opaque_tid(), lane = tid & 63, w = F.wave;
    LAS float* HIN = (LAS float*)(F.lds);
    for (int item = blockIdx.x; item < 256; item += F.G) {
        const int b = item >> 7, c = (item >> 3) & 15, sub = item & 7;
        { f32x4 hin = (f32x4){0.f, 0.f, 0.f, 0.f};
#pragma unroll
          for (int c0 = 0; c0 < 16; c0 += 8) { if (c0 < c) { f32x4 P[8], H[8];
#pragma unroll
              for (int j = 0; j < 8; ++j) { const int cs = (c0 + j < c) ? c0 + j : 0; P[j] = *(const GAS f32x4*)(LC + (size_t)((b * 16 + cs) * 2 + 0) * LW + 4 * tid); H[j] = *(const GAS f32x4*)(LC + (size_t)((b * 16 + cs) * 2 + 1) * LW + 4 * tid); }
#pragma unroll
              for (int j = 0; j < 8; ++j) { if (c0 + j < c) hin = P[j] * hin + H[j]; } } }
          *(LAS f32x4*)(HIN + 4 * tid) = hin; }
        WG_SYNC();
#pragma unroll 1
        for (int rr = 0; rr < 4; ++rr) { const size_t row = (size_t)b * SEQ + c * 256 + sub * 32 + w * 4 + rr;
            float hv[4][8]; float ss = 0.f;
#pragma unroll
            for (int j = 0; j < 4; ++j) { const int ch = (lane + 64 * j) * 8; const v4u hw = *(const GAS v4u*)(HLOC + row * LW + ch), aw = *(const GAS v4u*)(ACUM + row * LW + ch);
                const f32x4 i0 = *(LAS f32x4*)(HIN + ch), i1 = *(LAS f32x4*)(HIN + ch + 4);
                hv[j][0] = bflo(hw.x) + bflo(aw.x) * i0[0]; hv[j][1] = bfhi(hw.x) + bfhi(aw.x) * i0[1]; hv[j][2] = bflo(hw.y) + bflo(aw.y) * i0[2]; hv[j][3] = bfhi(hw.y) + bfhi(aw.y) * i0[3];
                hv[j][4] = bflo(hw.z) + bflo(aw.z) * i1[0]; hv[j][5] = bfhi(hw.z) + bfhi(aw.z) * i1[1]; hv[j][6] = bflo(hw.w) + bflo(aw.w) * i1[2]; hv[j][7] = bfhi(hw.w) + bfhi(aw.w) * i1[3];
#pragma unroll
                for (int e = 0; e < 8; ++e) ss += hv[j][e] * hv[j][e]; }
            const float rs = __builtin_amdgcn_rsqf(wave_sum(ss) * (1.f / LW) + EPS);
#pragma unroll
            for (int j = 0; j < 4; ++j) { const int ch = (lane + 64 * j) * 8; const v4u gw = *(const GAS v4u*)(proj + row * INC + 4 * HW + LW + ch);
                const f32x4 l0 = *(const GAS f32x4*)(ln + ch), l1 = *(const GAS f32x4*)(ln + ch + 4);
                v4u yw; yw.x = pk2(hv[j][0] * rs * l0[0] * gelu_tanh(bflo(gw.x)), hv[j][1] * rs * l0[1] * gelu_tanh(bfhi(gw.x))); yw.y = pk2(hv[j][2] * rs * l0[2] * gelu_tanh(bflo(gw.y)), hv[j][3] * rs * l0[3] * gelu_tanh(bfhi(gw.y)));
                yw.z = pk2(hv[j][4] * rs * l1[0] * gelu_tanh(bflo(gw.z)), hv[j][5] * rs * l1[1] * gelu_tanh(bfhi(gw.z))); yw.w = pk2(hv[j][6] * rs * l1[2] * gelu_tanh(bflo(gw.w)), hv[j][7] * rs * l1[3] * gelu_tanh(bfhi(gw.w)));
                *(GAS v4u*)(Y + row * D + HW + ch) = yw; } }
        WG_SYNC();
    }
}

#ifndef PHASE_MASK
#define PHASE_MASK 0xFFFFFFFF
#endif
#ifndef DUP_MASK
#define DUP_MASK 0
#endif
#define PH(k) if constexpr ((PHASE_MASK >> (k)) & 1) _Pragma("unroll") for (int rep_ = 0; rep_ < 1 + (int)((DUP_MASK >> (k)) & 1); ++rep_)
__global__ void __launch_bounds__(NWAVES * 64, 2) hymba_fwd(Args args) {
    extern __shared__ __attribute__((aligned(16))) unsigned char lds[];
    Frame F;
    F.lds = (LAS unsigned char*)lds;
    F.MISC = (volatile LAS unsigned*)(F.lds + MISC_OFF);
    F.tid = threadIdx.x; F.lane = F.tid & 63; F.wave = __builtin_amdgcn_readfirstlane(F.tid >> 6);
    F.G = gridDim.x; { const int bx = blockIdx.x; F.vcu = (F.G % 8 == 0) ? (bx % 8) * (F.G / 8) + bx / 8 : bx; }
    unsigned char* ws = args.ws;
    F.ctl = (gu32*)(ws + WS_CTL);
    for (int u = F.tid; u < (LDS_BYTES - LDSCTL_OFF) / 4; u += NWAVES * 64) ((LAS unsigned*)(F.lds + LDSCTL_OFF))[u] = 0u;
    __syncthreads();
    XcdBarrier bar = xcd_barrier_post((unsigned*)(F.ctl + CW_BAR), F.MISC + 8);
#define GRID_BAR() do { XcdBarrier b_ = bar; asm volatile("" : "+s"(b_.bar), "+s"(b_.x)); xcd_barrier(b_); } while (0)

    const float* x = args.in[0]; const float* meta = args.in[1];
    bf16* WGU1 = (bf16*)(ws + WS_WGU1); bf16* WD1 = (bf16*)(ws + WS_WD1); bf16* WIN = (bf16*)(ws + WS_WIN); bf16* WOUT = (bf16*)(ws + WS_WOUT);
    bf16* WGU2 = (bf16*)(ws + WS_WGU2); bf16* WD2 = (bf16*)(ws + WS_WD2); bf16* WLRU = (bf16*)(ws + WS_WLRU);
    bf16* U = (bf16*)(ws + WS_U); bf16* HID = (bf16*)(ws + WS_BIG); bf16* PROJ = (bf16*)(ws + WS_BIG);
    bf16* Fb = (bf16*)(ws + WS_F);
    float* HGs = (float*)(ws + WS_HG); float* HGs2 = (float*)(ws + WS_HG2); float* HDs = (float*)(ws + WS_HD); float* LC = (float*)(ws + WS_LC); bf16* HLOC = (bf16*)(ws + WS_HLOC); bf16* ACUM = (bf16*)(ws + WS_ACUM); bf16* Y = (bf16*)(ws + WS_Y); bf16* HB = (bf16*)(ws + WS_HB);
    float* out = args.out;
    const int gw = F.vcu * NWAVES + F.wave, NGW = F.G * NWAVES;

    PH(0) {
        LAS float* scr = (LAS float*)(F.lds + RING_OFF + F.wave * 16896); const int lane0 = opaque_lane();
        p0_convert_all(args, WGU1, WD1, WIN, WOUT, WGU2, WD2, WLRU, scr, gw, NGW, lane0);
        for (int m = gw; m < MT; m += NGW) rms_row_to_bf16(m < MR ? x + (size_t)m * D : meta + (size_t)(m - MR) * D, args.in[2], U, m, lane0);
    }
    GRID_BAR();

    PH(1) {
        skinny_phase<2, 3>(F, U, D, WGU1, D, D, FF / 16, MapGateUp{}, SkEpiSwiGLU{HID});
        pg8::Gemm g{U, WGU1, MR, 2 * FF, D, D, D, 0, 0}; pg8::StaticOrder S; S.init(MR, 2 * FF, F.G, (int)blockIdx.x);
        pg8::EpiSwiGLU E{HID, FF};
        pg8::gemm_phase<pg8::EpiSwiGLU, pg8::StaticOrder, true, true>(F.lds + RING_OFF, g, S, E, F.wave);
    }
    GRID_BAR();
    PH(2) {
        skinny_phase<1, 1>(F, HID, 0, WD1, FF, FF, D / 16, MapPlain{}, SkEpiBf16{Fb, D});
        pg8::Gemm g{HID, WD1, MR, D, FF, FF, FF, 0, 1}; pg8::StaticOrder S; S.init(MR, D, F.G, (int)blockIdx.x);
        pg8::EpiBf16 E{Fb, D};
        pg8::gemm_phase<pg8::EpiBf16, pg8::StaticOrder, true, true>(F.lds + RING_OFF, g, S, E, F.wave);
    }
    GRID_BAR();
    PH(3) { norm_rows<0>(Fb, x, meta, nullptr, HB, nullptr, U, args.in[6], args.in[7], 0.5f, MR, gw, NGW);
        for (int m = blockIdx.x; m < NMETA; m += F.G) norm_meta_row(F, m, Fb, meta, U, args.in[6], args.in[7], 0.5f); }
    GRID_BAR();
    PH(4) {
        skinny_phase<1, 3>(F, U, D, WIN, D, D, INC / 16, MapPlain{}, SkEpiBf16{PROJ, INC});
        pg8::Gemm g{U, WIN, MR, INC, D, D, D, 0, 0}; pg8::StaticOrder S; S.init(MR, INC, F.G, (int)blockIdx.x);
        pg8::EpiBf16 E{PROJ, INC};
        pg8::gemm_phase<pg8::EpiBf16, pg8::StaticOrder, true, true>(F.lds + RING_OFF, g, S, E, F.wave);
    }
    GRID_BAR();
    PH(5) {
        for (int u = blockIdx.x; u < 256; u += F.G) lru_unit(F, u, PROJ, WLRU, args.in[11], args.in[12], args.in[14], args.in[16], args.in[17], HLOC, ACUM, LC);
        for (int i = blockIdx.x; i < 512; i += F.G) { const int u = (i & ~255) | ((i + 4 + 4 * (i >> 8)) & 255); hgrn_unit<false>(F, u, PROJ, args.in[9], args.in[10], HGs, HDs, Y); }
    }
    GRID_BAR();
    PH(6) { hgrn_carry(F, HGs, HGs2, HDs); lru_finish(F, HLOC, ACUM, LC, PROJ, args.in[18], Y); }
    GRID_BAR();
    PH(7) { for (int i = blockIdx.x; i < 512; i += F.G) { const int u = (i & ~255) | ((i + 8 * (i >> 8)) & 255); hgrn_unit<true>(F, u, PROJ, args.in[9], args.in[10], HGs2, HDs, Y); } }
    GRID_BAR();
    PH(9) {
        pg8::Gemm g{Y, WOUT, MR, D, D, D, D, 0, 0}; pg8::StaticOrder S; S.init(MR, D, F.G, (int)blockIdx.x);
        pg8::EpiBf16 E{Fb, D};
        pg8::gemm_phase<pg8::EpiBf16, pg8::StaticOrder, true, true>(F.lds + RING_OFF, g, S, E, F.wave);
    }
    GRID_BAR();
    PH(10) norm_rows<1>(Fb, nullptr, nullptr, HB, HB, nullptr, U, args.in[20], args.in[21], 1.0f, MR, gw, NGW);
    GRID_BAR();
    PH(11) {
        pg8::Gemm g{U, WGU2, MR, 2 * FF, D, D, D, 0, 0}; pg8::StaticOrder S; S.init(MR, 2 * FF, F.G, (int)blockIdx.x);
        pg8::EpiSwiGLU E{HID, FF};
        pg8::gemm_phase<pg8::EpiSwiGLU, pg8::StaticOrder, true, true>(F.lds + RING_OFF, g, S, E, F.wave);
    }
    GRID_BAR();
    PH(12) {
        pg8::Gemm g{HID, WD2, MR, D, FF, FF, FF, 0, 1}; pg8::StaticOrder S; S.init(MR, D, F.G, (int)blockIdx.x);
        pg8::EpiBf16 E{Fb, D};
        pg8::gemm_phase<pg8::EpiBf16, pg8::StaticOrder, true, true>(F.lds + RING_OFF, g, S, E, F.wave);
    }
    GRID_BAR();
    PH(13) norm_rows<2>(Fb, nullptr, nullptr, HB, nullptr, out, nullptr, args.in[25], nullptr, 0.5f, MR, gw, NGW);
}

extern "C" void kernel_launch(void* const* d_in, const int* in_sizes, int n_in, void* d_out, int out_size, void* d_ws, size_t ws_size, hipStream_t stream) {
    static int grid = 0;
    if (grid == 0) {
        if (n_in != 26 || out_size != MR * D || ws_size < WS_END) { fprintf(stderr, "kernel_launch: unexpected shapes (n_in %d, out %d, ws %zu, need %zu)\n", n_in, out_size, ws_size, (size_t)WS_END); grid = -1; return; }
        int dev = 0, cus = 0, per_cu = 0;
        if (hipGetDevice(&dev) != hipSuccess || hipDeviceGetAttribute(&cus, hipDeviceAttributeMultiprocessorCount, dev) != hipSuccess) { grid = -1; return; }
        if (hipFuncSetAttribute((const void*)hymba_fwd, hipFuncAttributeMaxDynamicSharedMemorySize, LDS_BYTES) != hipSuccess) { fprintf(stderr, "kernel_launch: hipFuncSetAttribute failed\n"); grid = -1; return; }
        if (hipOccupancyMaxActiveBlocksPerMultiprocessor(&per_cu, (const void*)hymba_fwd, NWAVES * 64, LDS_BYTES) != hipSuccess || per_cu < 1) fprintf(stderr, "kernel_launch: occupancy query says %d\n", per_cu);
        (void)hipGetLastError();
        grid = cus;
    }
    if (grid < 0) return;
    if (hipMemsetAsync((char*)d_ws + WS_CTL, 0, CTL_ZERO_BYTES, stream) != hipSuccess) return;
    Args a{};
    for (int i = 0; i < 26; ++i) a.in[i] = (const float*)d_in[i];
    a.out = (float*)d_out; a.ws = (unsigned char*)d_ws;
    hipLaunchKernelGGL(hymba_fwd, dim3(grid), dim3(NWAVES * 64), LDS_BYTES, stream, a);
}
```

```cpp
#include <hip/hip_runtime.h>
#include <cstdio>
#include <cstdint>

namespace pg8 {
#define PG8_LAS __attribute__((address_space(3)))
typedef unsigned short bf16_t;
typedef short bf16x8 __attribute__((ext_vector_type(8)));
typedef float f32x4 __attribute__((ext_vector_type(4)));
typedef float f32x2 __attribute__((ext_vector_type(2)));
typedef unsigned u32x4 __attribute__((ext_vector_type(4)));
typedef unsigned u32x2 __attribute__((ext_vector_type(2)));
constexpr int BM = 256, BK = 64, HALF = 128, HTB = HALF * BK * 2, STAGE_BYTES = 8 * HTB, NXCD = 8, WGM = 8;

__host__ __device__ __forceinline__ int lds_byte(int r, int c) { const int st = (r >> 4) * 2 + (c >> 5), rr = r & 15, cc = c & 31, ob = rr * 64 + cc * 2; return st * 1024 + (ob ^ (((ob >> 9) & 1) << 5)); }
__host__ __device__ __forceinline__ void stage_rc(int b, int& R, int& C) { const int st = b / 1024, sb = b % 1024, swz = sb ^ (((sb >> 9) & 1) << 5); R = (st >> 1) * 16 + swz / 64; C = (st & 1) * 32 + (swz % 64) / 2; }
__host__ __device__ __forceinline__ int perm32(int rho) { const int n = rho >> 4, i = rho & 15; return 8 * (i >> 2) + 4 * n + (i & 3); }

struct Unit { int pm, pn; };
struct Gemm { const bf16_t* A; const bf16_t* Bt; int M, N, K, lda, ldb, agrp, ablk; };

struct StaticOrder {
    int nM, nN, nwg, G, c;
    __host__ __device__ void init(int M, int N, int G_, int c_) { nM = M / BM; nN = N / BM; nwg = nM * nN; G = G_; c = c_; }
    __host__ __device__ bool next(int i, Unit& u) const {
        const long L = (long)i * G + c; if (L >= nwg) return false;
        int wgid = (int)L; { const int q = nwg / NXCD, r = nwg % NXCD, xcd = wgid % NXCD, off = wgid / NXCD; wgid = (xcd < r ? xcd * (q + 1) : r * (q + 1) + (xcd - r) * q) + off; }
        const int nig = WGM * nN, gid = wgid / nig, fm = gid * WGM, gsz = (nM - fm) < WGM ? (nM - fm) : WGM;
        u.pm = fm + ((wgid % nig) % gsz); u.pn = (wgid % nig) / gsz; return true;
    }
    __device__ __forceinline__ void a_ready(const Unit&) const {}
    __device__ __forceinline__ void done(const Unit&) const {}
};

__device__ __forceinline__ unsigned cvt_pk_bf16(float lo, float hi) { unsigned r; asm volatile("v_cvt_pk_bf16_f32 %0, %1, %2" : "=v"(r) : "v"(lo), "v"(hi)); return r; }
__device__ __forceinline__ float fast_sigmoid(float x) { return __builtin_amdgcn_rcpf(1.0f + __builtin_amdgcn_exp2f(-1.44269504089f * x)); }
__device__ __forceinline__ float fast_silu(float x) { return x * fast_sigmoid(x); }

struct EpiF32 {
    static constexpr bool PERM = false, AFTER_DRAIN = false;
    float* C; int ldc;
    __device__ __forceinline__ void operator()(const f32x4 (&acc)[2][2][4][2], const Unit& u, int wr, int wc, int fr, int fq) const {
        const int row0 = u.pm * BM + wr * 64 + fr, col0 = u.pn * BM + wc * 32 + 4 * fq;
#pragma unroll
        for (int ai = 0; ai < 2; ++ai)
#pragma unroll
            for (int m = 0; m < 4; ++m) { float* rowp = C + (size_t)(row0 + ai * HALF + m * 16) * ldc + col0;
#pragma unroll
                for (int bj = 0; bj < 2; ++bj)
#pragma unroll
                    for (int n = 0; n < 2; ++n) *(f32x4*)(rowp + bj * HALF + n * 16) = acc[ai][bj][m][n]; }
    }
};
struct EpiBf16 {
    static constexpr bool PERM = true, AFTER_DRAIN = false;
    bf16_t* O; int ldc;
    __device__ __forceinline__ void operator()(const f32x4 (&acc)[2][2][4][2], const Unit& u, int wr, int wc, int fr, int fq) const {
        const int row0 = u.pm * BM + wr * 64 + fr, col0 = u.pn * BM + wc * 32 + 8 * fq;
#pragma unroll
        for (int ai = 0; ai < 2; ++ai)
#pragma unroll
            for (int m = 0; m < 4; ++m) { bf16_t* rowp = O + (size_t)(row0 + ai * HALF + m * 16) * ldc + col0;
#pragma unroll
                for (int bj = 0; bj < 2; ++bj) { const f32x4 v0 = acc[ai][bj][m][0], v1 = acc[ai][bj][m][1];
                    u32x4 w; w.x = cvt_pk_bf16(v0[0], v0[1]); w.y = cvt_pk_bf16(v0[2], v0[3]); w.z = cvt_pk_bf16(v1[0], v1[1]); w.w = cvt_pk_bf16(v1[2], v1[3]);
                    *(u32x4*)(rowp + bj * HALF) = w; } }
    }
};
struct EpiSwiGLU {
    static constexpr bool PERM = true, AFTER_DRAIN = false;
    bf16_t* O; int ldc;
    __device__ __forceinline__ void operator()(const f32x4 (&acc)[2][2][4][2], const Unit& u, int wr, int wc, int fr, int fq) const {
#pragma unroll
        for (int ai = 0; ai < 2; ++ai)
#pragma unroll
            for (int m = 0; m < 4; ++m) { bf16_t* rowp = O + ((((size_t)(u.pm * 16 + ai * 8 + wr * 4 + m)) * (ldc >> 5) + u.pn * 4 + wc) << 9) + fr * 32 + 8 * fq;
                const f32x4 g0 = acc[ai][0][m][0], g1 = acc[ai][0][m][1], u0 = acc[ai][1][m][0], u1 = acc[ai][1][m][1];
                f32x4 v0, v1;
#pragma unroll
                for (int e = 0; e < 4; ++e) { v0[e] = fast_silu(g0[e]) * u0[e]; v1[e] = fast_silu(g1[e]) * u1[e]; }
                u32x4 w; w.x = cvt_pk_bf16(v0[0], v0[1]); w.y = cvt_pk_bf16(v0[2], v0[3]); w.z = cvt_pk_bf16(v1[0], v1[1]); w.w = cvt_pk_bf16(v1[2], v1[3]);
                *(u32x4*)rowp = w; }
    }
};
__device__ __forceinline__ float softplus_neg(float lam) { const float y = __expf(-lam); return y < 0.05f ? y * (1.0f - y * (0.5f - y * (0.33333334f - y * 0.25f))) : __logf(1.0f + y); }
__device__ __forceinline__ float neg_expm1(float x) { const float s = -x * (1.0f + x * (0.5f + x * (0.16666667f + x * (0.041666668f + x * 0.0083333338f)))); return x > -0.1f ? s : 1.0f - __expf(x); }
__device__ __forceinline__ void lru_gate_math(float rp, float ip, float ba, float bx, float sp, float xcv, float& a, float& d) {
    const float r = fast_sigmoid(rp + ba), ig = fast_sigmoid(ip + bx);
    const float la = -8.0f * r * sp; a = __expf(la); const float x2 = 2.0f * la;
    const float ser = -x2 * (1.0f + x2 * (0.5f + x2 * (0.16666667f + x2 * (0.041666668f + x2 * 0.0083333338f))));
    d = __builtin_amdgcn_sqrtf(x2 > -0.1f ? ser : 1.0f - a * a) * (ig * xcv);
}
struct EpiLru {
    static constexpr bool PERM = false, AFTER_DRAIN = false;
    float* Aout; float* Dout; const bf16_t* XC; const float* b_a; const float* b_x; const float* lam;
    __device__ __forceinline__ void operator()(const f32x4 (&acc)[2][2][4][2], const Unit& u, int wr, int wc, int fr, int fq) const {
        const int chu = (u.pn >> 1) * 256 + (u.pn & 1) * 128 + wc * 32;
        const size_t rowu = (size_t)(u.pm * BM + wr * 64);
        const unsigned lo = (unsigned)(fr * 2048 + 4 * fq);
#pragma unroll
        for (int n = 0; n < 2; ++n) { const int ch = chu + n * 16 + 4 * fq;
            const f32x4 ba = *(const f32x4*)(b_a + ch), bx = *(const f32x4*)(b_x + ch), l = *(const f32x4*)(lam + ch); f32x4 sp;
#pragma unroll
            for (int e = 0; e < 4; ++e) sp[e] = softplus_neg(l[e]);
#pragma unroll
            for (int ai = 0; ai < 2; ++ai)
#pragma unroll
                for (int m = 0; m < 4; ++m) { const size_t ub = (rowu + ai * HALF + m * 16) * 2048 + chu + n * 16;
                    const u32x2 xw = *(const u32x2*)((const char*)(XC + ub) + lo * 2u);
                    const float xv[4] = {__uint_as_float(xw.x << 16), __uint_as_float(xw.x & 0xffff0000u), __uint_as_float(xw.y << 16), __uint_as_float(xw.y & 0xffff0000u)};
                    f32x4 av, dv;
#pragma unroll
                    for (int e = 0; e < 4; ++e) { float a, d; lru_gate_math(acc[ai][0][m][n][e], acc[ai][1][m][n][e], ba[e], bx[e], sp[e], xv[e], a, d); av[e] = a; dv[e] = d; }
                    *(f32x4*)((char*)(Aout + ub) + lo * 4u) = av; *(f32x4*)((char*)(Dout + ub) + lo * 4u) = dv;
                    asm volatile("" ::: "memory"); } }
    }
};

template <class Epi, class Sched, bool ALIGN_EPI = false, bool SP2 = false>
__device__ __forceinline__ void gemm_phase(PG8_LAS unsigned char* lds, const Gemm g, const Sched& S, const Epi& E, int wave_id) {
    int lane_; asm volatile("v_mbcnt_lo_u32_b32 %0, -1, 0\n\tv_mbcnt_hi_u32_b32 %0, -1, %0" : "=v"(lane_));
    const int wid = wave_id, lane = lane_, tid = wid * 64 + lane, wr = wid >> 2, wc = wid & 3, fr = lane & 15, fq = lane >> 4;
    const int K = g.K, nt = K / BK;
    unsigned voffA[2], voffB[2];
#pragma unroll
    for (int i = 0; i < 2; ++i) { int R, C; stage_rc(wid * 2048 + i * 1024 + lane * 16, R, C);
        voffB[i] = (unsigned)((((R >> 4) * (g.K >> 5) + (C >> 5)) << 10) + (R & 15) * 64 + (C & 31) * 2); voffA[i] = g.ablk ? voffB[i] : (unsigned)(R * g.lda + C) * 2u; }
    static_assert(Epi::PERM, "the blocked weight layout stores the rows in the PERM order");
    const size_t kstep = g.ablk ? (size_t)2048 : (size_t)(BK * 2), kstepB = 2048;
    const size_t hsA = (size_t)HALF * g.lda * 2, hsB = (size_t)HALF * g.K * 2;
    const size_t tsA = 2 * hsA, tsB = 2 * hsB;
    const size_t agb = g.agrp ? (size_t)K * 2 : 0;
    const unsigned ldsw = (unsigned)wid * 2048u;
    const int aoff = lds_byte(wr * 64 + fr, fq * 8), boff = lds_byte(wc * 32 + fr, fq * 8);
#define PG8_SA(b, h) (((b) * 2 + (h)) * HTB)
#define PG8_SB(b, h) ((4 + (b) * 2 + (h)) * HTB)
#define PG8_STAGE(bufoff, gbase, voff) do { _Pragma("unroll") for (int _i = 0; _i < 2; ++_i) \
        __builtin_amdgcn_global_load_lds((const unsigned*)((const char*)(gbase) + (voff)[_i]), (PG8_LAS unsigned*)(lds + (bufoff) + ldsw + _i * 1024), 16, 0, 0); } while (0)
#define PG8_LDA(dst, b, h) do { _Pragma("unroll") for (int m = 0; m < 4; ++m) _Pragma("unroll") for (int k = 0; k < 2; ++k) dst[m][k] = *(const PG8_LAS bf16x8*)(lds + PG8_SA(b, h) + aoff + m * 2048 + k * 1024); } while (0)
#define PG8_LDB(dst, b, h) do { _Pragma("unroll") for (int n = 0; n < 2; ++n) _Pragma("unroll") for (int k = 0; k < 2; ++k) dst[n][k] = *(const PG8_LAS bf16x8*)(lds + PG8_SB(b, h) + boff + n * 2048 + k * 1024); } while (0)
#define PG8_MMA(ai, bj, At, Bt) do { __builtin_amdgcn_s_setprio(1); _Pragma("unroll") for (int m = 0; m < 4; ++m) _Pragma("unroll") for (int n = 0; n < 2; ++n) _Pragma("unroll") for (int k = 0; k < 2; ++k) \
        acc[ai][bj][m][n] = __builtin_amdgcn_mfma_f32_16x16x32_bf16(Bt[n][k], At[m][k], acc[ai][bj][m][n], 0, 0, 0); __builtin_amdgcn_s_setprio(0); } while (0)
#define PG8_WAIT_V(n) asm volatile("s_waitcnt vmcnt(" #n ")" ::: "memory")
#define PG8_WAIT_L(n) asm volatile("s_waitcnt lgkmcnt(" #n ")" ::: "memory")
#define PG8_BAR __builtin_amdgcn_s_barrier()
#define PG8_SCHED __builtin_amdgcn_sched_barrier(0)
    Unit cur, nxt; int ui = 0;
    if (!S.next(0, cur)) return;
    f32x4 acc[2][2][4][2];
#pragma unroll
    for (int a = 0; a < 2; ++a)
#pragma unroll
        for (int b = 0; b < 2; ++b)
#pragma unroll
            for (int m = 0; m < 4; ++m)
#pragma unroll
                for (int n = 0; n < 2; ++n) acc[a][b][m][n] = (f32x4){0.f, 0.f, 0.f, 0.f};
    bf16x8 At[4][2], B0[2][2], B1[2][2];
    const char* cA = (const char*)g.A + (size_t)cur.pm * tsA + (size_t)(cur.pn >> 1) * agb; const char* cB = (const char*)g.Bt + (size_t)cur.pn * tsB;
    S.a_ready(cur);
    if constexpr (SP2) {
        PG8_STAGE(PG8_SB(0, 0), cB, voffB); PG8_STAGE(PG8_SB(0, 1), cB + hsB, voffB); PG8_STAGE(PG8_SA(0, 0), cA, voffA); PG8_STAGE(PG8_SA(0, 1), cA + hsA, voffA);
        if (wr == 1) PG8_BAR;
        PG8_WAIT_V(2); PG8_BAR;
        PG8_STAGE(PG8_SB(1, 0), cB + kstepB, voffB); PG8_STAGE(PG8_SA(1, 0), cA + kstep, voffA); PG8_STAGE(PG8_SB(1, 1), cB + hsB + kstepB, voffB);
        PG8_WAIT_V(6); PG8_BAR;
    } else {
        PG8_STAGE(PG8_SB(0, 0), cB, voffB); PG8_STAGE(PG8_SA(0, 0), cA, voffA); PG8_STAGE(PG8_SB(0, 1), cB + hsB, voffB); PG8_STAGE(PG8_SA(0, 1), cA + hsA, voffA);
        if (wr == 1) PG8_BAR;
        PG8_WAIT_V(4); PG8_BAR;
        PG8_STAGE(PG8_SB(1, 0), cB + kstepB, voffB); PG8_STAGE(PG8_SA(1, 0), cA + kstep, voffA); PG8_STAGE(PG8_SB(1, 1), cB + hsB + kstepB, voffB);
        PG8_WAIT_V(6); PG8_BAR;
    }
    for (;;) {
        const bool has_next = S.next(ui + 1, nxt);
        const char* nA = has_next ? (const char*)g.A + (size_t)nxt.pm * tsA + (size_t)(nxt.pn >> 1) * agb : cA; const char* nB = has_next ? (const char*)g.Bt + (size_t)nxt.pn * tsB : cB;
        for (int t = 0; t < nt; t += 2) {
            const bool last = (t == nt - 2);
            const char* a1 = cA + (size_t)(t + 1) * kstep;
            const char* a2 = last ? nA : cA + (size_t)(t + 2) * kstep; const char* b2 = last ? nB : cB + (size_t)(t + 2) * kstepB;
            const char* a3 = a2 + kstep; const char* b3 = b2 + kstepB;
            if (last && has_next) S.a_ready(nxt);
            if constexpr (SP2) {
            PG8_LDB(B0, 0, 0); PG8_LDB(B1, 0, 1); PG8_SCHED; PG8_LDA(At, 0, 0); PG8_STAGE(PG8_SA(1, 1), a1 + hsA, voffA);
            PG8_WAIT_V(8); PG8_WAIT_L(0); PG8_BAR; PG8_MMA(0, 0, At, B0); PG8_MMA(0, 1, At, B1); PG8_BAR; PG8_SCHED;
            PG8_LDA(At, 0, 1); PG8_STAGE(PG8_SB(0, 0), b2, voffB); PG8_STAGE(PG8_SB(0, 1), b2 + hsB, voffB); PG8_STAGE(PG8_SA(0, 0), a2, voffA);
            PG8_WAIT_V(8); PG8_WAIT_L(0); PG8_BAR; PG8_MMA(1, 0, At, B0); PG8_MMA(1, 1, At, B1); PG8_BAR; PG8_SCHED;
            PG8_LDB(B0, 1, 0); PG8_LDB(B1, 1, 1); PG8_SCHED; PG8_LDA(At, 1, 0); PG8_STAGE(PG8_SA(0, 1), a2 + hsA, voffA);
            PG8_WAIT_V(8); PG8_WAIT_L(0); PG8_BAR; PG8_MMA(0, 0, At, B0); PG8_MMA(0, 1, At, B1); PG8_BAR; PG8_SCHED;
            PG8_LDA(At, 1, 1); PG8_STAGE(PG8_SB(1, 0), b3, voffB); PG8_STAGE(PG8_SB(1, 1), b3 + hsB, voffB); PG8_STAGE(PG8_SA(1, 0), a3, voffA);
            PG8_WAIT_V(8); PG8_WAIT_L(0); PG8_BAR; PG8_MMA(1, 0, At, B0); PG8_MMA(1, 1, At, B1); PG8_BAR; PG8_SCHED;
            } else {
            PG8_LDB(B0, 0, 0); PG8_SCHED; PG8_LDA(At, 0, 0); PG8_STAGE(PG8_SA(1, 1), a1 + hsA, voffA);
            PG8_WAIT_L(8); PG8_BAR; PG8_WAIT_L(0); PG8_MMA(0, 0, At, B0); PG8_BAR; PG8_SCHED;
            PG8_LDB(B1, 0, 1); PG8_STAGE(PG8_SB(0, 0), b2, voffB);
            PG8_BAR; PG8_WAIT_L(0); PG8_MMA(0, 1, At, B1); PG8_BAR;
            PG8_LDA(At, 0, 1); PG8_STAGE(PG8_SA(0, 0), a2, voffA);
            PG8_BAR; PG8_WAIT_L(0); PG8_MMA(1, 0, At, B0); PG8_BAR; PG8_SCHED;
            PG8_STAGE(PG8_SB(0, 1), b2 + hsB, voffB);
            PG8_WAIT_V(6); PG8_BAR; PG8_MMA(1, 1, At, B1); PG8_BAR;
            PG8_LDB(B0, 1, 0); PG8_SCHED; PG8_LDA(At, 1, 0); PG8_STAGE(PG8_SA(0, 1), a2 + hsA, voffA);
            PG8_WAIT_L(8); PG8_BAR; PG8_WAIT_L(0); PG8_MMA(0, 0, At, B0); PG8_BAR; PG8_SCHED;
            PG8_LDB(B1, 1, 1); PG8_STAGE(PG8_SB(1, 0), b3, voffB);
            PG8_BAR; PG8_WAIT_L(0); PG8_MMA(0, 1, At, B1); PG8_BAR;
            PG8_LDA(At, 1, 1); PG8_STAGE(PG8_SA(1, 0), a3, voffA);
            PG8_BAR; PG8_WAIT_L(0); PG8_MMA(1, 0, At, B0); PG8_BAR; PG8_SCHED;
            PG8_STAGE(PG8_SB(1, 1), b3 + hsB, voffB);
            PG8_WAIT_V(6); PG8_BAR; PG8_MMA(1, 1, At, B1); PG8_BAR;
            }
        }
        if constexpr (ALIGN_EPI) { if (wr == 0) PG8_BAR; }
        if constexpr (!Epi::AFTER_DRAIN) { E(acc, cur, wr, wc, fr, fq); S.done(cur); }
        if (!has_next) break;
#pragma unroll
        for (int a = 0; a < 2; ++a)
#pragma unroll
            for (int b = 0; b < 2; ++b)
#pragma unroll
                for (int m = 0; m < 4; ++m)
#pragma unroll
                    for (int n = 0; n < 2; ++n) acc[a][b][m][n] = (f32x4){0.f, 0.f, 0.f, 0.f};
        cur = nxt; cA = nA; cB = nB; ++ui;
        if constexpr (ALIGN_EPI) { if (wr == 1) PG8_BAR; }
    }
    PG8_WAIT_V(0);
    if constexpr (!ALIGN_EPI) { if (wr == 0) PG8_BAR; }
    PG8_BAR;
#undef PG8_SA
#undef PG8_SB
#undef PG8_STAGE
#undef PG8_LDA
#undef PG8_LDB
#undef PG8_MMA
#undef PG8_WAIT_V
#undef PG8_WAIT_L
#undef PG8_BAR
#undef PG8_SCHED
}
}

constexpr int NWAVES = 8;
constexpr int D = 4096, SEQ = 4096, NB = 2, NMETA = 16, FF = 11008, INC = 12288, HW = 2048, LW = 2048;
constexpr int MR = NB * SEQ;
constexpr int MT = MR + NMETA;
constexpr float EPS = 1e-6f;

constexpr size_t MiB = 1u << 20;
constexpr size_t WS_CTL = 0, CTL_ZERO_BYTES = 32768;
constexpr size_t WS_WGU1 = 1 * MiB;
constexpr size_t WS_WD1  = WS_WGU1 + 172 * MiB;
constexpr size_t WS_WIN  = WS_WD1 + 86 * MiB;
constexpr size_t WS_WOUT = WS_WIN + 96 * MiB;
constexpr size_t WS_WGU2 = WS_WOUT + 32 * MiB;
constexpr size_t WS_WD2  = WS_WGU2 + 172 * MiB;
constexpr size_t WS_WLRU = WS_WD2 + 86 * MiB;
constexpr size_t WS_U    = WS_WLRU + 2 * MiB;
constexpr size_t WS_BIG  = WS_U + 65 * MiB;
constexpr size_t WS_F    = WS_BIG + 193 * MiB;
constexpr size_t WS_HG   = WS_F + 130 * MiB;
constexpr size_t WS_HG2  = WS_HG + 32 * MiB;
constexpr size_t WS_HD   = WS_HG2 + 32 * MiB;
constexpr size_t WS_LC   = WS_HD + 1 * MiB;
constexpr size_t WS_HLOC = WS_LC + 1 * MiB;
constexpr size_t WS_ACUM = WS_HLOC + 32 * MiB;
constexpr size_t WS_Y    = WS_ACUM + 32 * MiB;
constexpr size_t WS_HB   = WS_Y + 64 * MiB;
constexpr size_t WS_END  = WS_HB + 64 * MiB;
static_assert((size_t)MT * INC * 2 <= 193 * MiB && (size_t)MT * D * 4 <= 130 * MiB && (size_t)MT * D * 2 <= 65 * MiB, "ws map");
constexpr int CW_BAR = 4096;

constexpr int RING_OFF = 0, RING_BYTES = 131072;
constexpr int LDS_BYTES = 163840;
constexpr int LDSCTL_OFF = LDS_BYTES - 1024, MISC_OFF = LDSCTL_OFF + 320;

#define GAS __attribute__((address_space(1)))
#define LAS __attribute__((address_space(3)))
typedef unsigned short bf16;
typedef unsigned v4u __attribute__((ext_vector_type(4)));
typedef unsigned v2u __attribute__((ext_vector_type(2)));
typedef float f32x4 __attribute__((ext_vector_type(4)));
typedef short bf16x8 __attribute__((ext_vector_type(8)));
typedef GAS unsigned gu32;
#define RLX_AGENT __ATOMIC_RELAXED, __HIP_MEMORY_SCOPE_AGENT
#define LDS_WAIT() asm volatile("s_waitcnt lgkmcnt(0)" ::: "memory")
#define VM_WAIT() asm volatile("s_waitcnt vmcnt(0)" ::: "memory")
__device__ __forceinline__ unsigned f2bf(float f) { unsigned u = __builtin_bit_cast(unsigned, f); return (u + 0x7fffu + ((u >> 16) & 1u)) >> 16; }
typedef float f32x2_t __attribute__((ext_vector_type(2)));
typedef __bf16 bf16x2_t __attribute__((ext_vector_type(2)));
__device__ __forceinline__ unsigned pk2(float lo, float hi) { const f32x2_t v = {lo, hi}; const bf16x2_t b = __builtin_convertvector(v, bf16x2_t); return __builtin_bit_cast(unsigned, b); }
__device__ __forceinline__ bf16 f2bf16(float x) { return (bf16)(pk2(x, x) & 0xffffu); }
__device__ __forceinline__ float bflo(unsigned w) { return __uint_as_float(w << 16); }
__device__ __forceinline__ float bfhi(unsigned w) { return __uint_as_float(w & 0xffff0000u); }
__device__ __forceinline__ float bf2f(bf16 v) { return __uint_as_float(((unsigned)v) << 16); }

#define XB_TMO      128
#define XB_XCNT(j)  (256  + 64 * (j))
#define XB_XSUB(j)  (1280 + 64 * (j))
#define XB_XGEN(j)  (2304 + 64 * (j))
#define XB_TOP      3328
#define XB_TOPGEN   3392
#define XCD_BAR_WORDS 3456
#define XB_SPIN_CAP (1u << 18)

__device__ __forceinline__ unsigned xb_ld(unsigned* p)              { return __hip_atomic_load(p, __ATOMIC_RELAXED, __HIP_MEMORY_SCOPE_AGENT); }
__device__ __forceinline__ unsigned xb_add(unsigned* p, unsigned v) { return __hip_atomic_fetch_add(p, v, __ATOMIC_RELAXED, __HIP_MEMORY_SCOPE_AGENT); }
__device__ __forceinline__ unsigned xb_xcc_id() { return (unsigned)__builtin_amdgcn_s_getreg((3 << 11) | 20) & 0xFu; }
#define XB_SPIN(cond, bar) do { unsigned _sp = 0; while (cond) { __builtin_amdgcn_s_sleep(1); \
    if ((++_sp & 255u) == 0u) { if (xb_ld(&(bar)[XB_TMO])) break; if (_sp > XB_SPIN_CAP) { atomicAdd(&(bar)[XB_TMO], 1u); break; } } } } while (0)

struct XcdBarrier {
    unsigned* bar; unsigned x;
    volatile LAS unsigned* st;
};
__device__ __forceinline__ XcdBarrier xcd_barrier_post(unsigned* bar, volatile LAS unsigned* st) {
    XcdBarrier b; b.bar = bar; b.x = xb_xcc_id(); b.st = st;
    if (threadIdx.x == 0) (void)xb_add(&bar[XB_XCNT(b.x)], 1u);
    return b;
}
__device__ __forceinline__ void xcd_barrier_complete(unsigned* bar, unsigned x, unsigned& nloc, unsigned& nx) {
    const unsigned G = gridDim.x * gridDim.y * gridDim.z;
    unsigned sum, cnt, mine, sp = 0u;
    for (;;) {
        sum = 0u; cnt = 0u; mine = 0u;
#pragma unroll
        for (unsigned j = 0; j < 16; ++j) { const unsigned c = xb_ld(&bar[XB_XCNT(j)]); sum += c; cnt += (c > 0u) ? 1u : 0u; mine = (j == x) ? c : mine; }
        if (sum == G) break;
        __builtin_amdgcn_s_sleep(1);
        if ((++sp & 255u) == 0u) { if (xb_ld(&bar[XB_TMO])) break; if (sp > XB_SPIN_CAP) { atomicAdd(&bar[XB_TMO], 1u); break; } }
    }
    nloc = mine > 0u ? mine : 1u; nx = cnt > 0u ? cnt : 1u;
}
__device__ __forceinline__ void xcd_barrier(const XcdBarrier& b) {
    asm volatile("s_waitcnt vmcnt(0)" ::: "memory");
    __syncthreads();
    if (threadIdx.x == 0) {
        unsigned* bar = b.bar;
        __builtin_amdgcn_s_waitcnt(0);
        unsigned nloc = b.st[0], nx = b.st[1];
        if (nloc == 0u) { xcd_barrier_complete(bar, b.x, nloc, nx); b.st[0] = nloc; b.st[1] = nx; }
        const unsigned old = xb_add(&bar[XB_XSUB(b.x)], 1u);
        const unsigned gen = old / nloc;
        if (old + 1u == (gen + 1u) * nloc) {
            __builtin_amdgcn_fence(__ATOMIC_RELEASE, "agent");
            asm volatile("s_waitcnt vmcnt(0)" ::: "memory");
            const unsigned og = xb_add(&bar[XB_TOP], 1u);
            const unsigned tg = og / nx;
            if (og + 1u == (tg + 1u) * nx) xb_add(&bar[XB_TOPGEN], 1u);
            else XB_SPIN(xb_ld(&bar[XB_TOPGEN]) == tg, bar);
            __builtin_amdgcn_fence(__ATOMIC_ACQUIRE, "agent");
            xb_add(&bar[XB_XGEN(b.x)], 1u);
            asm volatile("s_waitcnt vmcnt(0)" ::: "memory");
        } else {
            XB_SPIN(xb_ld(&bar[XB_XGEN(b.x)]) == gen, bar);
            __builtin_amdgcn_fence(__ATOMIC_ACQUIRE, "agent");
            asm volatile("s_waitcnt vmcnt(0)" ::: "memory");
        }
    }
    __syncthreads();
}


struct Frame {
    LAS unsigned char* lds;
    volatile LAS unsigned* MISC;
    gu32* ctl;
    int tid, lane, wave;
    int vcu, G;
};

__device__ __forceinline__ int opaque_lane() { int l; asm volatile("v_mbcnt_lo_u32_b32 %0, -1, 0\n\tv_mbcnt_hi_u32_b32 %0, -1, %0" : "=v"(l)); return l; }
#define opaque_tid() ((F.wave << 6) + opaque_lane())
__device__ __forceinline__ float wave_sum(float v) {
#pragma unroll
    for (int o = 1; o < 64; o <<= 1) v += __shfl_xor(v, o);
    return v;
}
__device__ __forceinline__ float sigmoidf_(float x) { return __builtin_amdgcn_rcpf(1.0f + __builtin_amdgcn_exp2f(-1.44269504089f * x)); }
__device__ __forceinline__ float siluf_(float x) { return x * sigmoidf_(x); }
__device__ __forceinline__ float gelu_tanh(float x) { const float z = 0.7978845608028654f * (x + 0.044715f * x * x * x); const float t = __builtin_amdgcn_exp2f(2.88539008178f * z); return x * (1.0f - __builtin_amdgcn_rcpf(t + 1.0f)); }

constexpr int TP = 65;
__device__ __forceinline__ void p0_item_load(f32x4 (&v)[16], const float* W, int N, int k0, int n0, int lane) {
    const int rq = lane >> 4, cq = 4 * (lane & 15);
#pragma unroll
    for (int i = 0; i < 16; ++i) v[i] = __builtin_nontemporal_load((const GAS f32x4*)(W + (size_t)(k0 + 4 * i + rq) * N + n0 + cq));
}
__device__ __forceinline__ void p0_item_store(const f32x4 (&v)[16], bf16* WT, int ldo, int out_row0, int k0, LAS float* scr, int lane) {
    const int rq = lane >> 4, cq = 4 * (lane & 15);
#pragma unroll
    for (int i = 0; i < 16; ++i) { LAS float* d = scr + (4 * i + rq) * TP + cq; d[0] = v[i].x; d[1] = v[i].y; d[2] = v[i].z; d[3] = v[i].w; }
    LDS_WAIT(); asm volatile("" ::: "memory");
    const int c = lane & 7;
#pragma unroll
    for (int j = 0; j < 8; ++j) { const int n = (lane >> 3) + 8 * j; const LAS float* sp = scr + (8 * c) * TP + n;
        v4u o; o.x = pk2(sp[0 * TP], sp[1 * TP]); o.y = pk2(sp[2 * TP], sp[3 * TP]); o.z = pk2(sp[4 * TP], sp[5 * TP]); o.w = pk2(sp[6 * TP], sp[7 * TP]);
        __builtin_nontemporal_store(o, (GAS v4u*)(WT + (size_t)(out_row0 + n) * ldo + k0 + 8 * c)); }
    LDS_WAIT(); asm volatile("" ::: "memory");
}
__device__ __forceinline__ void p0_item_store_blk(const f32x4 (&v)[16], bf16* WT, int K, int out_row0, int k0, LAS float* scr, int lane) {
    const int rq = lane >> 4, cq = 4 * (lane & 15);
#pragma unroll
    for (int i = 0; i < 16; ++i) { LAS float* d = scr + (4 * i + rq) * TP + cq; d[0] = v[i].x; d[1] = v[i].y; d[2] = v[i].z; d[3] = v[i].w; }
    LDS_WAIT(); asm volatile("" ::: "memory");
    const int bi = lane >> 2, ch = lane & 3;
#pragma unroll
    for (int s8 = 0; s8 < 8; ++s8) { const int rbl = s8 >> 1, kbl = s8 & 1; const int n = 32 * (rbl >> 1) + 8 * (bi >> 2) + 4 * (rbl & 1) + (bi & 3);
        const LAS float* sa = scr + (32 * kbl + 8 * ch + 4 * (ch & 1)) * TP + n; const LAS float* sb = scr + (32 * kbl + 8 * ch + 4 - 4 * (ch & 1)) * TP + n;
        const unsigned p0 = pk2(sa[0 * TP], sa[1 * TP]), p1 = pk2(sa[2 * TP], sa[3 * TP]), p2 = pk2(sb[0 * TP], sb[1 * TP]), p3 = pk2(sb[2 * TP], sb[3 * TP]);
        const bool od = ch & 1; v4u o; o.x = od ? p2 : p0; o.y = od ? p3 : p1; o.z = od ? p0 : p2; o.w = od ? p1 : p3;
        *(GAS v4u*)(WT + ((size_t)((out_row0 >> 4) + rbl) * (K >> 5) + (k0 >> 5) + kbl) * 512 + bi * 32 + 8 * ch) = o; }
    LDS_WAIT(); asm volatile("" ::: "memory");
}
__device__ __forceinline__ void p0_transpose_matrix(const float* W, int K, int N, bf16* WT, int mode, int row_base, LAS float* scr, int gw, int NGW, int lane) {
    const int nblk = N / 64, nitems = (K / 64) * nblk;
    int it = gw; if (it >= nitems) return;
    f32x4 v[16], w[16];
    p0_item_load(v, W, N, 64 * (it / nblk), 64 * (it % nblk), lane);
    for (;;) {
        const int nx = it + NGW; const bool more = nx < nitems;
        if (more) p0_item_load(w, W, N, 64 * (nx / nblk), 64 * (nx % nblk), lane);
        { const int n0 = 64 * (it % nblk); const int r0 = row_base + (mode == 0 ? n0 : (256 * (n0 >> 7) + (n0 & 127) + (mode == 2 ? 128 : 0)));
          p0_item_store(v, WT, K, r0, 64 * (it / nblk), scr, lane); }
        if (!more) break;
#pragma unroll
        for (int i = 0; i < 16; ++i) v[i] = w[i];
        it = nx;
    }
}

struct Args { const float* in[26]; float* out; unsigned char* ws; };
struct P0Item { const float* W; bf16* WT; int K, N, mode, row_base, local; };
constexpr int P0_FFN = (D / 64) * (FF / 64), P0_IN = (D / 64) * (INC / 64), P0_OUT = (D / 64) * (D / 64), P0_LRU = 16 * 16;
constexpr int P0_TOTAL = 6 * P0_FFN + P0_IN + P0_OUT + P0_LRU;
__device__ __forceinline__ P0Item p0_decode(int g, const Args& args, bf16* WGU1, bf16* WD1, bf16* WIN, bf16* WOUT, bf16* WGU2, bf16* WD2, bf16* WLRU) {
    P0Item t;
    if (g < P0_FFN)               { t.W = args.in[3];  t.WT = WGU1; t.K = D;  t.N = FF;  t.mode = 1; t.row_base = 0; t.local = g; return t; } g -= P0_FFN;
    if (g < P0_FFN)               { t.W = args.in[4];  t.WT = WGU1; t.K = D;  t.N = FF;  t.mode = 2; t.row_base = 0; t.local = g; return t; } g -= P0_FFN;
    if (g < P0_FFN)               { t.W = args.in[5];  t.WT = WD1;  t.K = FF; t.N = D;   t.mode = 0; t.row_base = 0; t.local = g; return t; } g -= P0_FFN;
    if (g < P0_IN)                { t.W = args.in[8];  t.WT = WIN;  t.K = D;  t.N = INC; t.mode = 0; t.row_base = 0; t.local = g; return t; } g -= P0_IN;
    if (g < P0_OUT)               { t.W = args.in[19]; t.WT = WOUT; t.K = D;  t.N = D;   t.mode = 0; t.row_base = 0; t.local = g; return t; } g -= P0_OUT;
    if (g < P0_FFN)               { t.W = args.in[22]; t.WT = WGU2; t.K = D;  t.N = FF;  t.mode = 1; t.row_base = 0; t.local = g; return t; } g -= P0_FFN;
    if (g < P0_FFN)               { t.W = args.in[23]; t.WT = WGU2; t.K = D;  t.N = FF;  t.mode = 2; t.row_base = 0; t.local = g; return t; } g -= P0_FFN;
    if (g < P0_FFN)               { t.W = args.in[24]; t.WT = WD2;  t.K = FF; t.N = D;   t.mode = 0; t.row_base = 0; t.local = g; return t; } g -= P0_FFN;
    { const int hd = g >> 5, which = (g >> 4) & 1; t.W = (which ? args.in[15] : args.in[13]) + (size_t)hd * 65536; t.WT = WLRU; t.K = 256; t.N = 256; t.mode = 1 + which; t.row_base = 512 * hd; t.local = g & 15; return t; }
}
__device__ __forceinline__ void p0_convert_all(const Args& args, bf16* WGU1, bf16* WD1, bf16* WIN, bf16* WOUT, bf16* WGU2, bf16* WD2, bf16* WLRU, LAS float* scr, int gw, int NGW, int lane) {
    int it = gw; if (it >= P0_TOTAL) return;
    f32x4 v[16], w[16];
    P0Item cur = p0_decode(it, args, WGU1, WD1, WIN, WOUT, WGU2, WD2, WLRU), nxt = cur;
    { const int nnb = cur.N / 64; p0_item_load(v, cur.W, cur.N, 64 * (cur.local / nnb), 64 * (cur.local % nnb), lane); }
    for (;;) {
        const int nx = it + NGW; const bool more = nx < P0_TOTAL;
        if (more) { nxt = p0_decode(nx, args, WGU1, WD1, WIN, WOUT, WGU2, WD2, WLRU); const int nnb = nxt.N / 64; p0_item_load(w, nxt.W, nxt.N, 64 * (nxt.local / nnb), 64 * (nxt.local % nnb), lane); }
        { const int nnb = cur.N / 64, n0 = 64 * (cur.local % nnb); const int r0 = cur.row_base + (cur.mode == 0 ? n0 : (256 * (n0 >> 7) + (n0 & 127) + (cur.mode == 2 ? 128 : 0)));
          if (cur.K == 256) p0_item_store(v, cur.WT, cur.K, r0, 64 * (cur.local / nnb), scr, lane);
          else p0_item_store_blk(v, cur.WT, cur.K, r0, 64 * (cur.local / nnb), scr, lane); }
        if (!more) break;
#pragma unroll
        for (int i = 0; i < 16; ++i) v[i] = w[i];
        cur = nxt; it = nx;
    }
}

__device__ __forceinline__ size_t blk_off(int m, int c, int Kd) { return (((size_t)(m >> 4) * (Kd >> 5) + (c >> 5)) << 9) + ((m & 15) << 5) + (c & 31); }
__device__ __forceinline__ void rms_row_to_bf16(const float* xrow, const float* gain, bf16* Ub, int m, int lane) {
    f32x4 v[16]; float s = 0.f;
#pragma unroll
    for (int j = 0; j < 8; ++j) { const GAS f32x4* xp = (const GAS f32x4*)(xrow + 8 * (lane + 64 * j)); v[2 * j] = xp[0]; v[2 * j + 1] = xp[1]; }
#pragma unroll
    for (int j = 0; j < 16; ++j) s += (v[j].x * v[j].x + v[j].y * v[j].y) + (v[j].z * v[j].z + v[j].w * v[j].w);
    const float rs = __builtin_amdgcn_rsqf(wave_sum(s) * (1.f / D) + EPS);
#pragma unroll
    for (int j = 0; j < 8; ++j) { const GAS f32x4* gp = (const GAS f32x4*)(gain + 8 * (lane + 64 * j)); const f32x4 g0 = gp[0], g1 = gp[1], a = v[2 * j], b = v[2 * j + 1];
        v4u w; w.x = pk2(a.x * rs * g0.x, a.y * rs * g0.y); w.y = pk2(a.z * rs * g0.z, a.w * rs * g0.w); w.z = pk2(b.x * rs * g1.x, b.y * rs * g1.y); w.w = pk2(b.z * rs * g1.z, b.w * rs * g1.w);
        *(GAS v4u*)(Ub + (size_t)m * D + 8 * (lane + 64 * j)) = w; }
}

__device__ __forceinline__ void unpack8(const v4u w, f32x4& a, f32x4& b) { a = (f32x4){bflo(w.x), bfhi(w.x), bflo(w.y), bfhi(w.y)}; b = (f32x4){bflo(w.z), bfhi(w.z), bflo(w.w), bfhi(w.w)}; }
template <int HMODE>
__device__ __forceinline__ void norm_rows(const bf16* f, const float* hin_real, const float* hin_meta, const bf16* hin_b, bf16* hout_b, float* hout_f, bf16* uout, const float* gpost, const float* gpre, float coef, int nrows, int gw, int NGW) {
    int lane = opaque_lane();
    for (int row = gw; row < nrows; row += NGW) {
        asm volatile("" : "+v"(lane));
        const size_t ro = (size_t)row * D + 8 * lane;
        f32x4 v[16]; float s = 0.f;
#pragma unroll
        for (int j = 0; j < 8; ++j) { const v4u w = *(const GAS v4u*)(f + ro + 512 * j); unpack8(w, v[2 * j], v[2 * j + 1]); }
#pragma unroll
        for (int j = 0; j < 16; ++j) s += (v[j].x * v[j].x + v[j].y * v[j].y) + (v[j].z * v[j].z + v[j].w * v[j].w);
        const float rs = coef * __builtin_amdgcn_rsqf(wave_sum(s) * (1.f / D) + EPS);
        float s2 = 0.f;
#pragma unroll
        for (int j = 0; j < 8; ++j) { const GAS f32x4* gp = (const GAS f32x4*)(gpost + 8 * lane + 512 * j); const f32x4 g0 = gp[0], g1 = gp[1]; f32x4 h0, h1;
            if (HMODE == 0) { const GAS f32x4* hp = (const GAS f32x4*)((row < MR ? hin_real + (size_t)row * D : hin_meta + (size_t)(row - MR) * D) + 8 * lane + 512 * j); h0 = hp[0]; h1 = hp[1]; }
            else { const v4u hw = *(const GAS v4u*)(hin_b + ro + 512 * j); unpack8(hw, h0, h1); }
            v[2 * j] = h0 + v[2 * j] * rs * g0; v[2 * j + 1] = h1 + v[2 * j + 1] * rs * g1; }
#pragma unroll
        for (int j = 0; j < 16; ++j) s2 += (v[j].x * v[j].x + v[j].y * v[j].y) + (v[j].z * v[j].z + v[j].w * v[j].w);
        if (HMODE == 2) {
#pragma unroll
            for (int j = 0; j < 8; ++j) { GAS f32x4* op = (GAS f32x4*)(hout_f + ro + 512 * j); op[0] = v[2 * j]; op[1] = v[2 * j + 1]; }
        } else if (row < MR) {
#pragma unroll
            for (int j = 0; j < 8; ++j) { const f32x4 a = v[2 * j], b = v[2 * j + 1]; v4u w; w.x = pk2(a.x, a.y); w.y = pk2(a.z, a.w); w.z = pk2(b.x, b.y); w.w = pk2(b.z, b.w); *(GAS v4u*)(hout_b + ro + 512 * j) = w; } }
        if (uout != nullptr) { const float rs2 = __builtin_amdgcn_rsqf(wave_sum(s2) * (1.f / D) + EPS);
#pragma unroll
            for (int j = 0; j < 8; ++j) { const GAS f32x4* gp = (const GAS f32x4*)(gpre + 8 * lane + 512 * j); const f32x4 g0 = gp[0], g1 = gp[1], a = v[2 * j], b = v[2 * j + 1];
                v4u w; w.x = pk2(a.x * rs2 * g0.x, a.y * rs2 * g0.y); w.y = pk2(a.z * rs2 * g0.z, a.w * rs2 * g0.w); w.z = pk2(b.x * rs2 * g1.x, b.y * rs2 * g1.y); w.w = pk2(b.z * rs2 * g1.z, b.w * rs2 * g1.w);
                *(GAS v4u*)(uout + ro + 512 * j) = w; } }
    }
}

#define MFMA_SETTLE1(a) asm volatile("s_nop 7\n\ts_nop 7" : "+v"(a))
#define MFMA_SETTLE2(a, b) asm volatile("s_nop 7\n\ts_nop 7" : "+v"(a), "+v"(b))
#define MFMA_SETTLE4(a, b, c, d) asm volatile("s_nop 7\n\ts_nop 7" : "+v"(a), "+v"(b), "+v"(c), "+v"(d))
#define MFMA_SETTLE8(a, b, c, d, e, f, g, h) asm volatile("s_nop 7\n\ts_nop 7" : "+v"(a), "+v"(b), "+v"(c), "+v"(d), "+v"(e), "+v"(f), "+v"(g), "+v"(h))
template <int NACC, int T, class Map, class Epi>
__device__ __forceinline__ void skinny_phase(Frame& F, const bf16* A, int lda, const bf16* Bt, int ldb, int K, int ntiles, const Map& mp, const Epi& epi) {
    LAS f32x4* red = (LAS f32x4*)(F.lds + RING_OFF);
    const int lane = opaque_lane();
    const int ks = K / 8, k_lo = F.wave * ks, r = lane & 15, q = lane >> 4;
    const int rot = 32 * (int)((blockIdx.x * 7u + F.wave * 3u) % (unsigned)(ks / 32));
    for (int t0 = blockIdx.x; t0 < ntiles; t0 += F.G * T) {
        int brow[T][NACC], acol = 0; bool valid[T];
#pragma unroll
        for (int j = 0; j < T; ++j) { const int tj = t0 + j * F.G; valid[j] = tj < ntiles; mp(valid[j] ? tj : t0, brow[j], acol); }
        f32x4 acc[T][NACC];
#pragma unroll
        for (int j = 0; j < T; ++j)
#pragma unroll
            for (int i = 0; i < NACC; ++i) acc[j][i] = (f32x4){0.f, 0.f, 0.f, 0.f};
        const bf16* ap = lda == 0 ? A + (((size_t)(MR >> 4) * (K >> 5) + (k_lo >> 5)) << 9) + r * 32 + 8 * q : A + (size_t)(MR + r) * lda + k_lo + 8 * q;
        const int astep = lda == 0 ? 16 : 1;
        const bf16* bp[T][NACC];
#pragma unroll
        for (int j = 0; j < T; ++j)
#pragma unroll
            for (int i = 0; i < NACC; ++i) bp[j][i] = Bt + ((size_t)brow[j][i] * (K >> 5) + (k_lo >> 5)) * 512 + r * 32 + 8 * q;
        constexpr int UNR = (NACC * T <= 3) ? 8 : 4;
#pragma unroll UNR
        for (int k0 = 0; k0 < ks; k0 += 32) {
            int k = k0 + rot; k = k >= ks ? k - ks : k;
            const bf16x8 a = *(const GAS bf16x8*)(ap + k * astep);
#pragma unroll
            for (int j = 0; j < T; ++j) if (valid[j])
#pragma unroll
                for (int i = 0; i < NACC; ++i) { const bf16x8 b = *(const GAS bf16x8*)(bp[j][i] + k * 16); acc[j][i] = __builtin_amdgcn_mfma_f32_16x16x32_bf16(b, a, acc[j][i], 0, 0, 0); }
        }
#pragma unroll
        for (int j = 0; j < T; ++j)
#pragma unroll
            for (int i = 0; i < NACC; ++i) MFMA_SETTLE1(acc[j][i]);
#pragma unroll
        for (int j = 0; j < T; ++j)
#pragma unroll
            for (int i = 0; i < NACC; ++i) red[((F.wave * T + j) * NACC + i) * 64 + lane] = acc[j][i];
        LDS_WAIT(); __syncthreads();
#pragma unroll
        for (int j = 0; j < T; ++j) if (F.wave == j && valid[j]) {
            f32x4 sred[NACC];
#pragma unroll
            for (int i = 0; i < NACC; ++i) { sred[i] = red[(j * NACC + i) * 64 + lane];
#pragma unroll
                for (int w = 1; w < 8; ++w) sred[i] += red[((w * T + j) * NACC + i) * 64 + lane]; }
            epi(t0 + j * F.G, r, q, sred);
        }
        __syncthreads();
    }
}
struct MapPlain { __device__ __forceinline__ void operator()(int tile, int (&brow)[1], int& acol) const { brow[0] = tile; acol = 0; } };
struct MapGateUp { __device__ __forceinline__ void operator()(int tile, int (&brow)[2], int& acol) const { const int j0 = 32 * (tile >> 1); brow[0] = ((256 * (j0 >> 7) + (j0 & 127)) >> 4) + (tile & 1); brow[1] = brow[0] + 8; acol = 0; } };
struct MapLru { __device__ __forceinline__ void operator()(int tile, int (&brow)[2], int& acol) const { const int c0 = 16 * tile, head = c0 >> 8, w = c0 & 255; brow[0] = 256 * (2 * head + (w >> 7)) + (w & 127); brow[1] = brow[0] + 128; acol = head * 256; } };
struct SkEpiSwiGLU { bf16* O; __device__ __forceinline__ void operator()(int tile, int r, int q, const f32x4 (&s)[2]) const {
    v2u w; w.x = pk2(siluf_(s[0][0]) * s[1][0], siluf_(s[0][1]) * s[1][1]); w.y = pk2(siluf_(s[0][2]) * s[1][2], siluf_(s[0][3]) * s[1][3]);
    *(GAS v2u*)(O + ((((size_t)(MR >> 4)) * (FF >> 5) + (tile >> 1)) << 9) + r * 32 + 8 * q + 4 * (tile & 1)) = w; } };
struct SkEpiF32 { float* C; int ldc; __device__ __forceinline__ void operator()(int tile, int r, int q, const f32x4 (&s)[1]) const { *(GAS f32x4*)(C + (size_t)(MR + r) * ldc + 16 * tile + 4 * q) = s[0]; } };
struct SkEpiBf16 { bf16* O; int ldc; __device__ __forceinline__ void operator()(int tile, int r, int q, const f32x4 (&s)[1]) const {
    v2u w; w.x = pk2(s[0][0], s[0][1]); w.y = pk2(s[0][2], s[0][3]); *(GAS v2u*)(O + (size_t)(MR + r) * ldc + 32 * (tile >> 1) + 8 * q + 4 * (tile & 1)) = w; } };
struct SkEpiLru { float* Aout; float* Dout; const bf16* XC; const float* b_a; const float* b_x; const float* lam;
    __device__ __forceinline__ void operator()(int tile, int r, int q, const f32x4 (&s)[2]) const {
        const int ch = 16 * tile + 4 * q; const size_t ro = (size_t)(MR + r) * LW + ch; const v2u xw = *(const GAS v2u*)(XC + ro);
        const float xv[4] = {bflo(xw.x), bfhi(xw.x), bflo(xw.y), bfhi(xw.y)}; f32x4 av, dv;
#pragma unroll
        for (int e = 0; e < 4; ++e) { float a, d; pg8::lru_gate_math(s[0][e], s[1][e], b_a[ch + e], b_x[ch + e], pg8::softplus_neg(lam[ch + e]), xv[e], a, d); av[e] = a; dv[e] = d; }
        *(GAS f32x4*)(Aout + ro) = av; *(GAS f32x4*)(Dout + ro) = dv; } };

constexpr int HG_PQ = 136, HG_PT = 72;
constexpr int HG_Q = 0, HG_Q0 = HG_Q + 64 * HG_PQ * 2, HG_K = HG_Q0 + 64 * HG_PQ * 2, HG_KT = HG_K + 64 * HG_PQ * 2, HG_VT = HG_KT + 128 * HG_PT * 2,
              HG_P = HG_VT + 128 * HG_PT * 2, HG_ST = HG_P + 64 * HG_PT * 2, HG_PART = HG_ST + 128 * HG_PQ * 2, HG_EL = HG_PART + 8 * 128 * 4, HG_RS = HG_EL + 128 * 4, HG_END = HG_RS + 8 * 64 * 4;
static_assert(HG_END <= LDSCTL_OFF, "HGRN LDS map");
#define WG_SYNC() do { asm volatile("s_waitcnt vmcnt(0) lgkmcnt(0)" ::: "memory"); __builtin_amdgcn_s_barrier(); asm volatile("" ::: "memory"); } while (0)
#define LSYNC() do { asm volatile("s_waitcnt lgkmcnt(0)" ::: "memory"); __builtin_amdgcn_s_barrier(); asm volatile("" ::: "memory"); } while (0)
__device__ __forceinline__ void norm_meta_row(Frame& F, int m, const bf16* f, const float* meta, bf16* uout, const float* gpost, const float* gpre, float coef) {
    const int tid = opaque_tid(); LAS float* red = (LAS float*)F.lds;
    const size_t ro = (size_t)(MR + m) * D + 8 * tid;
    const v4u fw = *(const GAS v4u*)(f + ro);
    const f32x4 h0 = *(const GAS f32x4*)(meta + (size_t)m * D + 8 * tid), h1 = *(const GAS f32x4*)(meta + (size_t)m * D + 8 * tid + 4);
    const f32x4 g0 = *(const GAS f32x4*)(gpost + 8 * tid), g1 = *(const GAS f32x4*)(gpost + 8 * tid + 4), p0 = *(const GAS f32x4*)(gpre + 8 * tid), p1 = *(const GAS f32x4*)(gpre + 8 * tid + 4);
    float fv[8] = {bflo(fw.x), bfhi(fw.x), bflo(fw.y), bfhi(fw.y), bflo(fw.z), bfhi(fw.z), bflo(fw.w), bfhi(fw.w)};
    float s1 = 0.f;
#pragma unroll
    for (int e = 0; e < 8; ++e) s1 += fv[e] * fv[e];
    s1 = wave_sum(s1); if ((tid & 63) == 0) red[F.wave] = s1;
    WG_SYNC();
    float t1 = 0.f;
#pragma unroll
    for (int w = 0; w < 8; ++w) t1 += red[w];
    const float rs = coef * __builtin_amdgcn_rsqf(t1 * (1.f / D) + EPS);
    const float hv[8] = {h0.x + fv[0] * rs * g0.x, h0.y + fv[1] * rs * g0.y, h0.z + fv[2] * rs * g0.z, h0.w + fv[3] * rs * g0.w, h1.x + fv[4] * rs * g1.x, h1.y + fv[5] * rs * g1.y, h1.z + fv[6] * rs * g1.z, h1.w + fv[7] * rs * g1.w};
    float s2 = 0.f;
#pragma unroll
    for (int e = 0; e < 8; ++e) s2 += hv[e] * hv[e];
    s2 = wave_sum(s2); if ((tid & 63) == 0) red[8 + F.wave] = s2;
    WG_SYNC();
    float t2 = 0.f;
#pragma unroll
    for (int w = 0; w < 8; ++w) t2 += red[8 + w];
    const float rs2 = __builtin_amdgcn_rsqf(t2 * (1.f / D) + EPS);
    v4u o; o.x = pk2(hv[0] * rs2 * p0.x, hv[1] * rs2 * p0.y); o.y = pk2(hv[2] * rs2 * p0.z, hv[3] * rs2 * p0.w); o.z = pk2(hv[4] * rs2 * p1.x, hv[5] * rs2 * p1.y); o.w = pk2(hv[6] * rs2 * p1.z, hv[7] * rs2 * p1.w);
    *(GAS v4u*)(uout + ro) = o;
    WG_SYNC();
}

typedef LAS unsigned char* ldsp;
__device__ __forceinline__ bf16x8 lds_frag(ldsp base, int row, int pitch, int col) { return *(const LAS bf16x8*)(base + (row * pitch + col) * 2); }

template <bool PASS_C>
__device__ __forceinline__ void hgrn_unit(Frame& F, int unit, const bf16* proj, const float* lbl, const float* gn, float* HG, float* HD, bf16* Y) {
    const int tid = opaque_tid(), lane = tid & 63, w = F.wave, r = lane & 15, q = lane >> 4;
    const int b = unit >> 8, h = (unit >> 4) & 15, c = unit & 15;
    ldsp L = F.lds;
    const int ch0 = 2 * lane;
    const float lb0 = sigmoidf_(lbl[h * 128 + ch0] - lbl[HW + h * 128 + ch0]), lb1 = sigmoidf_(lbl[h * 128 + ch0 + 1] - lbl[HW + h * 128 + ch0 + 1]);
    f32x4 st[8];
    float* Gu = HG + (size_t)unit * 16384;
    if (PASS_C) {
#pragma unroll
        for (int tk = 0; tk < 8; ++tk)
#pragma unroll
            for (int e = 0; e < 4; ++e) st[tk][e] = Gu[(16 * w + 4 * q + e) * 128 + 16 * tk + r];
#pragma unroll
        for (int tk = 0; tk < 8; ++tk)
#pragma unroll
            for (int e = 0; e < 4; ++e) *(LAS bf16*)(L + HG_ST + ((16 * w + 4 * q + e) * HG_PQ + 16 * tk + r) * 2) = f2bf16(st[tk][e]);
    } else {
#pragma unroll
        for (int tk = 0; tk < 8; ++tk) st[tk] = (f32x4){0.f, 0.f, 0.f, 0.f};
    }
    float tl0 = 0.f, tl1 = 0.f;
    const int nch = (c == 0) ? 5 : 4;
    unsigned Lf[8], Lv[8], Lq[8];
#define HG_LOAD(cj) do { const bool mc_ = (c == 0 && (cj) == 0); const size_t r0_ = (size_t)b * SEQ + c * 256 + ((c == 0) ? (cj) - 1 : (cj)) * 64; \
        _Pragma("unroll") for (int i = 0; i < 8; ++i) { const int t = 8 * w + i; const size_t row = mc_ ? (size_t)(MR + (t < 48 ? 0 : t - 48)) : r0_ + t; const bf16* pr = proj + row * INC + h * 128 + ch0; \
            Lf[i] = *(const GAS unsigned*)(pr + HW); Lv[i] = *(const GAS unsigned*)(pr + 2 * HW); if (PASS_C) Lq[i] = *(const GAS unsigned*)pr; } } while (0)
    HG_LOAD(0);
    for (int ci = 0; ci < nch; ++ci) {
        const bool metac = (c == 0 && ci == 0);
        const int s = (c == 0) ? ci - 1 : ci;
        const size_t row0 = (size_t)b * SEQ + c * 256 + s * 64;
        float lc0[8], lc1[8], kk0[8], kk1[8], qa0[8], qa1[8]; unsigned vv[8];
        float run0 = 0.f, run1 = 0.f;
#pragma unroll
        for (int i = 0; i < 8; ++i) { const int t = 8 * w + i; const bool nul = metac && t < 48;
            const unsigned fw = Lf[i]; const unsigned vw = Lv[i];
            const float sg0 = sigmoidf_(bflo(fw)), sg1 = sigmoidf_(bfhi(fw));
            const float l0 = nul ? 0.f : __logf(lb0 + (1.f - lb0) * sg0), l1 = nul ? 0.f : __logf(lb1 + (1.f - lb1) * sg1);
            run0 += l0; run1 += l1; lc0[i] = run0; lc1[i] = run1;
            kk0[i] = nul ? 0.f : (1.f - lb0) * (1.f - sg0); kk1[i] = nul ? 0.f : (1.f - lb1) * (1.f - sg1); vv[i] = nul ? 0u : vw;
            if (PASS_C) { const unsigned qw = Lq[i]; qa0[i] = nul ? 0.f : siluf_(bflo(qw)); qa1[i] = nul ? 0.f : siluf_(bfhi(qw)); } }
        if (ci + 1 < nch) HG_LOAD(ci + 1);
        *(LAS float*)(L + HG_PART + (w * 128 + ch0) * 4) = run0; *(LAS float*)(L + HG_PART + (w * 128 + ch0 + 1) * 4) = run1;
        LSYNC();
        float pre0 = 0.f, pre1 = 0.f, mid0 = 0.f, mid1 = 0.f, last0 = 0.f, last1 = 0.f;
#pragma unroll
        for (int ww = 0; ww < 8; ++ww) { const float p0 = *(LAS float*)(L + HG_PART + (ww * 128 + ch0) * 4), p1 = *(LAS float*)(L + HG_PART + (ww * 128 + ch0 + 1) * 4);
            if (ww < w) { pre0 += p0; pre1 += p1; } if (ww < 4) { mid0 += p0; mid1 += p1; } last0 += p0; last1 += p1; }
        tl0 += last0; tl1 += last1;
        if (w == 0) { *(LAS float*)(L + HG_EL + ch0 * 4) = __expf(last0); *(LAS float*)(L + HG_EL + (ch0 + 1) * 4) = __expf(last1); }
        const float em0 = __expf(mid0), em1 = __expf(mid1), elm0 = __expf(last0 - mid0), elm1 = __expf(last1 - mid1);
        unsigned ktw0[4], ktw1[4], vtw0[4], vtw1[4];
#pragma unroll
        for (int i = 0; i < 8; i += 2) {
            float kl0[2], kl1[2];
#pragma unroll
            for (int j = 0; j < 2; ++j) { const int t = 8 * w + i + j; const float c0 = pre0 + lc0[i + j] - mid0, c1 = pre1 + lc1[i + j] - mid1;
                const float kt0 = kk0[i + j] * __expf(-c0), kt1 = kk1[i + j] * __expf(-c1);
                kl0[j] = kt0 * elm0; kl1[j] = kt1 * elm1;
                if (PASS_C) { const float qt0 = qa0[i + j] * __expf(c0), qt1 = qa1[i + j] * __expf(c1);
                    *(LAS unsigned*)(L + HG_Q + (t * HG_PQ + ch0) * 2) = pk2(qt0, qt1); *(LAS unsigned*)(L + HG_Q0 + (t * HG_PQ + ch0) * 2) = pk2(qt0 * em0, qt1 * em1);
                    *(LAS unsigned*)(L + HG_K + (t * HG_PQ + ch0) * 2) = pk2(kt0, kt1); } }
            ktw0[i >> 1] = pk2(kl0[0], kl0[1]); ktw1[i >> 1] = pk2(kl1[0], kl1[1]);
            vtw0[i >> 1] = (vv[i] & 0xffffu) | (vv[i + 1] << 16); vtw1[i >> 1] = (vv[i] >> 16) | (vv[i + 1] & 0xffff0000u); }
        *(LAS v4u*)(L + HG_KT + (ch0 * HG_PT + 8 * w) * 2) = (v4u){ktw0[0], ktw0[1], ktw0[2], ktw0[3]}; *(LAS v4u*)(L + HG_KT + ((ch0 + 1) * HG_PT + 8 * w) * 2) = (v4u){ktw1[0], ktw1[1], ktw1[2], ktw1[3]};
        *(LAS v4u*)(L + HG_VT + (ch0 * HG_PT + 8 * w) * 2) = (v4u){vtw0[0], vtw0[1], vtw0[2], vtw0[3]}; *(LAS v4u*)(L + HG_VT + ((ch0 + 1) * HG_PT + 8 * w) * 2) = (v4u){vtw1[0], vtw1[1], vtw1[2], vtw1[3]};
        LSYNC();
        const bool do_out = PASS_C && !metac;
        if (do_out) {
            v2u gwp[4];
#pragma unroll
            for (int ti2 = 0; ti2 < 4; ++ti2) gwp[ti2] = *(const GAS v2u*)(proj + (row0 + 16 * ti2 + r) * INC + 3 * HW + h * 128 + 16 * w + 4 * q);
            const int ti = w >> 1;
#pragma unroll
            for (int jj = 0; jj < 2; ++jj) { const int tj = 2 * (w & 1) + jj; f32x4 a4 = (f32x4){0.f, 0.f, 0.f, 0.f};
                if (tj <= ti) {
#pragma unroll
                    for (int ks = 0; ks < 4; ++ks) a4 = __builtin_amdgcn_mfma_f32_16x16x32_bf16(lds_frag(L + HG_K, 16 * tj + r, HG_PQ, 32 * ks + 8 * q), lds_frag(L + HG_Q, 16 * ti + r, HG_PQ, 32 * ks + 8 * q), a4, 0, 0, 0);
                    MFMA_SETTLE1(a4);
                    if (tj == ti) {
#pragma unroll
                        for (int e = 0; e < 4; ++e) a4[e] = (4 * q + e <= r) ? a4[e] : 0.f; } }
                *(LAS v2u*)(L + HG_P + ((16 * ti + r) * HG_PT + 16 * tj + 4 * q) * 2) = (v2u){pk2(a4[0], a4[1]), pk2(a4[2], a4[3])}; }
            LSYNC();
            f32x4 o[4];
#pragma unroll
            for (int ti2 = 0; ti2 < 4; ++ti2) o[ti2] = (f32x4){0.f, 0.f, 0.f, 0.f};
#pragma unroll
            for (int ks = 0; ks < 4; ++ks) { const bf16x8 a = lds_frag(L + HG_ST, 16 * w + r, HG_PQ, 32 * ks + 8 * q);
#pragma unroll
                for (int ti2 = 0; ti2 < 4; ++ti2) o[ti2] = __builtin_amdgcn_mfma_f32_16x16x32_bf16(a, lds_frag(L + HG_Q0, 16 * ti2 + r, HG_PQ, 32 * ks + 8 * q), o[ti2], 0, 0, 0); }
#pragma unroll
            for (int js = 0; js < 2; ++js) { const bf16x8 a = lds_frag(L + HG_VT, 16 * w + r, HG_PT, 32 * js + 8 * q);
#pragma unroll
                for (int ti2 = 0; ti2 < 4; ++ti2) o[ti2] = __builtin_amdgcn_mfma_f32_16x16x32_bf16(a, lds_frag(L + HG_P, 16 * ti2 + r, HG_PT, 32 * js + 8 * q), o[ti2], 0, 0, 0); }
            MFMA_SETTLE4(o[0], o[1], o[2], o[3]);
#pragma unroll
            for (int ti2 = 0; ti2 < 4; ++ti2) { float ss = (o[ti2][0] * o[ti2][0] + o[ti2][1] * o[ti2][1]) + (o[ti2][2] * o[ti2][2] + o[ti2][3] * o[ti2][3]);
                ss += __shfl_xor(ss, 16); ss += __shfl_xor(ss, 32);
                if (q == 0) *(LAS float*)(L + HG_RS + (w * 64 + 16 * ti2 + r) * 4) = ss; }
            LSYNC();
            const f32x4 g4 = *(const GAS f32x4*)(gn + h * 128 + 16 * w + 4 * q);
#pragma unroll
            for (int ti2 = 0; ti2 < 4; ++ti2) { float tot = 0.f;
#pragma unroll
                for (int ww = 0; ww < 8; ++ww) tot += *(LAS float*)(L + HG_RS + (ww * 64 + 16 * ti2 + r) * 4);
                const float rs = __builtin_amdgcn_rsqf(tot * (1.f / 128.f) + EPS);
                const size_t row = row0 + 16 * ti2 + r; const v2u gw = gwp[ti2];
                v2u yw; yw.x = pk2(o[ti2][0] * rs * g4[0] * siluf_(bflo(gw.x)), o[ti2][1] * rs * g4[1] * siluf_(bfhi(gw.x))); yw.y = pk2(o[ti2][2] * rs * g4[2] * siluf_(bflo(gw.y)), o[ti2][3] * rs * g4[3] * siluf_(bfhi(gw.y)));
                *(GAS v2u*)(Y + row * D + h * 128 + 16 * w + 4 * q) = yw; }
        }
        if (!(PASS_C && ci == nch - 1)) {
#pragma unroll
            for (int tk = 0; tk < 8; ++tk) { const float el = *(LAS float*)(L + HG_EL + (16 * tk + r) * 4); st[tk] = st[tk] * el; }
#pragma unroll
            for (int js = 0; js < 2; ++js) { const bf16x8 a = lds_frag(L + HG_VT, 16 * w + r, HG_PT, 32 * js + 8 * q);
#pragma unroll
                for (int tk = 0; tk < 8; ++tk) st[tk] = __builtin_amdgcn_mfma_f32_16x16x32_bf16(a, lds_frag(L + HG_KT, 16 * tk + r, HG_PT, 32 * js + 8 * q), st[tk], 0, 0, 0); }
            MFMA_SETTLE8(st[0], st[1], st[2], st[3], st[4], st[5], st[6], st[7]);
            if (PASS_C) {
#pragma unroll
                for (int tk = 0; tk < 8; ++tk)
#pragma unroll
                    for (int e = 0; e < 4; ++e) *(LAS bf16*)(L + HG_ST + ((16 * w + 4 * q + e) * HG_PQ + 16 * tk + r) * 2) = f2bf16(st[tk][e]);
            }
        }
    }
    if (!PASS_C) {
#pragma unroll
        for (int tk = 0; tk < 8; ++tk)
#pragma unroll
            for (int e = 0; e < 4; ++e) Gu[(16 * w + 4 * q + e) * 128 + 16 * tk + r] = st[tk][e];
        if (w == 0) { HD[unit * 128 + ch0] = __expf(tl0); HD[unit * 128 + ch0 + 1] = __expf(tl1); }
    }
    WG_SYNC();
}
__device__ __forceinline__ void hgrn_carry(Frame& F, const float* HG, float* HG2, const float* HD) {
    const int tid = opaque_tid();
    for (int idx = blockIdx.x * 512 + tid; idx < 32 * 16384; idx += F.G * 512) {
        const int bh = idx >> 14, e = idx & 16383, k = e & 127; float S = 0.f;
        float g[16], dk[16];
#pragma unroll
        for (int c = 0; c < 16; ++c) { g[c] = HG[(size_t)(bh * 16 + c) * 16384 + e]; dk[c] = HD[(bh * 16 + c) * 128 + k]; }
#pragma unroll
        for (int c = 0; c < 16; ++c) { HG2[(size_t)(bh * 16 + c) * 16384 + e] = S; S = dk[c] * S + g[c]; }
    }
}

constexpr int LR_P = 264;
constexpr int LR_XC = 0, LR_OH = LR_XC + 64 * LR_P * 2, LR_OA = LR_OH + 64 * LR_P * 2, LR_END = LR_OA + 64 * LR_P * 2;
static_assert(LR_END <= LDSCTL_OFF, "LRU LDS map");
__device__ __forceinline__ void lru_unit(Frame& F, int unit, const bf16* proj, const bf16* WL, const float* cw, const float* cb, const float* b_a, const float* b_x, const float* lam,
                                         bf16* HLOC, bf16* ACUM, float* LC) {
    const int tid = opaque_tid(), lane = tid & 63, w = F.wave, r = lane & 15, q = lane >> 4;
    const int b = unit >> 7, hd = (unit >> 4) & 7, c = unit & 15;
    ldsp L = F.lds;
    const int c8 = tid & 31, tg = tid >> 5;
    float ba[2], bx[2], sp[2], hc[2] = {0.f, 0.f}, pc[2] = {1.f, 1.f};
#pragma unroll
    for (int ct = 0; ct < 2; ++ct) { const int ch = hd * 256 + 32 * w + 16 * ct + r; ba[ct] = b_a[ch]; bx[ct] = b_x[ch]; sp[ct] = pg8::softplus_neg(lam[ch]); }
    const int nsc = (c == 0) ? 5 : 4;
    const int chg = hd * 256 + 8 * c8;
    float wv[4][8], bv[8];
#pragma unroll
    for (int e = 0; e < 8; ++e) { bv[e] = cb[chg + e];
#pragma unroll
        for (int k = 0; k < 4; ++k) wv[k][e] = cw[k * LW + chg + e]; }
    v4u xw[7];
#define LR_LOAD(sj) do { const bool mc_ = (c == 0 && (sj) == 0); const int p0_ = (mc_ ? 0 : NMETA + c * 256 + ((c == 0) ? (sj) - 1 : (sj)) * 64) + 4 * tg - 3; \
        if (tg < (mc_ ? 4 : 16)) { _Pragma("unroll") for (int d = 0; d < 7; ++d) { const int p = p0_ + d; \
            if (p >= 0) { const size_t row = p < NMETA ? (size_t)(MR + p) : (size_t)b * SEQ + p - NMETA; xw[d] = *(const GAS v4u*)(proj + row * INC + 4 * HW + chg); } \
            else xw[d] = (v4u){0u, 0u, 0u, 0u}; } } } while (0)
    LR_LOAD(0);
    for (int si = 0; si < nsc; ++si) {
        const bool metac = (c == 0 && si == 0);
        const int ntt = metac ? 1 : 4;
        const int pos0 = metac ? 0 : NMETA + c * 256 + ((c == 0) ? si - 1 : si) * 64;
        if (tg < 4 * ntt) {
            float xr[7][8];
#pragma unroll
            for (int d = 0; d < 7; ++d) { xr[d][0] = bflo(xw[d].x); xr[d][1] = bfhi(xw[d].x); xr[d][2] = bflo(xw[d].y); xr[d][3] = bfhi(xw[d].y); xr[d][4] = bflo(xw[d].z); xr[d][5] = bfhi(xw[d].z); xr[d][6] = bflo(xw[d].w); xr[d][7] = bfhi(xw[d].w); }
#pragma unroll
            for (int i = 0; i < 4; ++i) { float xo[8];
#pragma unroll
                for (int e = 0; e < 8; ++e) xo[e] = bv[e] + xr[i][e] * wv[0][e] + xr[i + 1][e] * wv[1][e] + xr[i + 2][e] * wv[2][e] + xr[i + 3][e] * wv[3][e];
                *(LAS v4u*)(L + LR_XC + ((4 * tg + i) * LR_P + 8 * c8) * 2) = (v4u){pk2(xo[0], xo[1]), pk2(xo[2], xo[3]), pk2(xo[4], xo[5]), pk2(xo[6], xo[7])}; }
        }
        LSYNC();
        f32x4 ar[2][4], ai[2][4];
#pragma unroll
        for (int ct = 0; ct < 2; ++ct)
#pragma unroll
            for (int tt = 0; tt < 4; ++tt) { ar[ct][tt] = (f32x4){0.f, 0.f, 0.f, 0.f}; ai[ct][tt] = (f32x4){0.f, 0.f, 0.f, 0.f}; }
        const bf16* wrow = WL + (size_t)(512 * hd + 256 * (w >> 2) + 32 * (w & 3) + r) * 256 + 8 * q;
#pragma unroll 4
        for (int ks = 0; ks < 8; ++ks) {
            bf16x8 br[2], bi[2];
#pragma unroll
            for (int ct = 0; ct < 2; ++ct) { br[ct] = *(const GAS bf16x8*)(wrow + (size_t)(16 * ct) * 256 + 32 * ks); bi[ct] = *(const GAS bf16x8*)(wrow + (size_t)(16 * ct + 128) * 256 + 32 * ks); }
#pragma unroll
            for (int tt = 0; tt < 4; ++tt) { if (tt < ntt) { const bf16x8 a = lds_frag(L + LR_XC, 16 * tt + r, LR_P, 32 * ks + 8 * q);
#pragma unroll
                for (int ct = 0; ct < 2; ++ct) { ar[ct][tt] = __builtin_amdgcn_mfma_f32_16x16x32_bf16(a, br[ct], ar[ct][tt], 0, 0, 0); ai[ct][tt] = __builtin_amdgcn_mfma_f32_16x16x32_bf16(a, bi[ct], ai[ct][tt], 0, 0, 0); } } }
        }
        MFMA_SETTLE8(ar[0][0], ar[0][1], ar[0][2], ar[0][3], ar[1][0], ar[1][1], ar[1][2], ar[1][3]); MFMA_SETTLE8(ai[0][0], ai[0][1], ai[0][2], ai[0][3], ai[1][0], ai[1][1], ai[1][2], ai[1][3]);
        if (si + 1 < nsc) LR_LOAD(si + 1);
#pragma unroll
        for (int ct = 0; ct < 2; ++ct) {
#pragma unroll
            for (int tt = 0; tt < 4; ++tt) { if (tt < ntt) {
                float al[4], hl[4]; float P = 1.f, H = 0.f;
#pragma unroll
                for (int e = 0; e < 4; ++e) { const int t = 16 * tt + 4 * q + e; const float xcv = bf2f(*(LAS bf16*)(L + LR_XC + (t * LR_P + 32 * w + 16 * ct + r) * 2));
                    float a, d; pg8::lru_gate_math(ar[ct][tt][e], ai[ct][tt][e], ba[ct], bx[ct], sp[ct], xcv, a, d); H = a * H + d; P *= a; al[e] = P; hl[e] = H; }
                float Pi = P, Hi = H;
                { const float Pp = __shfl(Pi, lane - 16), Hp = __shfl(Hi, lane - 16); if (q >= 1) { Hi = Pi * Hp + Hi; Pi = Pp * Pi; } }
                { const float Pp = __shfl(Pi, lane - 32), Hp = __shfl(Hi, lane - 32); if (q >= 2) { Hi = Pi * Hp + Hi; Pi = Pp * Pi; } }
                float Pe = __shfl(Pi, lane - 16), He = __shfl(Hi, lane - 16); if (q == 0) { Pe = 1.f; He = 0.f; }
                const float Pt = __shfl(Pi, 48 + r), Ht = __shfl(Hi, 48 + r);
                const float hin = Pe * hc[ct] + He, pin = pc[ct] * Pe;
                if (!metac) {
#pragma unroll
                    for (int e = 0; e < 4; ++e) { const int t = 16 * tt + 4 * q + e; const int o = (t * LR_P + 32 * w + 16 * ct + r) * 2;
                        *(LAS bf16*)(L + LR_OH + o) = f2bf16(al[e] * hin + hl[e]); *(LAS bf16*)(L + LR_OA + o) = f2bf16(pin * al[e]); } }
                hc[ct] = Pt * hc[ct] + Ht; pc[ct] = pc[ct] * Pt; } }
        }
        LSYNC();
        if (!metac) {
            const size_t rowb = (size_t)b * SEQ + pos0 - NMETA;
#pragma unroll
            for (int i = 0; i < 4; ++i) { const int t = 4 * tg + i; const size_t go = (rowb + t) * LW + hd * 256 + 8 * c8;
                *(GAS v4u*)(HLOC + go) = *(LAS v4u*)(L + LR_OH + (t * LR_P + 8 * c8) * 2); *(GAS v4u*)(ACUM + go) = *(LAS v4u*)(L + LR_OA + (t * LR_P + 8 * c8) * 2); }
        }
    }
    if (q == 0) {
#pragma unroll
        for (int ct = 0; ct < 2; ++ct) { const int ch = hd * 256 + 32 * w + 16 * ct + r; LC[(size_t)((b * 16 + c) * 2 + 0) * LW + ch] = pc[ct]; LC[(size_t)((b * 16 + c) * 2 + 1) * LW + ch] = hc[ct]; }
    }
    WG_SYNC();
}
__device__ __forceinline__ void lru_finish(Frame& F, const bf16* HLOC, const bf16* ACUM, const float* LC, const bf16* proj, const float* ln, bf16* Y) {
    const int tid = opaque_tid(), lane = tid & 63, w = F.wave;
    LAS float* HIN = (LAS float*)(F.lds);
    for (int item = blockIdx.x; item < 256; item += F.G) {
        const int b = item >> 7, c = (item >> 3) & 15, sub = item & 7;
        { f32x4 hin = (f32x4){0.f, 0.f, 0.f, 0.f};
#pragma unroll
          for (int c0 = 0; c0 < 16; c0 += 8) { if (c0 < c) { f32x4 P[8], H[8];
#pragma unroll
              for (int j = 0; j < 8; ++j) { const int cs = (c0 + j < c) ? c0 + j : 0; P[j] = *(const GAS f32x4*)(LC + (size_t)((b * 16 + cs) * 2 + 0) * LW + 4 * tid); H[j] = *(const GAS f32x4*)(LC + (size_t)((b * 16 + cs) * 2 + 1) * LW + 4 * tid); }
#pragma unroll
              for (int j = 0; j < 8; ++j) { if (c0 + j < c) hin = P[j] * hin + H[j]; } } }
          *(LAS f32x4*)(HIN + 4 * tid) = hin; }
        WG_SYNC();
#pragma unroll 1
        for (int rr = 0; rr < 4; ++rr) { const size_t row = (size_t)b * SEQ + c * 256 + sub * 32 + w * 4 + rr;
            float hv[4][8]; float ss = 0.f;
#pragma unroll
            for (int j = 0; j < 4; ++j) { const int ch = (lane + 64 * j) * 8; const v4u hw = *(const GAS v4u*)(HLOC + row * LW + ch), aw = *(const GAS v4u*)(ACUM + row * LW + ch);
                const f32x4 i0 = *(LAS f32x4*)(HIN + ch), i1 = *(LAS f32x4*)(HIN + ch + 4);
                hv[j][0] = bflo(hw.x) + bflo(aw.x) * i0[0]; hv[j][1] = bfhi(hw.x) + bfhi(aw.x) * i0[1]; hv[j][2] = bflo(hw.y) + bflo(aw.y) * i0[2]; hv[j][3] = bfhi(hw.y) + bfhi(aw.y) * i0[3];
                hv[j][4] = bflo(hw.z) + bflo(aw.z) * i1[0]; hv[j][5] = bfhi(hw.z) + bfhi(aw.z) * i1[1]; hv[j][6] = bflo(hw.w) + bflo(aw.w) * i1[2]; hv[j][7] = bfhi(hw.w) + bfhi(aw.w) * i1[3];
#pragma unroll
                for (int e = 0; e < 8; ++e) ss += hv[j][e] * hv[j][e]; }
            const float rs = __builtin_amdgcn_rsqf(wave_sum(ss) * (1.f / LW) + EPS);
#pragma unroll
            for (int j = 0; j < 4; ++j) { const int ch = (lane + 64 * j) * 8; const v4u gw = *(const GAS v4u*)(proj + row * INC + 4 * HW + LW + ch);
                const f32x4 l0 = *(const GAS f32x4*)(ln + ch), l1 = *(const GAS f32x4*)(ln + ch + 4);
                v4u yw; yw.x = pk2(hv[j][0] * rs * l0[0] * gelu_tanh(bflo(gw.x)), hv[j][1] * rs * l0[1] * gelu_tanh(bfhi(gw.x))); yw.y = pk2(hv[j][2] * rs * l0[2] * gelu_tanh(bflo(gw.y)), hv[j][3] * rs * l0[3] * gelu_tanh(bfhi(gw.y)));
                yw.z = pk2(hv[j][4] * rs * l1[0] * gelu_tanh(bflo(gw.z)), hv[j][5] * rs * l1[1] * gelu_tanh(bfhi(gw.z))); yw.w = pk2(hv[j][6] * rs * l1[2] * gelu_tanh(bflo(gw.w)), hv[j][7] * rs * l1[3] * gelu_tanh(bfhi(gw.w)));
                *(GAS v4u*)(Y + row * D + HW + ch) = yw; } }
        WG_SYNC();
    }
}

#ifndef PHASE_MASK
#define PHASE_MASK 0xFFFFFFFF
#endif
#ifndef DUP_MASK
#define DUP_MASK 0
#endif
#define PH(k) if constexpr ((PHASE_MASK >> (k)) & 1) _Pragma("unroll") for (int rep_ = 0; rep_ < 1 + (int)((DUP_MASK >> (k)) & 1); ++rep_)
__global__ void __launch_bounds__(NWAVES * 64, 2) hymba_fwd(Args args) {
    extern __shared__ __attribute__((aligned(16))) unsigned char lds[];
    Frame F;
    F.lds = (LAS unsigned char*)lds;
    F.MISC = (volatile LAS unsigned*)(F.lds + MISC_OFF);
    F.tid = threadIdx.x; F.lane = F.tid & 63; F.wave = __builtin_amdgcn_readfirstlane(F.tid >> 6);
    F.G = gridDim.x; { const int bx = blockIdx.x; F.vcu = (F.G % 8 == 0) ? (bx % 8) * (F.G / 8) + bx / 8 : bx; }
    unsigned char* ws = args.ws;
    F.ctl = (gu32*)(ws + WS_CTL);
    for (int u = F.tid; u < (LDS_BYTES - LDSCTL_OFF) / 4; u += NWAVES * 64) ((LAS unsigned*)(F.lds + LDSCTL_OFF))[u] = 0u;
    __syncthreads();
    XcdBarrier bar = xcd_barrier_post((unsigned*)(F.ctl + CW_BAR), F.MISC + 8);
#define GRID_BAR() do { XcdBarrier b_ = bar; asm volatile("" : "+s"(b_.bar), "+s"(b_.x)); xcd_barrier(b_); } while (0)

    const float* x = args.in[0]; const float* meta = args.in[1];
    bf16* WGU1 = (bf16*)(ws + WS_WGU1); bf16* WD1 = (bf16*)(ws + WS_WD1); bf16* WIN = (bf16*)(ws + WS_WIN); bf16* WOUT = (bf16*)(ws + WS_WOUT);
    bf16* WGU2 = (bf16*)(ws + WS_WGU2); bf16* WD2 = (bf16*)(ws + WS_WD2); bf16* WLRU = (bf16*)(ws + WS_WLRU);
    bf16* U = (bf16*)(ws + WS_U); bf16* HID = (bf16*)(ws + WS_BIG); bf16* PROJ = (bf16*)(ws + WS_BIG);
    bf16* Fb = (bf16*)(ws + WS_F);
    float* HGs = (float*)(ws + WS_HG); float* HGs2 = (float*)(ws + WS_HG2); float* HDs = (float*)(ws + WS_HD); float* LC = (float*)(ws + WS_LC); bf16* HLOC = (bf16*)(ws + WS_HLOC); bf16* ACUM = (bf16*)(ws + WS_ACUM); bf16* Y = (bf16*)(ws + WS_Y); bf16* HB = (bf16*)(ws + WS_HB);
    float* out = args.out;
    const int gw = F.vcu * NWAVES + F.wave, NGW = F.G * NWAVES;

    PH(0) {
        LAS float* scr = (LAS float*)(F.lds + RING_OFF + F.wave * 16896); const int lane0 = opaque_lane();
        p0_convert_all(args, WGU1, WD1, WIN, WOUT, WGU2, WD2, WLRU, scr, gw, NGW, lane0);
        for (int m = gw; m < MT; m += NGW) rms_row_to_bf16(m < MR ? x + (size_t)m * D : meta + (size_t)(m - MR) * D, args.in[2], U, m, lane0);
    }
    GRID_BAR();

    PH(1) {
        skinny_phase<2, 3>(F, U, D, WGU1, D, D, FF / 16, MapGateUp{}, SkEpiSwiGLU{HID});
        pg8::Gemm g{U, WGU1, MR, 2 * FF, D, D, D, 0, 0}; pg8::StaticOrder S; S.init(MR, 2 * FF, F.G, (int)blockIdx.x);
        pg8::EpiSwiGLU E{HID, FF};
        pg8::gemm_phase<pg8::EpiSwiGLU, pg8::StaticOrder, true, true>(F.lds + RING_OFF, g, S, E, F.wave);
    }
    GRID_BAR();
    PH(2) {
        skinny_phase<1, 1>(F, HID, 0, WD1, FF, FF, D / 16, MapPlain{}, SkEpiBf16{Fb, D});
        pg8::Gemm g{HID, WD1, MR, D, FF, FF, FF, 0, 1}; pg8::StaticOrder S; S.init(MR, D, F.G, (int)blockIdx.x);
        pg8::EpiBf16 E{Fb, D};
        pg8::gemm_phase<pg8::EpiBf16, pg8::StaticOrder, true, true>(F.lds + RING_OFF, g, S, E, F.wave);
    }
    GRID_BAR();
    PH(3) { norm_rows<0>(Fb, x, meta, nullptr, HB, nullptr, U, args.in[6], args.in[7], 0.5f, MR, gw, NGW);
        for (int m = blockIdx.x; m < NMETA; m += F.G) norm_meta_row(F, m, Fb, meta, U, args.in[6], args.in[7], 0.5f); }
    GRID_BAR();
    PH(4) {
        skinny_phase<1, 3>(F, U, D, WIN, D, D, INC / 16, MapPlain{}, SkEpiBf16{PROJ, INC});
        pg8::Gemm g{U, WIN, MR, INC, D, D, D, 0, 0}; pg8::StaticOrder S; S.init(MR, INC, F.G, (int)blockIdx.x);
        pg8::EpiBf16 E{PROJ, INC};
        pg8::gemm_phase<pg8::EpiBf16, pg8::StaticOrder, true, true>(F.lds + RING_OFF, g, S, E, F.wave);
    }
    GRID_BAR();
    PH(5) {
        for (int u = blockIdx.x; u < 256; u += F.G) lru_unit(F, u, PROJ, WLRU, args.in[11], args.in[12], args.in[14], args.in[16], args.in[17], HLOC, ACUM, LC);
        for (int i = blockIdx.x; i < 512; i += F.G) { const int u = (i & ~255) | ((i + 4 + 4 * (i >> 8)) & 255); hgrn_unit<false>(F, u, PROJ, args.in[9], args.in[10], HGs, HDs, Y); }
    }
    GRID_BAR();
    PH(6) { hgrn_carry(F, HGs, HGs2, HDs); lru_finish(F, HLOC, ACUM, LC, PROJ, args.in[18], Y); }
    GRID_BAR();
    PH(7) { for (int i = blockIdx.x; i < 512; i += F.G) { const int u = (i & ~255) | ((i + 8 * (i >> 8)) & 255); hgrn_unit<true>(F, u, PROJ, args.in[9], args.in[10], HGs2, HDs, Y); } }
    GRID_BAR();
    PH(9) {
        pg8::Gemm g{Y, WOUT, MR, D, D, D, D, 0, 0}; pg8::StaticOrder S; S.init(MR, D, F.G, (int)blockIdx.x);
        pg8::EpiBf16 E{Fb, D};
        pg8::gemm_phase<pg8::EpiBf16, pg8::StaticOrder, true, true>(F.lds + RING_OFF, g, S, E, F.wave);
    }
    GRID_BAR();
    PH(10) norm_rows<1>(Fb, nullptr, nullptr, HB, HB, nullptr, U, args.in[20], args.in[21], 1.0f, MR, gw, NGW);
    GRID_BAR();
    PH(11) {
        pg8::Gemm g{U, WGU2, MR, 2 * FF, D, D, D, 0, 0}; pg8::StaticOrder S; S.init(MR, 2 * FF, F.G, (int)blockIdx.x);
        pg8::EpiSwiGLU E{HID, FF};
        pg8::gemm_phase<pg8::EpiSwiGLU, pg8::StaticOrder, true, true>(F.lds + RING_OFF, g, S, E, F.wave);
    }
    GRID_BAR();
    PH(12) {
        pg8::Gemm g{HID, WD2, MR, D, FF, FF, FF, 0, 1}; pg8::StaticOrder S; S.init(MR, D, F.G, (int)blockIdx.x);
        pg8::EpiBf16 E{Fb, D};
        pg8::gemm_phase<pg8::EpiBf16, pg8::StaticOrder, true, true>(F.lds + RING_OFF, g, S, E, F.wave);
    }
    GRID_BAR();
    PH(13) norm_rows<2>(Fb, nullptr, nullptr, HB, nullptr, out, nullptr, args.in[25], nullptr, 0.5f, MR, gw, NGW);
}

extern "C" void kernel_launch(void* const* d_in, const int* in_sizes, int n_in, void* d_out, int out_size, void* d_ws, size_t ws_size, hipStream_t stream) {
    static int grid = 0;
    if (grid == 0) {
        if (n_in != 26 || out_size != MR * D || ws_size < WS_END) { fprintf(stderr, "kernel_launch: unexpected shapes (n_in %d, out %d, ws %zu, need %zu)\n", n_in, out_size, ws_size, (size_t)WS_END); grid = -1; return; }
        int dev = 0, cus = 0, per_cu = 0;
        if (hipGetDevice(&dev) != hipSuccess || hipDeviceGetAttribute(&cus, hipDeviceAttributeMultiprocessorCount, dev) != hipSuccess) { grid = -1; return; }
        if (hipFuncSetAttribute((const void*)hymba_fwd, hipFuncAttributeMaxDynamicSharedMemorySize, LDS_BYTES) != hipSuccess) { fprintf(stderr, "kernel_launch: hipFuncSetAttribute failed\n"); grid = -1; return; }
        if (hipOccupancyMaxActiveBlocksPerMultiprocessor(&per_cu, (const void*)hymba_fwd, NWAVES * 64, LDS_BYTES) != hipSuccess || per_cu < 1) fprintf(stderr, "kernel_launch: occupancy query says %d\n", per_cu);
        (void)hipGetLastError();
        grid = cus;
    }
    if (grid < 0) return;
    if (hipMemsetAsync((char*)d_ws + WS_CTL, 0, CTL_ZERO_BYTES, stream) != hipSuccess) return;
    Args a{};
    for (int i = 0; i < 26; ++i) a.in[i] = (const float*)d_in[i];
    a.out = (float*)d_out; a.ws = (unsigned char*)d_ws;
    hipLaunchKernelGGL(hymba_fwd, dim3(grid), dim3(NWAVES * 64), LDS_BYTES, stream, a);
}
```

```cpp
#include <hip/hip_runtime.h>
#include <cstdio>
#include <cstdint>

namespace pg8 {
#define PG8_LAS __attribute__((address_space(3)))
typedef unsigned short bf16_t;
typedef short bf16x8 __attribute__((ext_vector_type(8)));
typedef float f32x4 __attribute__((ext_vector_type(4)));
typedef float f32x2 __attribute__((ext_vector_type(2)));
typedef unsigned u32x4 __attribute__((ext_vector_type(4)));
typedef unsigned u32x2 __attribute__((ext_vector_type(2)));
constexpr int BM = 256, BK = 64, HALF = 128, HTB = HALF * BK * 2, STAGE_BYTES = 8 * HTB, NXCD = 8, WGM = 8;

__host__ __device__ __forceinline__ int lds_byte(int r, int c) { const int st = (r >> 4) * 2 + (c >> 5), rr = r & 15, cc = c & 31, ob = rr * 64 + cc * 2; return st * 1024 + (ob ^ (((ob >> 9) & 1) << 5)); }
__host__ __device__ __forceinline__ void stage_rc(int b, int& R, int& C) { const int st = b / 1024, sb = b % 1024, swz = sb ^ (((sb >> 9) & 1) << 5); R = (st >> 1) * 16 + swz / 64; C = (st & 1) * 32 + (swz % 64) / 2; }
__host__ __device__ __forceinline__ int perm32(int rho) { const int n = rho >> 4, i = rho & 15; return 8 * (i >> 2) + 4 * n + (i & 3); }

struct Unit { int pm, pn; };
struct Gemm { const bf16_t* A; const bf16_t* Bt; int M, N, K, lda, ldb, agrp, ablk; };

struct StaticOrder {
    int nM, nN, nwg, G, c;
    __host__ __device__ void init(int M, int N, int G_, int c_) { nM = M / BM; nN = N / BM; nwg = nM * nN; G = G_; c = c_; }
    __host__ __device__ bool next(int i, Unit& u) const {
        const long L = (long)i * G + c; if (L >= nwg) return false;
        int wgid = (int)L; { const int q = nwg / NXCD, r = nwg % NXCD, xcd = wgid % NXCD, off = wgid / NXCD; wgid = (xcd < r ? xcd * (q + 1) : r * (q + 1) + (xcd - r) * q) + off; }
        const int nig = WGM * nN, gid = wgid / nig, fm = gid * WGM, gsz = (nM - fm) < WGM ? (nM - fm) : WGM;
        u.pm = fm + ((wgid % nig) % gsz); u.pn = (wgid % nig) / gsz; return true;
    }
    __device__ __forceinline__ void a_ready(const Unit&) const {}
    __device__ __forceinline__ void done(const Unit&) const {}
};

__device__ __forceinline__ unsigned cvt_pk_bf16(float lo, float hi) { unsigned r; asm volatile("v_cvt_pk_bf16_f32 %0, %1, %2" : "=v"(r) : "v"(lo), "v"(hi)); return r; }
__device__ __forceinline__ float fast_sigmoid(float x) { return __builtin_amdgcn_rcpf(1.0f + __builtin_amdgcn_exp2f(-1.44269504089f * x)); }
__device__ __forceinline__ float fast_silu(float x) { return x * fast_sigmoid(x); }

struct EpiF32 {
    static constexpr bool PERM = false, AFTER_DRAIN = false;
    float* C; int ldc;
    __device__ __forceinline__ void operator()(const f32x4 (&acc)[2][2][4][2], const Unit& u, int wr, int wc, int fr, int fq) const {
        const int row0 = u.pm * BM + wr * 64 + fr, col0 = u.pn * BM + wc * 32 + 4 * fq;
#pragma unroll
        for (int ai = 0; ai < 2; ++ai)
#pragma unroll
            for (int m = 0; m < 4; ++m) { float* rowp = C + (size_t)(row0 + ai * HALF + m * 16) * ldc + col0;
#pragma unroll
                for (int bj = 0; bj < 2; ++bj)
#pragma unroll
                    for (int n = 0; n < 2; ++n) *(f32x4*)(rowp + bj * HALF + n * 16) = acc[ai][bj][m][n]; }
    }
};
struct EpiBf16 {
    static constexpr bool PERM = true, AFTER_DRAIN = false;
    bf16_t* O; int ldc;
    __device__ __forceinline__ void operator()(const f32x4 (&acc)[2][2][4][2], const Unit& u, int wr, int wc, int fr, int fq) const {
        const int row0 = u.pm * BM + wr * 64 + fr, col0 = u.pn * BM + wc * 32 + 8 * fq;
#pragma unroll
        for (int ai = 0; ai < 2; ++ai)
#pragma unroll
            for (int m = 0; m < 4; ++m) { bf16_t* rowp = O + (size_t)(row0 + ai * HALF + m * 16) * ldc + col0;
#pragma unroll
                for (int bj = 0; bj < 2; ++bj) { const f32x4 v0 = acc[ai][bj][m][0], v1 = acc[ai][bj][m][1];
                    u32x4 w; w.x = cvt_pk_bf16(v0[0], v0[1]); w.y = cvt_pk_bf16(v0[2], v0[3]); w.z = cvt_pk_bf16(v1[0], v1[1]); w.w = cvt_pk_bf16(v1[2], v1[3]);
                    *(u32x4*)(rowp + bj * HALF) = w; } }
    }
};
struct EpiSwiGLU {
    static constexpr bool PERM = true, AFTER_DRAIN = false;
    bf16_t* O; int ldc;
    __device__ __forceinline__ void operator()(const f32x4 (&acc)[2][2][4][2], const Unit& u, int wr, int wc, int fr, int fq) const {
#pragma unroll
        for (int ai = 0; ai < 2; ++ai)
#pragma unroll
            for (int m = 0; m < 4; ++m) { bf16_t* rowp = O + ((((size_t)(u.pm * 16 + ai * 8 + wr * 4 + m)) * (ldc >> 5) + u.pn * 4 + wc) << 9) + fr * 32 + 8 * fq;
                const f32x4 g0 = acc[ai][0][m][0], g1 = acc[ai][0][m][1], u0 = acc[ai][1][m][0], u1 = acc[ai][1][m][1];
                f32x4 v0, v1;
#pragma unroll
                for (int e = 0; e < 4; ++e) { v0[e] = fast_silu(g0[e]) * u0[e]; v1[e] = fast_silu(g1[e]) * u1[e]; }
                u32x4 w; w.x = cvt_pk_bf16(v0[0], v0[1]); w.y = cvt_pk_bf16(v0[2], v0[3]); w.z = cvt_pk_bf16(v1[0], v1[1]); w.w = cvt_pk_bf16(v1[2], v1[3]);
                *(u32x4*)rowp = w; }
    }
};
__device__ __forceinline__ float softplus_neg(float lam) { const float y = __expf(-lam); return y < 0.05f ? y * (1.0f - y * (0.5f - y * (0.33333334f - y * 0.25f))) : __logf(1.0f + y); }
__device__ __forceinline__ float neg_expm1(float x) { const float s = -x * (1.0f + x * (0.5f + x * (0.16666667f + x * (0.041666668f + x * 0.0083333338f)))); return x > -0.1f ? s : 1.0f - __expf(x); }
__device__ __forceinline__ void lru_gate_math(float rp, float ip, float ba, float bx, float sp, float xcv, float& a, float& d) {
    const float r = fast_sigmoid(rp + ba), ig = fast_sigmoid(ip + bx);
    const float la = -8.0f * r * sp; a = __expf(la); const float x2 = 2.0f * la;
    const float ser = -x2 * (1.0f + x2 * (0.5f + x2 * (0.16666667f + x2 * (0.041666668f + x2 * 0.0083333338f))));
    d = __builtin_amdgcn_sqrtf(x2 > -0.1f ? ser : 1.0f - a * a) * (ig * xcv);
}
struct EpiLru {
    static constexpr bool PERM = false, AFTER_DRAIN = false;
    float* Aout; float* Dout; const bf16_t* XC; const float* b_a; const float* b_x; const float* lam;
    __device__ __forceinline__ void operator()(const f32x4 (&acc)[2][2][4][2], const Unit& u, int wr, int wc, int fr, int fq) const {
        const int chu = (u.pn >> 1) * 256 + (u.pn & 1) * 128 + wc * 32;
        const size_t rowu = (size_t)(u.pm * BM + wr * 64);
        const unsigned lo = (unsigned)(fr * 2048 + 4 * fq);
#pragma unroll
        for (int n = 0; n < 2; ++n) { const int ch = chu + n * 16 + 4 * fq;
            const f32x4 ba = *(const f32x4*)(b_a + ch), bx = *(const f32x4*)(b_x + ch), l = *(const f32x4*)(lam + ch); f32x4 sp;
#pragma unroll
            for (int e = 0; e < 4; ++e) sp[e] = softplus_neg(l[e]);
#pragma unroll
            for (int ai = 0; ai < 2; ++ai)
#pragma unroll
                for (int m = 0; m < 4; ++m) { const size_t ub = (rowu + ai * HALF + m * 16) * 2048 + chu + n * 16;
                    const u32x2 xw = *(const u32x2*)((const char*)(XC + ub) + lo * 2u);
                    const float xv[4] = {__uint_as_float(xw.x << 16), __uint_as_float(xw.x & 0xffff0000u), __uint_as_float(xw.y << 16), __uint_as_float(xw.y & 0xffff0000u)};
                    f32x4 av, dv;
#pragma unroll
                    for (int e = 0; e < 4; ++e) { float a, d; lru_gate_math(acc[ai][0][m][n][e], acc[ai][1][m][n][e], ba[e], bx[e], sp[e], xv[e], a, d); av[e] = a; dv[e] = d; }
                    *(f32x4*)((char*)(Aout + ub) + lo * 4u) = av; *(f32x4*)((char*)(Dout + ub) + lo * 4u) = dv;
                    asm volatile("" ::: "memory"); } }
    }
};

template <class Epi, class Sched, bool ALIGN_EPI = false, bool SP2 = false>
__device__ __forceinline__ void gemm_phase(PG8_LAS unsigned char* lds, const Gemm g, const Sched& S, const Epi& E, int wave_id) {
    int lane_; asm volatile("v_mbcnt_lo_u32_b32 %0, -1, 0\n\tv_mbcnt_hi_u32_b32 %0, -1, %0" : "=v"(lane_));
    const int wid = wave_id, lane = lane_, tid = wid * 64 + lane, wr = wid >> 2, wc = wid & 3, fr = lane & 15, fq = lane >> 4;
    const int K = g.K, nt = K / BK;
    unsigned voffA[2], voffB[2];
#pragma unroll
    for (int i = 0; i < 2; ++i) { int R, C; stage_rc(wid * 2048 + i * 1024 + lane * 16, R, C);
        voffB[i] = (unsigned)((((R >> 4) * (g.K >> 5) + (C >> 5)) << 10) + (R & 15) * 64 + (C & 31) * 2); voffA[i] = g.ablk ? voffB[i] : (unsigned)(R * g.lda + C) * 2u; }
    static_assert(Epi::PERM, "the blocked weight layout stores the rows in the PERM order");
    const size_t kstep = g.ablk ? (size_t)2048 : (size_t)(BK * 2), kstepB = 2048;
    const size_t hsA = (size_t)HALF * g.lda * 2, hsB = (size_t)HALF * g.K * 2;
    const size_t tsA = 2 * hsA, tsB = 2 * hsB;
    const size_t agb = g.agrp ? (size_t)K * 2 : 0;
    const unsigned ldsw = (unsigned)wid * 2048u;
    const int aoff = lds_byte(wr * 64 + fr, fq * 8), boff = lds_byte(wc * 32 + fr, fq * 8);
#define PG8_SA(b, h) (((b) * 2 + (h)) * HTB)
#define PG8_SB(b, h) ((4 + (b) * 2 + (h)) * HTB)
#define PG8_STAGE(bufoff, gbase, voff) do { _Pragma("unroll") for (int _i = 0; _i < 2; ++_i) \
        __builtin_amdgcn_global_load_lds((const unsigned*)((const char*)(gbase) + (voff)[_i]), (PG8_LAS unsigned*)(lds + (bufoff) + ldsw + _i * 1024), 16, 0, 0); } while (0)
#define PG8_LDA(dst, b, h) do { _Pragma("unroll") for (int m = 0; m < 4; ++m) _Pragma("unroll") for (int k = 0; k < 2; ++k) dst[m][k] = *(const PG8_LAS bf16x8*)(lds + PG8_SA(b, h) + aoff + m * 2048 + k * 1024); } while (0)
#define PG8_LDB(dst, b, h) do { _Pragma("unroll") for (int n = 0; n < 2; ++n) _Pragma("unroll") for (int k = 0; k < 2; ++k) dst[n][k] = *(const PG8_LAS bf16x8*)(lds + PG8_SB(b, h) + boff + n * 2048 + k * 1024); } while (0)
#define PG8_MMA(ai, bj, At, Bt) do { __builtin_amdgcn_s_setprio(1); _Pragma("unroll") for (int m = 0; m < 4; ++m) _Pragma("unroll") for (int n = 0; n < 2; ++n) _Pragma("unroll") for (int k = 0; k < 2; ++k) \
        acc[ai][bj][m][n] = __builtin_amdgcn_mfma_f32_16x16x32_bf16(Bt[n][k], At[m][k], acc[ai][bj][m][n], 0, 0, 0); __builtin_amdgcn_s_setprio(0); } while (0)
#define PG8_WAIT_V(n) asm volatile("s_waitcnt vmcnt(" #n ")" ::: "memory")
#define PG8_WAIT_L(n) asm volatile("s_waitcnt lgkmcnt(" #n ")" ::: "memory")
#define PG8_BAR __builtin_amdgcn_s_barrier()
#define PG8_SCHED __builtin_amdgcn_sched_barrier(0)
    Unit cur, nxt; int ui = 0;
    if (!S.next(0, cur)) return;
    f32x4 acc[2][2][4][2];
#pragma unroll
    for (int a = 0; a < 2; ++a)
#pragma unroll
        for (int b = 0; b < 2; ++b)
#pragma unroll
            for (int m = 0; m < 4; ++m)
#pragma unroll
                for (int n = 0; n < 2; ++n) acc[a][b][m][n] = (f32x4){0.f, 0.f, 0.f, 0.f};
    bf16x8 At[4][2], B0[2][2], B1[2][2];
    const char* cA = (const char*)g.A + (size_t)cur.pm * tsA + (size_t)(cur.pn >> 1) * agb; const char* cB = (const char*)g.Bt + (size_t)cur.pn * tsB;
    S.a_ready(cur);
    if constexpr (SP2) {
        PG8_STAGE(PG8_SB(0, 0), cB, voffB); PG8_STAGE(PG8_SB(0, 1), cB + hsB, voffB); PG8_STAGE(PG8_SA(0, 0), cA, voffA); PG8_STAGE(PG8_SA(0, 1), cA + hsA, voffA);
        if (wr == 1) PG8_BAR;
        PG8_WAIT_V(2); PG8_BAR;
        PG8_STAGE(PG8_SB(1, 0), cB + kstepB, voffB); PG8_STAGE(PG8_SA(1, 0), cA + kstep, voffA); PG8_STAGE(PG8_SB(1, 1), cB + hsB + kstepB, voffB);
        PG8_WAIT_V(6); PG8_BAR;
    } else {
        PG8_STAGE(PG8_SB(0, 0), cB, voffB); PG8_STAGE(PG8_SA(0, 0), cA, voffA); PG8_STAGE(PG8_SB(0, 1), cB + hsB, voffB); PG8_STAGE(PG8_SA(0, 1), cA + hsA, voffA);
        if (wr == 1) PG8_BAR;
        PG8_WAIT_V(4); PG8_BAR;
        PG8_STAGE(PG8_SB(1, 0), cB + kstepB, voffB); PG8_STAGE(PG8_SA(1, 0), cA + kstep, voffA); PG8_STAGE(PG8_SB(1, 1), cB + hsB + kstepB, voffB);
        PG8_WAIT_V(6); PG8_BAR;
    }
    for (;;) {
        const bool has_next = S.next(ui + 1, nxt);
        const char* nA = has_next ? (const char*)g.A + (size_t)nxt.pm * tsA + (size_t)(nxt.pn >> 1) * agb : cA; const char* nB = has_next ? (const char*)g.Bt + (size_t)nxt.pn * tsB : cB;
        for (int t = 0; t < nt; t += 2) {
            const bool last = (t == nt - 2);
            const char* a1 = cA + (size_t)(t + 1) * kstep;
            const char* a2 = last ? nA : cA + (size_t)(t + 2) * kstep; const char* b2 = last ? nB : cB + (size_t)(t + 2) * kstepB;
            const char* a3 = a2 + kstep; const char* b3 = b2 + kstepB;
            if (last && has_next) S.a_ready(nxt);
            if constexpr (SP2) {
            PG8_LDB(B0, 0, 0); PG8_LDB(B1, 0, 1); PG8_SCHED; PG8_LDA(At, 0, 0); PG8_STAGE(PG8_SA(1, 1), a1 + hsA, voffA);
            PG8_WAIT_V(8); PG8_WAIT_L(0); PG8_BAR; PG8_MMA(0, 0, At, B0); PG8_MMA(0, 1, At, B1); PG8_BAR; PG8_SCHED;
            PG8_LDA(At, 0, 1); PG8_STAGE(PG8_SB(0, 0), b2, voffB); PG8_STAGE(PG8_SB(0, 1), b2 + hsB, voffB); PG8_STAGE(PG8_SA(0, 0), a2, voffA);
            PG8_WAIT_V(8); PG8_WAIT_L(0); PG8_BAR; PG8_MMA(1, 0, At, B0); PG8_MMA(1, 1, At, B1); PG8_BAR; PG8_SCHED;
            PG8_LDB(B0, 1, 0); PG8_LDB(B1, 1, 1); PG8_SCHED; PG8_LDA(At, 1, 0); PG8_STAGE(PG8_SA(0, 1), a2 + hsA, voffA);
            PG8_WAIT_V(8); PG8_WAIT_L(0); PG8_BAR; PG8_MMA(0, 0, At, B0); PG8_MMA(0, 1, At, B1); PG8_BAR; PG8_SCHED;
            PG8_LDA(At, 1, 1); PG8_STAGE(PG8_SB(1, 0), b3, voffB); PG8_STAGE(PG8_SB(1, 1), b3 + hsB, voffB); PG8_STAGE(PG8_SA(1, 0), a3, voffA);
            PG8_WAIT_V(8); PG8_WAIT_L(0); PG8_BAR; PG8_MMA(1, 0, At, B0); PG8_MMA(1, 1, At, B1); PG8_BAR; PG8_SCHED;
            } else {
            PG8_LDB(B0, 0, 0); PG8_SCHED; PG8_LDA(At, 0, 0); PG8_STAGE(PG8_SA(1, 1), a1 + hsA, voffA);
            PG8_WAIT_L(8); PG8_BAR; PG8_WAIT_L(0); PG8_MMA(0, 0, At, B0); PG8_BAR; PG8_SCHED;
            PG8_LDB(B1, 0, 1); PG8_STAGE(PG8_SB(0, 0), b2, voffB);
            PG8_BAR; PG8_WAIT_L(0); PG8_MMA(0, 1, At, B1); PG8_BAR;
            PG8_LDA(At, 0, 1); PG8_STAGE(PG8_SA(0, 0), a2, voffA);
            PG8_BAR; PG8_WAIT_L(0); PG8_MMA(1, 0, At, B0); PG8_BAR; PG8_SCHED;
            PG8_STAGE(PG8_SB(0, 1), b2 + hsB, voffB);
            PG8_WAIT_V(6); PG8_BAR; PG8_MMA(1, 1, At, B1); PG8_BAR;
            PG8_LDB(B0, 1, 0); PG8_SCHED; PG8_LDA(At, 1, 0); PG8_STAGE(PG8_SA(0, 1), a2 + hsA, voffA);
            PG8_WAIT_L(8); PG8_BAR; PG8_WAIT_L(0); PG8_MMA(0, 0, At, B0); PG8_BAR; PG8_SCHED;
            PG8_LDB(B1, 1, 1); PG8_STAGE(PG8_SB(1, 0), b3, voffB);
            PG8_BAR; PG8_WAIT_L(0); PG8_MMA(0, 1, At, B1); PG8_BAR;
            PG8_LDA(At, 1, 1); PG8_STAGE(PG8_SA(1, 0), a3, voffA);
            PG8_BAR; PG8_WAIT_L(0); PG8_MMA(1, 0, At, B0); PG8_BAR; PG8_SCHED;
            PG8_STAGE(PG8_SB(1, 1), b3 + hsB, voffB);
            PG8_WAIT_V(6); PG8_BAR; PG8_MMA(1, 1, At, B1); PG8_BAR;
            }
        }
        if constexpr (ALIGN_EPI) { if (wr == 0) PG8_BAR; }
        if constexpr (!Epi::AFTER_DRAIN) { E(acc, cur, wr, wc, fr, fq); S.done(cur); }
        if (!has_next) break;
#pragma unroll
        for (int a = 0; a < 2; ++a)
#pragma unroll
            for (int b = 0; b < 2; ++b)
#pragma unroll
                for (int m = 0; m < 4; ++m)
#pragma unroll
                    for (int n = 0; n < 2; ++n) acc[a][b][m][n] = (f32x4){0.f, 0.f, 0.f, 0.f};
        cur = nxt; cA = nA; cB = nB; ++ui;
        if constexpr (ALIGN_EPI) { if (wr == 1) PG8_BAR; }
    }
    PG8_WAIT_V(0);
    if constexpr (!ALIGN_EPI) { if (wr == 0) PG8_BAR; }
    PG8_BAR;
#undef PG8_SA
#undef PG8_SB
#undef PG8_STAGE
#undef PG8_LDA
#undef PG8_LDB
#undef PG8_MMA
#undef PG8_WAIT_V
#undef PG8_WAIT_L
#undef PG8_BAR
#undef PG8_SCHED
}
}

constexpr int NWAVES = 8;
constexpr int D = 4096, SEQ = 4096, NB = 2, NMETA = 16, FF = 11008, INC = 12288, HW = 2048, LW = 2048;
constexpr int MR = NB * SEQ;
constexpr int MT = MR + NMETA;
constexpr float EPS = 1e-6f;

constexpr size_t MiB = 1u << 20;
constexpr size_t WS_CTL = 0, CTL_ZERO_BYTES = 32768;
constexpr size_t WS_WGU1 = 1 * MiB;
constexpr size_t WS_WD1  = WS_WGU1 + 172 * MiB;
constexpr size_t WS_WIN  = WS_WD1 + 86 * MiB;
constexpr size_t WS_WOUT = WS_WIN + 96 * MiB;
constexpr size_t WS_WGU2 = WS_WOUT + 32 * MiB;
constexpr size_t WS_WD2  = WS_WGU2 + 172 * MiB;
constexpr size_t WS_WLRU = WS_WD2 + 86 * MiB;
constexpr size_t WS_U    = WS_WLRU + 2 * MiB;
constexpr size_t WS_BIG  = WS_U + 65 * MiB;
constexpr size_t WS_F    = WS_BIG + 193 * MiB;
constexpr size_t WS_HG   = WS_F + 130 * MiB;
constexpr size_t WS_HG2  = WS_HG + 32 * MiB;
constexpr size_t WS_HD   = WS_HG2 + 32 * MiB;
constexpr size_t WS_LC   = WS_HD + 1 * MiB;
constexpr size_t WS_HLOC = WS_LC + 1 * MiB;
constexpr size_t WS_ACUM = WS_HLOC + 32 * MiB;
constexpr size_t WS_Y    = WS_ACUM + 32 * MiB;
constexpr size_t WS_HB   = WS_Y + 64 * MiB;
constexpr size_t WS_END  = WS_HB + 64 * MiB;
static_assert((size_t)MT * INC * 2 <= 193 * MiB && (size_t)MT * D * 4 <= 130 * MiB && (size_t)MT * D * 2 <= 65 * MiB, "ws map");
constexpr int CW_BAR = 4096;

constexpr int RING_OFF = 0, RING_BYTES = 131072;
constexpr int LDS_BYTES = 163840;
constexpr int LDSCTL_OFF = LDS_BYTES - 1024, MISC_OFF = LDSCTL_OFF + 320;

#define GAS __attribute__((address_space(1)))
#define LAS __attribute__((address_space(3)))
typedef unsigned short bf16;
typedef unsigned v4u __attribute__((ext_vector_type(4)));
typedef unsigned v2u __attribute__((ext_vector_type(2)));
typedef float f32x4 __attribute__((ext_vector_type(4)));
typedef short bf16x8 __attribute__((ext_vector_type(8)));
typedef GAS unsigned gu32;
#define RLX_AGENT __ATOMIC_RELAXED, __HIP_MEMORY_SCOPE_AGENT
#define LDS_WAIT() asm volatile("s_waitcnt lgkmcnt(0)" ::: "memory")
#define VM_WAIT() asm volatile("s_waitcnt vmcnt(0)" ::: "memory")
__device__ __forceinline__ unsigned f2bf(float f) { unsigned u = __builtin_bit_cast(unsigned, f); return (u + 0x7fffu + ((u >> 16) & 1u)) >> 16; }
typedef float f32x2_t __attribute__((ext_vector_type(2)));
typedef __bf16 bf16x2_t __attribute__((ext_vector_type(2)));
__device__ __forceinline__ unsigned pk2(float lo, float hi) { const f32x2_t v = {lo, hi}; const bf16x2_t b = __builtin_convertvector(v, bf16x2_t); return __builtin_bit_cast(unsigned, b); }
__device__ __forceinline__ bf16 f2bf16(float x) { return (bf16)(pk2(x, x) & 0xffffu); }
__device__ __forceinline__ float bflo(unsigned w) { return __uint_as_float(w << 16); }
__device__ __forceinline__ float bfhi(unsigned w) { return __uint_as_float(w & 0xffff0000u); }
__device__ __forceinline__ float bf2f(bf16 v) { return __uint_as_float(((unsigned)v) << 16); }

#define XB_TMO      128
#define XB_XCNT(j)  (256  + 64 * (j))
#define XB_XSUB(j)  (1280 + 64 * (j))
#define XB_XGEN(j)  (2304 + 64 * (j))
#define XB_TOP      3328
#define XB_TOPGEN   3392
#define XCD_BAR_WORDS 3456
#define XB_SPIN_CAP (1u << 18)

__device__ __forceinline__ unsigned xb_ld(unsigned* p)              { return __hip_atomic_load(p, __ATOMIC_RELAXED, __HIP_MEMORY_SCOPE_AGENT); }
__device__ __forceinline__ unsigned xb_add(unsigned* p, unsigned v) { return __hip_atomic_fetch_add(p, v, __ATOMIC_RELAXED, __HIP_MEMORY_SCOPE_AGENT); }
__device__ __forceinline__ unsigned xb_xcc_id() { return (unsigned)__builtin_amdgcn_s_getreg((3 << 11) | 20) & 0xFu; }
#define XB_SPIN(cond, bar) do { unsigned _sp = 0; while (cond) { __builtin_amdgcn_s_sleep(1); \
    if ((++_sp & 255u) == 0u) { if (xb_ld(&(bar)[XB_TMO])) break; if (_sp > XB_SPIN_CAP) { atomicAdd(&(bar)[XB_TMO], 1u); break; } } } } while (0)

struct XcdBarrier {
    unsigned* bar; unsigned x;
    volatile LAS unsigned* st;
};
__device__ __forceinline__ XcdBarrier xcd_barrier_post(unsigned* bar, volatile LAS unsigned* st) {
    XcdBarrier b; b.bar = bar; b.x = xb_xcc_id(); b.st = st;
    if (threadIdx.x == 0) (void)xb_add(&bar[XB_XCNT(b.x)], 1u);
    return b;
}
__device__ __forceinline__ void xcd_barrier_complete(unsigned* bar, unsigned x, unsigned& nloc, unsigned& nx) {
    const unsigned G = gridDim.x * gridDim.y * gridDim.z;
    unsigned sum, cnt, mine, sp = 0u;
    for (;;) {
        sum = 0u; cnt = 0u; mine = 0u;
#pragma unroll
        for (unsigned j = 0; j < 16; ++j) { const unsigned c = xb_ld(&bar[XB_XCNT(j)]); sum += c; cnt += (c > 0u) ? 1u : 0u; mine = (j == x) ? c : mine; }
        if (sum == G) break;
        __builtin_amdgcn_s_sleep(1);
        if ((++sp & 255u) == 0u) { if (xb_ld(&bar[XB_TMO])) break; if (sp > XB_SPIN_CAP) { atomicAdd(&bar[XB_TMO], 1u); break; } }
    }
    nloc = mine > 0u ? mine : 1u; nx = cnt > 0u ? cnt : 1u;
}
__device__ __forceinline__ void xcd_barrier(const XcdBarrier& b) {
    asm volatile("s_waitcnt vmcnt(0)" ::: "memory");
    __syncthreads();
    if (threadIdx.x == 0) {
        unsigned* bar = b.bar;
        __builtin_amdgcn_s_waitcnt(0);
        unsigned nloc = b.st[0], nx = b.st[1];
        if (nloc == 0u) { xcd_barrier_complete(bar, b.x, nloc, nx); b.st[0] = nloc; b.st[1] = nx; }
        const unsigned old = xb_add(&bar[XB_XSUB(b.x)], 1u);
        const unsigned gen = old / nloc;
        if (old + 1u == (gen + 1u) * nloc) {
            __builtin_amdgcn_fence(__ATOMIC_RELEASE, "agent");
            asm volatile("s_waitcnt vmcnt(0)" ::: "memory");
            const unsigned og = xb_add(&bar[XB_TOP], 1u);
            const unsigned tg = og / nx;
            if (og + 1u == (tg + 1u) * nx) xb_add(&bar[XB_TOPGEN], 1u);
            else XB_SPIN(xb_ld(&bar[XB_TOPGEN]) == tg, bar);
            __builtin_amdgcn_fence(__ATOMIC_ACQUIRE, "agent");
            xb_add(&bar[XB_XGEN(b.x)], 1u);
            asm volatile("s_waitcnt vmcnt(0)" ::: "memory");
        } else {
            XB_SPIN(xb_ld(&bar[XB_XGEN(b.x)]) == gen, bar);
            __builtin_amdgcn_fence(__ATOMIC_ACQUIRE, "agent");
            asm volatile("s_waitcnt vmcnt(0)" ::: "memory");
        }
    }
    __syncthreads();
}


struct Frame {
    LAS unsigned char* lds;
    volatile LAS unsigned* MISC;
    gu32* ctl;
    int tid, lane, wave;
    int vcu, G;
};

__device__ __forceinline__ int opaque_lane() { int l; asm volatile("v_mbcnt_lo_u32_b32 %0, -1, 0\n\tv_mbcnt_hi_u32_b32 %0, -1, %0" : "=v"(l)); return l; }
#define opaque_tid() ((F.wave << 6) + opaque_lane())
__device__ __forceinline__ float wave_sum(float v) {
#pragma unroll
    for (int o = 1; o < 64; o <<= 1) v += __shfl_xor(v, o);
    return v;
}
__device__ __forceinline__ float sigmoidf_(float x) { return __builtin_amdgcn_rcpf(1.0f + __builtin_amdgcn_exp2f(-1.44269504089f * x)); }
__device__ __forceinline__ float siluf_(float x) { return x * sigmoidf_(x); }
__device__ __forceinline__ float gelu_tanh(float x) { const float z = 0.7978845608028654f * (x + 0.044715f * x * x * x); const float t = __builtin_amdgcn_exp2f(2.88539008178f * z); return x * (1.0f - __builtin_amdgcn_rcpf(t + 1.0f)); }

constexpr int TP = 65;
__device__ __forceinline__ void p0_item_load(f32x4 (&v)[16], const float* W, int N, int k0, int n0, int lane) {
    const int rq = lane >> 4, cq = 4 * (lane & 15);
#pragma unroll
    for (int i = 0; i < 16; ++i) v[i] = __builtin_nontemporal_load((const GAS f32x4*)(W + (size_t)(k0 + 4 * i + rq) * N + n0 + cq));
}
__device__ __forceinline__ void p0_item_store(const f32x4 (&v)[16], bf16* WT, int ldo, int out_row0, int k0, LAS float* scr, int lane) {
    const int rq = lane >> 4, cq = 4 * (lane & 15);
#pragma unroll
    for (int i = 0; i < 16; ++i) { LAS float* d = scr + (4 * i + rq) * TP + cq; d[0] = v[i].x; d[1] = v[i].y; d[2] = v[i].z; d[3] = v[i].w; }
    LDS_WAIT(); asm volatile("" ::: "memory");
    const int c = lane & 7;
#pragma unroll
    for (int j = 0; j < 8; ++j) { const int n = (lane >> 3) + 8 * j; const LAS float* sp = scr + (8 * c) * TP + n;
        v4u o; o.x = pk2(sp[0 * TP], sp[1 * TP]); o.y = pk2(sp[2 * TP], sp[3 * TP]); o.z = pk2(sp[4 * TP], sp[5 * TP]); o.w = pk2(sp[6 * TP], sp[7 * TP]);
        __builtin_nontemporal_store(o, (GAS v4u*)(WT + (size_t)(out_row0 + n) * ldo + k0 + 8 * c)); }
    LDS_WAIT(); asm volatile("" ::: "memory");
}
__device__ __forceinline__ void p0_item_store_blk(const f32x4 (&v)[16], bf16* WT, int K, int out_row0, int k0, LAS float* scr, int lane) {
    const int rq = lane >> 4, cq = 4 * (lane & 15);
#pragma unroll
    for (int i = 0; i < 16; ++i) { LAS float* d = scr + (4 * i + rq) * TP + cq; d[0] = v[i].x; d[1] = v[i].y; d[2] = v[i].z; d[3] = v[i].w; }
    LDS_WAIT(); asm volatile("" ::: "memory");
    const int bi = lane >> 2, ch = lane & 3;
#pragma unroll
    for (int s8 = 0; s8 < 8; ++s8) { const int rbl = s8 >> 1, kbl = s8 & 1; const int n = 32 * (rbl >> 1) + 8 * (bi >> 2) + 4 * (rbl & 1) + (bi & 3);
        const LAS float* sa = scr + (32 * kbl + 8 * ch + 4 * (ch & 1)) * TP + n; const LAS float* sb = scr + (32 * kbl + 8 * ch + 4 - 4 * (ch & 1)) * TP + n;
        const unsigned p0 = pk2(sa[0 * TP], sa[1 * TP]), p1 = pk2(sa[2 * TP], sa[3 * TP]), p2 = pk2(sb[0 * TP], sb[1 * TP]), p3 = pk2(sb[2 * TP], sb[3 * TP]);
        const bool od = ch & 1; v4u o; o.x = od ? p2 : p0; o.y = od ? p3 : p1; o.z = od ? p0 : p2; o.w = od ? p1 : p3;
        *(GAS v4u*)(WT + ((size_t)((out_row0 >> 4) + rbl) * (K >> 5) + (k0 >> 5) + kbl) * 512 + bi * 32 + 8 * ch) = o; }
    LDS_WAIT(); asm volatile("" ::: "memory");
}
__device__ __forceinline__ void p0_transpose_matrix(const float* W, int K, int N, bf16* WT, int mode, int row_base, LAS float* scr, int gw, int NGW, int lane) {
    const int nblk = N / 64, nitems = (K / 64) * nblk;
    int it = gw; if (it >= nitems) return;
    f32x4 v[16], w[16];
    p0_item_load(v, W, N, 64 * (it / nblk), 64 * (it % nblk), lane);
    for (;;) {
        const int nx = it + NGW; const bool more = nx < nitems;
        if (more) p0_item_load(w, W, N, 64 * (nx / nblk), 64 * (nx % nblk), lane);
        { const int n0 = 64 * (it % nblk); const int r0 = row_base + (mode == 0 ? n0 : (256 * (n0 >> 7) + (n0 & 127) + (mode == 2 ? 128 : 0)));
          p0_item_store(v, WT, K, r0, 64 * (it / nblk), scr, lane); }
        if (!more) break;
#pragma unroll
        for (int i = 0; i < 16; ++i) v[i] = w[i];
        it = nx;
    }
}

struct Args { const float* in[26]; float* out; unsigned char* ws; };
struct P0Item { const float* W; bf16* WT; int K, N, mode, row_base, local; };
constexpr int P0_FFN = (D / 64) * (FF / 64), P0_IN = (D / 64) * (INC / 64), P0_OUT = (D / 64) * (D / 64), P0_LRU = 16 * 16;
constexpr int P0_TOTAL = 6 * P0_FFN + P0_IN + P0_OUT + P0_LRU;
__device__ __forceinline__ P0Item p0_decode(int g, const Args& args, bf16* WGU1, bf16* WD1, bf16* WIN, bf16* WOUT, bf16* WGU2, bf16* WD2, bf16* WLRU) {
    P0Item t;
    if (g < P0_FFN)               { t.W = args.in[3];  t.WT = WGU1; t.K = D;  t.N = FF;  t.mode = 1; t.row_base = 0; t.local = g; return t; } g -= P0_FFN;
    if (g < P0_FFN)               { t.W = args.in[4];  t.WT = WGU1; t.K = D;  t.N = FF;  t.mode = 2; t.row_base = 0; t.local = g; return t; } g -= P0_FFN;
    if (g < P0_FFN)               { t.W = args.in[5];  t.WT = WD1;  t.K = FF; t.N = D;   t.mode = 0; t.row_base = 0; t.local = g; return t; } g -= P0_FFN;
    if (g < P0_IN)                { t.W = args.in[8];  t.WT = WIN;  t.K = D;  t.N = INC; t.mode = 0; t.row_base = 0; t.local = g; return t; } g -= P0_IN;
    if (g < P0_OUT)               { t.W = args.in[19]; t.WT = WOUT; t.K = D;  t.N = D;   t.mode = 0; t.row_base = 0; t.local = g; return t; } g -= P0_OUT;
    if (g < P0_FFN)               { t.W = args.in[22]; t.WT = WGU2; t.K = D;  t.N = FF;  t.mode = 1; t.row_base = 0; t.local = g; return t; } g -= P0_FFN;
    if (g < P0_FFN)               { t.W = args.in[23]; t.WT = WGU2; t.K = D;  t.N = FF;  t.mode = 2; t.row_base = 0; t.local = g; return t; } g -= P0_FFN;
    if (g < P0_FFN)               { t.W = args.in[24]; t.WT = WD2;  t.K = FF; t.N = D;   t.mode = 0; t.row_base = 0; t.local = g; return t; } g -= P0_FFN;
    { const int hd = g >> 5, which = (g >> 4) & 1; t.W = (which ? args.in[15] : args.in[13]) + (size_t)hd * 65536; t.WT = WLRU; t.K = 256; t.N = 256; t.mode = 1 + which; t.row_base = 512 * hd; t.local = g & 15; return t; }
}
__device__ __forceinline__ void rms_row_to_bf16(const float* xrow, const float* gain, bf16* Ub, int m, int lane);
__device__ __forceinline__ int p0_convert_all(const Args& args, bf16* WGU1, bf16* WD1, bf16* WIN, bf16* WOUT, bf16* WGU2, bf16* WD2, bf16* WLRU, LAS float* scr, int gw, int NGW, int lane, bf16* Ub) {
    int it = gw, jn = 0, rows = 0; if (it >= P0_TOTAL) return 0;
    f32x4 v[16], w[16];
    P0Item cur = p0_decode(it, args, WGU1, WD1, WIN, WOUT, WGU2, WD2, WLRU), nxt = cur;
    { const int nnb = cur.N / 64; p0_item_load(v, cur.W, cur.N, 64 * (cur.local / nnb), 64 * (cur.local % nnb), lane); }
    for (;;) {
        const int nx = it + NGW; const bool more = nx < P0_TOTAL;
        if (more) { nxt = p0_decode(nx, args, WGU1, WD1, WIN, WOUT, WGU2, WD2, WLRU); const int nnb = nxt.N / 64; p0_item_load(w, nxt.W, nxt.N, 64 * (nxt.local / nnb), 64 * (nxt.local % nnb), lane); }
        { const int nnb = cur.N / 64, n0 = 64 * (cur.local % nnb); const int r0 = cur.row_base + (cur.mode == 0 ? n0 : (256 * (n0 >> 7) + (n0 & 127) + (cur.mode == 2 ? 128 : 0)));
          if (cur.K == 256) p0_item_store(v, cur.WT, cur.K, r0, 64 * (cur.local / nnb), scr, lane);
          else p0_item_store_blk(v, cur.WT, cur.K, r0, 64 * (cur.local / nnb), scr, lane); }
        if ((++jn & 7) == 0) { const int m = gw + rows * NGW; if (m < MT) { rms_row_to_bf16(m < MR ? args.in[0] + (size_t)m * D : args.in[1] + (size_t)(m - MR) * D, args.in[2], Ub, m, lane); ++rows; } }
        if (!more) break;
#pragma unroll
        for (int i = 0; i < 16; ++i) v[i] = w[i];
        cur = nxt; it = nx;
    }
    return rows;
}

__device__ __forceinline__ size_t blk_off(int m, int c, int Kd) { return (((size_t)(m >> 4) * (Kd >> 5) + (c >> 5)) << 9) + ((m & 15) << 5) + (c & 31); }
__device__ __forceinline__ void rms_row_to_bf16(const float* xrow, const float* gain, bf16* Ub, int m, int lane) {
    f32x4 v[16]; float s = 0.f;
#pragma unroll
    for (int j = 0; j < 8; ++j) { const GAS f32x4* xp = (const GAS f32x4*)(xrow + 8 * (lane + 64 * j)); v[2 * j] = xp[0]; v[2 * j + 1] = xp[1]; }
#pragma unroll
    for (int j = 0; j < 16; ++j) s += (v[j].x * v[j].x + v[j].y * v[j].y) + (v[j].z * v[j].z + v[j].w * v[j].w);
    const float rs = __builtin_amdgcn_rsqf(wave_sum(s) * (1.f / D) + EPS);
#pragma unroll
    for (int j = 0; j < 8; ++j) { const GAS f32x4* gp = (const GAS f32x4*)(gain + 8 * (lane + 64 * j)); const f32x4 g0 = gp[0], g1 = gp[1], a = v[2 * j], b = v[2 * j + 1];
        v4u w; w.x = pk2(a.x * rs * g0.x, a.y * rs * g0.y); w.y = pk2(a.z * rs * g0.z, a.w * rs * g0.w); w.z = pk2(b.x * rs * g1.x, b.y * rs * g1.y); w.w = pk2(b.z * rs * g1.z, b.w * rs * g1.w);
        *(GAS v4u*)(Ub + (size_t)m * D + 8 * (lane + 64 * j)) = w; }
}

__device__ __forceinline__ void unpack8(const v4u w, f32x4& a, f32x4& b) { a = (f32x4){bflo(w.x), bfhi(w.x), bflo(w.y), bfhi(w.y)}; b = (f32x4){bflo(w.z), bfhi(w.z), bflo(w.w), bfhi(w.w)}; }
template <int HMODE>
__device__ __forceinline__ void norm_rows(const bf16* f, const float* hin_real, const float* hin_meta, const bf16* hin_b, bf16* hout_b, float* hout_f, bf16* uout, const float* gpost, const float* gpre, float coef, int nrows, int gw, int NGW) {
    int lane = opaque_lane();
    for (int row = gw; row < nrows; row += NGW) {
        asm volatile("" : "+v"(lane));
        const size_t ro = (size_t)row * D + 8 * lane;
        f32x4 v[16]; float s = 0.f;
#pragma unroll
        for (int j = 0; j < 8; ++j) { const v4u w = *(const GAS v4u*)(f + ro + 512 * j); unpack8(w, v[2 * j], v[2 * j + 1]); }
#pragma unroll
        for (int j = 0; j < 16; ++j) s += (v[j].x * v[j].x + v[j].y * v[j].y) + (v[j].z * v[j].z + v[j].w * v[j].w);
        const float rs = coef * __builtin_amdgcn_rsqf(wave_sum(s) * (1.f / D) + EPS);
        float s2 = 0.f;
#pragma unroll
        for (int j = 0; j < 8; ++j) { const GAS f32x4* gp = (const GAS f32x4*)(gpost + 8 * lane + 512 * j); const f32x4 g0 = gp[0], g1 = gp[1]; f32x4 h0, h1;
            if (HMODE == 0) { const GAS f32x4* hp = (const GAS f32x4*)((row < MR ? hin_real + (size_t)row * D : hin_meta + (size_t)(row - MR) * D) + 8 * lane + 512 * j); h0 = hp[0]; h1 = hp[1]; }
            else { const v4u hw = *(const GAS v4u*)(hin_b + ro + 512 * j); unpack8(hw, h0, h1); }
            v[2 * j] = h0 + v[2 * j] * rs * g0; v[2 * j + 1] = h1 + v[2 * j + 1] * rs * g1; }
#pragma unroll
        for (int j = 0; j < 16; ++j) s2 += (v[j].x * v[j].x + v[j].y * v[j].y) + (v[j].z * v[j].z + v[j].w * v[j].w);
        if (HMODE == 2) {
#pragma unroll
            for (int j = 0; j < 8; ++j) { GAS f32x4* op = (GAS f32x4*)(hout_f + ro + 512 * j); op[0] = v[2 * j]; op[1] = v[2 * j + 1]; }
        } else if (row < MR) {
#pragma unroll
            for (int j = 0; j < 8; ++j) { const f32x4 a = v[2 * j], b = v[2 * j + 1]; v4u w; w.x = pk2(a.x, a.y); w.y = pk2(a.z, a.w); w.z = pk2(b.x, b.y); w.w = pk2(b.z, b.w); *(GAS v4u*)(hout_b + ro + 512 * j) = w; } }
        if (uout != nullptr) { const float rs2 = __builtin_amdgcn_rsqf(wave_sum(s2) * (1.f / D) + EPS);
#pragma unroll
            for (int j = 0; j < 8; ++j) { const GAS f32x4* gp = (const GAS f32x4*)(gpre + 8 * lane + 512 * j); const f32x4 g0 = gp[0], g1 = gp[1], a = v[2 * j], b = v[2 * j + 1];
                v4u w; w.x = pk2(a.x * rs2 * g0.x, a.y * rs2 * g0.y); w.y = pk2(a.z * rs2 * g0.z, a.w * rs2 * g0.w); w.z = pk2(b.x * rs2 * g1.x, b.y * rs2 * g1.y); w.w = pk2(b.z * rs2 * g1.z, b.w * rs2 * g1.w);
                *(GAS v4u*)(uout + ro + 512 * j) = w; } }
    }
}

#define MFMA_SETTLE1(a) asm volatile("s_nop 7\n\ts_nop 7" : "+v"(a))
#define MFMA_SETTLE2(a, b) asm volatile("s_nop 7\n\ts_nop 7" : "+v"(a), "+v"(b))
#define MFMA_SETTLE4(a, b, c, d) asm volatile("s_nop 7\n\ts_nop 7" : "+v"(a), "+v"(b), "+v"(c), "+v"(d))
#define MFMA_SETTLE8(a, b, c, d, e, f, g, h) asm volatile("s_nop 7\n\ts_nop 7" : "+v"(a), "+v"(b), "+v"(c), "+v"(d), "+v"(e), "+v"(f), "+v"(g), "+v"(h))
template <int NACC, int T, class Map, class Epi>
__device__ __forceinline__ void skinny_phase(Frame& F, const bf16* A, int lda, const bf16* Bt, int ldb, int K, int ntiles, const Map& mp, const Epi& epi) {
    LAS f32x4* red = (LAS f32x4*)(F.lds + RING_OFF);
    const int lane = opaque_lane();
    const int ks = K / 8, k_lo = F.wave * ks, r = lane & 15, q = lane >> 4;
    const int rot = 32 * (int)((blockIdx.x * 7u + F.wave * 3u) % (unsigned)(ks / 32));
    for (int t0 = blockIdx.x; t0 < ntiles; t0 += F.G * T) {
        int brow[T][NACC], acol = 0; bool valid[T];
#pragma unroll
        for (int j = 0; j < T; ++j) { const int tj = t0 + j * F.G; valid[j] = tj < ntiles; mp(valid[j] ? tj : t0, brow[j], acol); }
        f32x4 acc[T][NACC];
#pragma unroll
        for (int j = 0; j < T; ++j)
#pragma unroll
            for (int i = 0; i < NACC; ++i) acc[j][i] = (f32x4){0.f, 0.f, 0.f, 0.f};
        const bf16* ap = lda == 0 ? A + (((size_t)(MR >> 4) * (K >> 5) + (k_lo >> 5)) << 9) + r * 32 + 8 * q : A + (size_t)(MR + r) * lda + k_lo + 8 * q;
        const int astep = lda == 0 ? 16 : 1;
        const bf16* bp[T][NACC];
#pragma unroll
        for (int j = 0; j < T; ++j)
#pragma unroll
            for (int i = 0; i < NACC; ++i) bp[j][i] = Bt + ((size_t)brow[j][i] * (K >> 5) + (k_lo >> 5)) * 512 + r * 32 + 8 * q;
#pragma unroll 4
        for (int k0 = 0; k0 < ks; k0 += 32) {
            int k = k0 + rot; k = k >= ks ? k - ks : k;
            const bf16x8 a = *(const GAS bf16x8*)(ap + k * astep);
#pragma unroll
            for (int j = 0; j < T; ++j)
#pragma unroll
                for (int i = 0; i < NACC; ++i) { const bf16x8 b = *(const GAS bf16x8*)(bp[j][i] + k * 16); acc[j][i] = __builtin_amdgcn_mfma_f32_16x16x32_bf16(b, a, acc[j][i], 0, 0, 0); }
        }
#pragma unroll
        for (int j = 0; j < T; ++j)
#pragma unroll
            for (int i = 0; i < NACC; ++i) MFMA_SETTLE1(acc[j][i]);
#pragma unroll
        for (int j = 0; j < T; ++j)
#pragma unroll
            for (int i = 0; i < NACC; ++i) red[((F.wave * T + j) * NACC + i) * 64 + lane] = acc[j][i];
        LDS_WAIT(); __syncthreads();
#pragma unroll
        for (int j = 0; j < T; ++j) if (F.wave == j && valid[j]) {
            f32x4 sred[NACC];
#pragma unroll
            for (int i = 0; i < NACC; ++i) { sred[i] = red[(j * NACC + i) * 64 + lane];
#pragma unroll
                for (int w = 1; w < 8; ++w) sred[i] += red[((w * T + j) * NACC + i) * 64 + lane]; }
            epi(t0 + j * F.G, r, q, sred);
        }
        __syncthreads();
    }
}
struct MapPlain { __device__ __forceinline__ void operator()(int tile, int (&brow)[1], int& acol) const { brow[0] = tile; acol = 0; } };
struct MapGateUp { __device__ __forceinline__ void operator()(int tile, int (&brow)[2], int& acol) const { const int j0 = 32 * (tile >> 1); brow[0] = ((256 * (j0 >> 7) + (j0 & 127)) >> 4) + (tile & 1); brow[1] = brow[0] + 8; acol = 0; } };
struct MapLru { __device__ __forceinline__ void operator()(int tile, int (&brow)[2], int& acol) const { const int c0 = 16 * tile, head = c0 >> 8, w = c0 & 255; brow[0] = 256 * (2 * head + (w >> 7)) + (w & 127); brow[1] = brow[0] + 128; acol = head * 256; } };
struct SkEpiSwiGLU { bf16* O; __device__ __forceinline__ void operator()(int tile, int r, int q, const f32x4 (&s)[2]) const {
    v2u w; w.x = pk2(siluf_(s[0][0]) * s[1][0], siluf_(s[0][1]) * s[1][1]); w.y = pk2(siluf_(s[0][2]) * s[1][2], siluf_(s[0][3]) * s[1][3]);
    *(GAS v2u*)(O + ((((size_t)(MR >> 4)) * (FF >> 5) + (tile >> 1)) << 9) + r * 32 + 8 * q + 4 * (tile & 1)) = w; } };
struct SkEpiF32 { float* C; int ldc; __device__ __forceinline__ void operator()(int tile, int r, int q, const f32x4 (&s)[1]) const { *(GAS f32x4*)(C + (size_t)(MR + r) * ldc + 16 * tile + 4 * q) = s[0]; } };
struct SkEpiBf16 { bf16* O; int ldc; __device__ __forceinline__ void operator()(int tile, int r, int q, const f32x4 (&s)[1]) const {
    v2u w; w.x = pk2(s[0][0], s[0][1]); w.y = pk2(s[0][2], s[0][3]); *(GAS v2u*)(O + (size_t)(MR + r) * ldc + 32 * (tile >> 1) + 8 * q + 4 * (tile & 1)) = w; } };
struct SkEpiLru { float* Aout; float* Dout; const bf16* XC; const float* b_a; const float* b_x; const float* lam;
    __device__ __forceinline__ void operator()(int tile, int r, int q, const f32x4 (&s)[2]) const {
        const int ch = 16 * tile + 4 * q; const size_t ro = (size_t)(MR + r) * LW + ch; const v2u xw = *(const GAS v2u*)(XC + ro);
        const float xv[4] = {bflo(xw.x), bfhi(xw.x), bflo(xw.y), bfhi(xw.y)}; f32x4 av, dv;
#pragma unroll
        for (int e = 0; e < 4; ++e) { float a, d; pg8::lru_gate_math(s[0][e], s[1][e], b_a[ch + e], b_x[ch + e], pg8::softplus_neg(lam[ch + e]), xv[e], a, d); av[e] = a; dv[e] = d; }
        *(GAS f32x4*)(Aout + ro) = av; *(GAS f32x4*)(Dout + ro) = dv; } };

constexpr int HG_PQ = 136, HG_PT = 72;
constexpr int HG_Q = 0, HG_Q0 = HG_Q + 64 * HG_PQ * 2, HG_K = HG_Q0 + 64 * HG_PQ * 2, HG_KT = HG_K + 64 * HG_PQ * 2, HG_VT = HG_KT + 128 * HG_PT * 2,
              HG_P = HG_VT + 128 * HG_PT * 2, HG_ST = HG_P + 64 * HG_PT * 2, HG_PART = HG_ST + 128 * HG_PQ * 2, HG_EL = HG_PART + 8 * 128 * 4, HG_RS = HG_EL + 128 * 4, HG_END = HG_RS + 8 * 64 * 4;
static_assert(HG_END <= LDSCTL_OFF, "HGRN LDS map");
#define WG_SYNC() do { asm volatile("s_waitcnt vmcnt(0) lgkmcnt(0)" ::: "memory"); __builtin_amdgcn_s_barrier(); asm volatile("" ::: "memory"); } while (0)
#define LSYNC() do { asm volatile("s_waitcnt lgkmcnt(0)" ::: "memory"); __builtin_amdgcn_s_barrier(); asm volatile("" ::: "memory"); } while (0)
__device__ __forceinline__ void norm_meta_row(Frame& F, int m, const bf16* f, const float* meta, bf16* uout, const float* gpost, const float* gpre, float coef) {
    const int tid = opaque_tid(); LAS float* red = (LAS float*)F.lds;
    const size_t ro = (size_t)(MR + m) * D + 8 * tid;
    const v4u fw = *(const GAS v4u*)(f + ro);
    const f32x4 h0 = *(const GAS f32x4*)(meta + (size_t)m * D + 8 * tid), h1 = *(const GAS f32x4*)(meta + (size_t)m * D + 8 * tid + 4);
    const f32x4 g0 = *(const GAS f32x4*)(gpost + 8 * tid), g1 = *(const GAS f32x4*)(gpost + 8 * tid + 4), p0 = *(const GAS f32x4*)(gpre + 8 * tid), p1 = *(const GAS f32x4*)(gpre + 8 * tid + 4);
    float fv[8] = {bflo(fw.x), bfhi(fw.x), bflo(fw.y), bfhi(fw.y), bflo(fw.z), bfhi(fw.z), bflo(fw.w), bfhi(fw.w)};
    float s1 = 0.f;
#pragma unroll
    for (int e = 0; e < 8; ++e) s1 += fv[e] * fv[e];
    s1 = wave_sum(s1); if ((tid & 63) == 0) red[F.wave] = s1;
    WG_SYNC();
    float t1 = 0.f;
#pragma unroll
    for (int w = 0; w < 8; ++w) t1 += red[w];
    const float rs = coef * __builtin_amdgcn_rsqf(t1 * (1.f / D) + EPS);
    const float hv[8] = {h0.x + fv[0] * rs * g0.x, h0.y + fv[1] * rs * g0.y, h0.z + fv[2] * rs * g0.z, h0.w + fv[3] * rs * g0.w, h1.x + fv[4] * rs * g1.x, h1.y + fv[5] * rs * g1.y, h1.z + fv[6] * rs * g1.z, h1.w + fv[7] * rs * g1.w};
    float s2 = 0.f;
#pragma unroll
    for (int e = 0; e < 8; ++e) s2 += hv[e] * hv[e];
    s2 = wave_sum(s2); if ((tid & 63) == 0) red[8 + F.wave] = s2;
    WG_SYNC();
    float t2 = 0.f;
#pragma unroll
    for (int w = 0; w < 8; ++w) t2 += red[8 + w];
    const float rs2 = __builtin_amdgcn_rsqf(t2 * (1.f / D) + EPS);
    v4u o; o.x = pk2(hv[0] * rs2 * p0.x, hv[1] * rs2 * p0.y); o.y = pk2(hv[2] * rs2 * p0.z, hv[3] * rs2 * p0.w); o.z = pk2(hv[4] * rs2 * p1.x, hv[5] * rs2 * p1.y); o.w = pk2(hv[6] * rs2 * p1.z, hv[7] * rs2 * p1.w);
    *(GAS v4u*)(uout + ro) = o;
    WG_SYNC();
}

typedef LAS unsigned char* ldsp;
__device__ __forceinline__ bf16x8 lds_frag(ldsp base, int row, int pitch, int col) { return *(const LAS bf16x8*)(base + (row * pitch + col) * 2); }

template <bool PASS_C>
__device__ __forceinline__ void hgrn_unit(Frame& F, int unit, const bf16* proj, const float* lbl, const float* gn, float* HG, float* HD, bf16* Y) {
    const int tid = opaque_tid(), lane = tid & 63, w = F.wave, r = lane & 15, q = lane >> 4;
    const int b = unit >> 8, h = (unit >> 4) & 15, c = unit & 15;
    ldsp L = F.lds;
    const int ch0 = 2 * lane;
    const float lb0 = sigmoidf_(lbl[h * 128 + ch0] - lbl[HW + h * 128 + ch0]), lb1 = sigmoidf_(lbl[h * 128 + ch0 + 1] - lbl[HW + h * 128 + ch0 + 1]);
    f32x4 st[8];
    float* Gu = HG + (size_t)unit * 16384;
    if (PASS_C) {
#pragma unroll
        for (int tk = 0; tk < 8; ++tk)
#pragma unroll
            for (int e = 0; e < 4; ++e) st[tk][e] = Gu[(16 * w + 4 * q + e) * 128 + 16 * tk + r];
#pragma unroll
        for (int tk = 0; tk < 8; ++tk)
#pragma unroll
            for (int e = 0; e < 4; ++e) *(LAS bf16*)(L + HG_ST + ((16 * w + 4 * q + e) * HG_PQ + 16 * tk + r) * 2) = f2bf16(st[tk][e]);
    } else {
#pragma unroll
        for (int tk = 0; tk < 8; ++tk) st[tk] = (f32x4){0.f, 0.f, 0.f, 0.f};
    }
    float tl0 = 0.f, tl1 = 0.f;
    const int nch = (c == 0) ? 5 : 4;
    unsigned Lf[8], Lv[8], Lq[8];
#define HG_LOAD(cj) do { const bool mc_ = (c == 0 && (cj) == 0); const size_t r0_ = (size_t)b * SEQ + c * 256 + ((c == 0) ? (cj) - 1 : (cj)) * 64; \
        _Pragma("unroll") for (int i = 0; i < 8; ++i) { const int t = 8 * w + i; const size_t row = mc_ ? (size_t)(MR + (t < 48 ? 0 : t - 48)) : r0_ + t; const bf16* pr = proj + row * INC + h * 128 + ch0; \
            Lf[i] = *(const GAS unsigned*)(pr + HW); Lv[i] = *(const GAS unsigned*)(pr + 2 * HW); if (PASS_C) Lq[i] = *(const GAS unsigned*)pr; } } while (0)
    HG_LOAD(0);
    for (int ci = 0; ci < nch; ++ci) {
        const bool metac = (c == 0 && ci == 0);
        const int s = (c == 0) ? ci - 1 : ci;
        const size_t row0 = (size_t)b * SEQ + c * 256 + s * 64;
        float lc0[8], lc1[8], kk0[8], kk1[8], qa0[8], qa1[8]; unsigned vv[8];
        float run0 = 0.f, run1 = 0.f;
#pragma unroll
        for (int i = 0; i < 8; ++i) { const int t = 8 * w + i; const bool nul = metac && t < 48;
            const unsigned fw = Lf[i]; const unsigned vw = Lv[i];
            const float sg0 = sigmoidf_(bflo(fw)), sg1 = sigmoidf_(bfhi(fw));
            const float l0 = nul ? 0.f : __logf(lb0 + (1.f - lb0) * sg0), l1 = nul ? 0.f : __logf(lb1 + (1.f - lb1) * sg1);
            run0 += l0; run1 += l1; lc0[i] = run0; lc1[i] = run1;
            kk0[i] = nul ? 0.f : (1.f - lb0) * (1.f - sg0); kk1[i] = nul ? 0.f : (1.f - lb1) * (1.f - sg1); vv[i] = nul ? 0u : vw;
            if (PASS_C) { const unsigned qw = Lq[i]; qa0[i] = nul ? 0.f : siluf_(bflo(qw)); qa1[i] = nul ? 0.f : siluf_(bfhi(qw)); } }
        if (ci + 1 < nch) HG_LOAD(ci + 1);
        *(LAS float*)(L + HG_PART + (w * 128 + ch0) * 4) = run0; *(LAS float*)(L + HG_PART + (w * 128 + ch0 + 1) * 4) = run1;
        LSYNC();
        float pre0 = 0.f, pre1 = 0.f, mid0 = 0.f, mid1 = 0.f, last0 = 0.f, last1 = 0.f;
#pragma unroll
        for (int ww = 0; ww < 8; ++ww) { const float p0 = *(LAS float*)(L + HG_PART + (ww * 128 + ch0) * 4), p1 = *(LAS float*)(L + HG_PART + (ww * 128 + ch0 + 1) * 4);
            if (ww < w) { pre0 += p0; pre1 += p1; } if (ww < 4) { mid0 += p0; mid1 += p1; } last0 += p0; last1 += p1; }
        tl0 += last0; tl1 += last1;
        if (w == 0) { *(LAS float*)(L + HG_EL + ch0 * 4) = __expf(last0); *(LAS float*)(L + HG_EL + (ch0 + 1) * 4) = __expf(last1); }
        const float em0 = __expf(mid0), em1 = __expf(mid1), elm0 = __expf(last0 - mid0), elm1 = __expf(last1 - mid1);
        unsigned ktw0[4], ktw1[4], vtw0[4], vtw1[4];
#pragma unroll
        for (int i = 0; i < 8; i += 2) {
            float kl0[2], kl1[2];
#pragma unroll
            for (int j = 0; j < 2; ++j) { const int t = 8 * w + i + j; const float c0 = pre0 + lc0[i + j] - mid0, c1 = pre1 + lc1[i + j] - mid1;
                const float kt0 = kk0[i + j] * __expf(-c0), kt1 = kk1[i + j] * __expf(-c1);
                kl0[j] = kt0 * elm0; kl1[j] = kt1 * elm1;
                if (PASS_C) { const float qt0 = qa0[i + j] * __expf(c0), qt1 = qa1[i + j] * __expf(c1);
                    *(LAS unsigned*)(L + HG_Q + (t * HG_PQ + ch0) * 2) = pk2(qt0, qt1); *(LAS unsigned*)(L + HG_Q0 + (t * HG_PQ + ch0) * 2) = pk2(qt0 * em0, qt1 * em1);
                    *(LAS unsigned*)(L + HG_K + (t * HG_PQ + ch0) * 2) = pk2(kt0, kt1); } }
            ktw0[i >> 1] = pk2(kl0[0], kl0[1]); ktw1[i >> 1] = pk2(kl1[0], kl1[1]);
            vtw0[i >> 1] = (vv[i] & 0xffffu) | (vv[i + 1] << 16); vtw1[i >> 1] = (vv[i] >> 16) | (vv[i + 1] & 0xffff0000u); }
        *(LAS v4u*)(L + HG_KT + (ch0 * HG_PT + 8 * w) * 2) = (v4u){ktw0[0], ktw0[1], ktw0[2], ktw0[3]}; *(LAS v4u*)(L + HG_KT + ((ch0 + 1) * HG_PT + 8 * w) * 2) = (v4u){ktw1[0], ktw1[1], ktw1[2], ktw1[3]};
        *(LAS v4u*)(L + HG_VT + (ch0 * HG_PT + 8 * w) * 2) = (v4u){vtw0[0], vtw0[1], vtw0[2], vtw0[3]}; *(LAS v4u*)(L + HG_VT + ((ch0 + 1) * HG_PT + 8 * w) * 2) = (v4u){vtw1[0], vtw1[1], vtw1[2], vtw1[3]};
        LSYNC();
        const bool do_out = PASS_C && !metac;
        if (do_out) {
            v2u gwp[4];
#pragma unroll
            for (int ti2 = 0; ti2 < 4; ++ti2) gwp[ti2] = *(const GAS v2u*)(proj + (row0 + 16 * ti2 + r) * INC + 3 * HW + h * 128 + 16 * w + 4 * q);
            const int ti = w >> 1;
#pragma unroll
            for (int jj = 0; jj < 2; ++jj) { const int tj = 2 * (w & 1) + jj; f32x4 a4 = (f32x4){0.f, 0.f, 0.f, 0.f};
                if (tj <= ti) {
#pragma unroll
                    for (int ks = 0; ks < 4; ++ks) a4 = __builtin_amdgcn_mfma_f32_16x16x32_bf16(lds_frag(L + HG_K, 16 * tj + r, HG_PQ, 32 * ks + 8 * q), lds_frag(L + HG_Q, 16 * ti + r, HG_PQ, 32 * ks + 8 * q), a4, 0, 0, 0);
                    MFMA_SETTLE1(a4);
                    if (tj == ti) {
#pragma unroll
                        for (int e = 0; e < 4; ++e) a4[e] = (4 * q + e <= r) ? a4[e] : 0.f; } }
                *(LAS v2u*)(L + HG_P + ((16 * ti + r) * HG_PT + 16 * tj + 4 * q) * 2) = (v2u){pk2(a4[0], a4[1]), pk2(a4[2], a4[3])}; }
            LSYNC();
            f32x4 o[4];
#pragma unroll
            for (int ti2 = 0; ti2 < 4; ++ti2) o[ti2] = (f32x4){0.f, 0.f, 0.f, 0.f};
#pragma unroll
            for (int ks = 0; ks < 4; ++ks) { const bf16x8 a = lds_frag(L + HG_ST, 16 * w + r, HG_PQ, 32 * ks + 8 * q);
#pragma unroll
                for (int ti2 = 0; ti2 < 4; ++ti2) o[ti2] = __builtin_amdgcn_mfma_f32_16x16x32_bf16(a, lds_frag(L + HG_Q0, 16 * ti2 + r, HG_PQ, 32 * ks + 8 * q), o[ti2], 0, 0, 0); }
#pragma unroll
            for (int js = 0; js < 2; ++js) { const bf16x8 a = lds_frag(L + HG_VT, 16 * w + r, HG_PT, 32 * js + 8 * q);
#pragma unroll
                for (int ti2 = 0; ti2 < 4; ++ti2) o[ti2] = __builtin_amdgcn_mfma_f32_16x16x32_bf16(a, lds_frag(L + HG_P, 16 * ti2 + r, HG_PT, 32 * js + 8 * q), o[ti2], 0, 0, 0); }
            MFMA_SETTLE4(o[0], o[1], o[2], o[3]);
#pragma unroll
            for (int ti2 = 0; ti2 < 4; ++ti2) { float ss = (o[ti2][0] * o[ti2][0] + o[ti2][1] * o[ti2][1]) + (o[ti2][2] * o[ti2][2] + o[ti2][3] * o[ti2][3]);
                ss += __shfl_xor(ss, 16); ss += __shfl_xor(ss, 32);
                if (q == 0) *(LAS float*)(L + HG_RS + (w * 64 + 16 * ti2 + r) * 4) = ss; }
            LSYNC();
            const f32x4 g4 = *(const GAS f32x4*)(gn + h * 128 + 16 * w + 4 * q);
#pragma unroll
            for (int ti2 = 0; ti2 < 4; ++ti2) { float tot = 0.f;
#pragma unroll
                for (int ww = 0; ww < 8; ++ww) tot += *(LAS float*)(L + HG_RS + (ww * 64 + 16 * ti2 + r) * 4);
                const float rs = __builtin_amdgcn_rsqf(tot * (1.f / 128.f) + EPS);
                const size_t row = row0 + 16 * ti2 + r; const v2u gw = gwp[ti2];
                v2u yw; yw.x = pk2(o[ti2][0] * rs * g4[0] * siluf_(bflo(gw.x)), o[ti2][1] * rs * g4[1] * siluf_(bfhi(gw.x))); yw.y = pk2(o[ti2][2] * rs * g4[2] * siluf_(bflo(gw.y)), o[ti2][3] * rs * g4[3] * siluf_(bfhi(gw.y)));
                *(GAS v2u*)(Y + row * D + h * 128 + 16 * w + 4 * q) = yw; }
        }
        if (!(PASS_C && ci == nch - 1)) {
#pragma unroll
            for (int tk = 0; tk < 8; ++tk) { const float el = *(LAS float*)(L + HG_EL + (16 * tk + r) * 4); st[tk] = st[tk] * el; }
#pragma unroll
            for (int js = 0; js < 2; ++js) { const bf16x8 a = lds_frag(L + HG_VT, 16 * w + r, HG_PT, 32 * js + 8 * q);
#pragma unroll
                for (int tk = 0; tk < 8; ++tk) st[tk] = __builtin_amdgcn_mfma_f32_16x16x32_bf16(a, lds_frag(L + HG_KT, 16 * tk + r, HG_PT, 32 * js + 8 * q), st[tk], 0, 0, 0); }
            MFMA_SETTLE8(st[0], st[1], st[2], st[3], st[4], st[5], st[6], st[7]);
            if (PASS_C) {
#pragma unroll
                for (int tk = 0; tk < 8; ++tk)
#pragma unroll
                    for (int e = 0; e < 4; ++e) *(LAS bf16*)(L + HG_ST + ((16 * w + 4 * q + e) * HG_PQ + 16 * tk + r) * 2) = f2bf16(st[tk][e]);
            }
        }
    }
    if (!PASS_C) {
#pragma unroll
        for (int tk = 0; tk < 8; ++tk)
#pragma unroll
            for (int e = 0; e < 4; ++e) Gu[(16 * w + 4 * q + e) * 128 + 16 * tk + r] = st[tk][e];
        if (w == 0) { HD[unit * 128 + ch0] = __expf(tl0); HD[unit * 128 + ch0 + 1] = __expf(tl1); }
    }
    WG_SYNC();
}
__device__ __forceinline__ void hgrn_carry(Frame& F, const float* HG, float* HG2, const float* HD) {
    const int tid = opaque_tid();
    for (int idx = blockIdx.x * 512 + tid; idx < 32 * 16384; idx += F.G * 512) {
        const int bh = idx >> 14, e = idx & 16383, k = e & 127; float S = 0.f;
        float g[16], dk[16];
#pragma unroll
        for (int c = 0; c < 16; ++c) { g[c] = HG[(size_t)(bh * 16 + c) * 16384 + e]; dk[c] = HD[(bh * 16 + c) * 128 + k]; }
#pragma unroll
        for (int c = 0; c < 16; ++c) { HG2[(size_t)(bh * 16 + c) * 16384 + e] = S; S = dk[c] * S + g[c]; }
    }
}

constexpr int LR_P = 264;
constexpr int LR_XC = 0, LR_OH = LR_XC + 64 * LR_P * 2, LR_OA = LR_OH + 64 * LR_P * 2, LR_END = LR_OA + 64 * LR_P * 2;
static_assert(LR_END <= LDSCTL_OFF, "LRU LDS map");
__device__ __forceinline__ void lru_unit(Frame& F, int unit, const bf16* proj, const bf16* WL, const float* cw, const float* cb, const float* b_a, const float* b_x, const float* lam,
                                         bf16* HLOC, bf16* ACUM, float* LC) {
    const int tid = opaque_tid(), lane = tid & 63, w = F.wave, r = lane & 15, q = lane >> 4;
    const int b = unit >> 7, hd = (unit >> 4) & 7, c = unit & 15;
    ldsp L = F.lds;
    const int c8 = tid & 31, tg = tid >> 5;
    float ba[2], bx[2], sp[2], hc[2] = {0.f, 0.f}, pc[2] = {1.f, 1.f};
#pragma unroll
    for (int ct = 0; ct < 2; ++ct) { const int ch = hd * 256 + 32 * w + 16 * ct + r; ba[ct] = b_a[ch]; bx[ct] = b_x[ch]; sp[ct] = pg8::softplus_neg(lam[ch]); }
    const int nsc = (c == 0) ? 5 : 4;
    const int chg = hd * 256 + 8 * c8;
    float wv[4][8], bv[8];
#pragma unroll
    for (int e = 0; e < 8; ++e) { bv[e] = cb[chg + e];
#pragma unroll
        for (int k = 0; k < 4; ++k) wv[k][e] = cw[k * LW + chg + e]; }
    v4u xw[7];
#define LR_LOAD(sj) do { const bool mc_ = (c == 0 && (sj) == 0); const int p0_ = (mc_ ? 0 : NMETA + c * 256 + ((c == 0) ? (sj) - 1 : (sj)) * 64) + 4 * tg - 3; \
        if (tg < (mc_ ? 4 : 16)) { _Pragma("unroll") for (int d = 0; d < 7; ++d) { const int p = p0_ + d; \
            if (p >= 0) { const size_t row = p < NMETA ? (size_t)(MR + p) : (size_t)b * SEQ + p - NMETA; xw[d] = *(const GAS v4u*)(proj + row * INC + 4 * HW + chg); } \
            else xw[d] = (v4u){0u, 0u, 0u, 0u}; } } } while (0)
    LR_LOAD(0);
    for (int si = 0; si < nsc; ++si) {
        const bool metac = (c == 0 && si == 0);
        const int ntt = metac ? 1 : 4;
        const int pos0 = metac ? 0 : NMETA + c * 256 + ((c == 0) ? si - 1 : si) * 64;
        if (tg < 4 * ntt) {
            float xr[7][8];
#pragma unroll
            for (int d = 0; d < 7; ++d) { xr[d][0] = bflo(xw[d].x); xr[d][1] = bfhi(xw[d].x); xr[d][2] = bflo(xw[d].y); xr[d][3] = bfhi(xw[d].y); xr[d][4] = bflo(xw[d].z); xr[d][5] = bfhi(xw[d].z); xr[d][6] = bflo(xw[d].w); xr[d][7] = bfhi(xw[d].w); }
#pragma unroll
            for (int i = 0; i < 4; ++i) { float xo[8];
#pragma unroll
                for (int e = 0; e < 8; ++e) xo[e] = bv[e] + xr[i][e] * wv[0][e] + xr[i + 1][e] * wv[1][e] + xr[i + 2][e] * wv[2][e] + xr[i + 3][e] * wv[3][e];
                *(LAS v4u*)(L + LR_XC + ((4 * tg + i) * LR_P + 8 * c8) * 2) = (v4u){pk2(xo[0], xo[1]), pk2(xo[2], xo[3]), pk2(xo[4], xo[5]), pk2(xo[6], xo[7])}; }
        }
        LSYNC();
        f32x4 ar[2][4], ai[2][4];
#pragma unroll
        for (int ct = 0; ct < 2; ++ct)
#pragma unroll
            for (int tt = 0; tt < 4; ++tt) { ar[ct][tt] = (f32x4){0.f, 0.f, 0.f, 0.f}; ai[ct][tt] = (f32x4){0.f, 0.f, 0.f, 0.f}; }
        const bf16* wrow = WL + (size_t)(512 * hd + 256 * (w >> 2) + 32 * (w & 3) + r) * 256 + 8 * q;
#pragma unroll 4
        for (int ks = 0; ks < 8; ++ks) {
            bf16x8 br[2], bi[2];
#pragma unroll
            for (int ct = 0; ct < 2; ++ct) { br[ct] = *(const GAS bf16x8*)(wrow + (size_t)(16 * ct) * 256 + 32 * ks); bi[ct] = *(const GAS bf16x8*)(wrow + (size_t)(16 * ct + 128) * 256 + 32 * ks); }
#pragma unroll
            for (int tt = 0; tt < 4; ++tt) { if (tt < ntt) { const bf16x8 a = lds_frag(L + LR_XC, 16 * tt + r, LR_P, 32 * ks + 8 * q);
#pragma unroll
                for (int ct = 0; ct < 2; ++ct) { ar[ct][tt] = __builtin_amdgcn_mfma_f32_16x16x32_bf16(a, br[ct], ar[ct][tt], 0, 0, 0); ai[ct][tt] = __builtin_amdgcn_mfma_f32_16x16x32_bf16(a, bi[ct], ai[ct][tt], 0, 0, 0); } } }
        }
        MFMA_SETTLE8(ar[0][0], ar[0][1], ar[0][2], ar[0][3], ar[1][0], ar[1][1], ar[1][2], ar[1][3]); MFMA_SETTLE8(ai[0][0], ai[0][1], ai[0][2], ai[0][3], ai[1][0], ai[1][1], ai[1][2], ai[1][3]);
        if (si + 1 < nsc) LR_LOAD(si + 1);
#pragma unroll
        for (int ct = 0; ct < 2; ++ct) {
#pragma unroll
            for (int tt = 0; tt < 4; ++tt) { if (tt < ntt) {
                float al[4], hl[4]; float P = 1.f, H = 0.f;
#pragma unroll
                for (int e = 0; e < 4; ++e) { const int t = 16 * tt + 4 * q + e; const float xcv = bf2f(*(LAS bf16*)(L + LR_XC + (t * LR_P + 32 * w + 16 * ct + r) * 2));
                    float a, d; pg8::lru_gate_math(ar[ct][tt][e], ai[ct][tt][e], ba[ct], bx[ct], sp[ct], xcv, a, d); H = a * H + d; P *= a; al[e] = P; hl[e] = H; }
                float Pi = P, Hi = H;
                { const float Pp = __shfl(Pi, lane - 16), Hp = __shfl(Hi, lane - 16); if (q >= 1) { Hi = Pi * Hp + Hi; Pi = Pp * Pi; } }
                { const float Pp = __shfl(Pi, lane - 32), Hp = __shfl(Hi, lane - 32); if (q >= 2) { Hi = Pi * Hp + Hi; Pi = Pp * Pi; } }
                float Pe = __shfl(Pi, lane - 16), He = __shfl(Hi, lane - 16); if (q == 0) { Pe = 1.f; He = 0.f; }
                const float Pt = __shfl(Pi, 48 + r), Ht = __shfl(Hi, 48 + r);
                const float hin = Pe * hc[ct] + He, pin = pc[ct] * Pe;
                if (!metac) {
#pragma unroll
                    for (int e = 0; e < 4; ++e) { const int t = 16 * tt + 4 * q + e; const int o = (t * LR_P + 32 * w + 16 * ct + r) * 2;
                        *(LAS bf16*)(L + LR_OH + o) = f2bf16(al[e] * hin + hl[e]); *(LAS bf16*)(L + LR_OA + o) = f2bf16(pin * al[e]); } }
                hc[ct] = Pt * hc[ct] + Ht; pc[ct] = pc[ct] * Pt; } }
        }
        LSYNC();
        if (!metac) {
            const size_t rowb = (size_t)b * SEQ + pos0 - NMETA;
#pragma unroll
            for (int i = 0; i < 4; ++i) { const int t = 4 * tg + i; const size_t go = (rowb + t) * LW + hd * 256 + 8 * c8;
                *(GAS v4u*)(HLOC + go) = *(LAS v4u*)(L + LR_OH + (t * LR_P + 8 * c8) * 2); *(GAS v4u*)(ACUM + go) = *(LAS v4u*)(L + LR_OA + (t * LR_P + 8 * c8) * 2); }
        }
    }
    if (q == 0) {
#pragma unroll
        for (int ct = 0; ct < 2; ++ct) { const int ch = hd * 256 + 32 * w + 16 * ct + r; LC[(size_t)((b * 16 + c) * 2 + 0) * LW + ch] = pc[ct]; LC[(size_t)((b * 16 + c) * 2 + 1) * LW + ch] = hc[ct]; }
    }
    WG_SYNC();
}
__device__ __forceinline__ void lru_finish(Frame& F, const bf16* HLOC, const bf16* ACUM, const float* LC, const bf16* proj, const float* ln, bf16* Y) {
    const int tid = opaque_tid(), lane = tid & 63, w = F.wave;
    LAS float* HIN = (LAS float*)(F.lds);
    for (int item = blockIdx.x; item < 256; item += F.G) {
        const int b = item >> 7, c = (item >> 3) & 15, sub = item & 7;
        { f32x4 hin = (f32x4){0.f, 0.f, 0.f, 0.f};
#pragma unroll
          for (int c0 = 0; c0 < 16; c0 += 8) { if (c0 < c) { f32x4 P[8], H[8];
#pragma unroll
              for (int j = 0; j < 8; ++j) { const int cs = (c0 + j < c) ? c0 + j : 0; P[j] = *(const GAS f32x4*)(LC + (size_t)((b * 16 + cs) * 2 + 0) * LW + 4 * tid); H[j] = *(const GAS f32x4*)(LC + (size_t)((b * 16 + cs) * 2 + 1) * LW + 4 * tid); }
#pragma unroll
              for (int j = 0; j < 8; ++j) { if (c0 + j < c) hin = P[j] * hin + H[j]; } } }
          *(LAS f32x4*)(HIN + 4 * tid) = hin; }
        WG_SYNC();
#pragma unroll 1
        for (int rr = 0; rr < 4; ++rr) { const size_t row = (size_t)b * SEQ + c * 256 + sub * 32 + w * 4 + rr;
            float hv[4][8]; float ss = 0.f;
#pragma unroll
            for (int j = 0; j < 4; ++j) { const int ch = (lane + 64 * j) * 8; const v4u hw = *(const GAS v4u*)(HLOC + row * LW + ch), aw = *(const GAS v4u*)(ACUM + row * LW + ch);
                const f32x4 i0 = *(LAS f32x4*)(HIN + ch), i1 = *(LAS f32x4*)(HIN + ch + 4);
                hv[j][0] = bflo(hw.x) + bflo(aw.x) * i0[0]; hv[j][1] = bfhi(hw.x) + bfhi(aw.x) * i0[1]; hv[j][2] = bflo(hw.y) + bflo(aw.y) * i0[2]; hv[j][3] = bfhi(hw.y) + bfhi(aw.y) * i0[3];
                hv[j][4] = bflo(hw.z) + bflo(aw.z) * i1[0]; hv[j][5] = bfhi(hw.z) + bfhi(aw.z) * i1[1]; hv[j][6] = bflo(hw.w) + bflo(aw.w) * i1[2]; hv[j][7] = bfhi(hw.w) + bfhi(aw.w) * i1[3];
#pragma unroll
                for (int e = 0; e < 8; ++e) ss += hv[j][e] * hv[j][e]; }
            const float rs = __builtin_amdgcn_rsqf(wave_sum(ss) * (1.f / LW) + EPS);
#pragma unroll
            for (int j = 0; j < 4; ++j) { const int ch = (lane + 64 * j) * 8; const v4u gw = *(const GAS v4u*)(proj + row * INC + 4 * HW + LW + ch);
                const f32x4 l0 = *(const GAS f32x4*)(ln + ch), l1 = *(const GAS f32x4*)(ln + ch + 4);
                v4u yw; yw.x = pk2(hv[j][0] * rs * l0[0] * gelu_tanh(bflo(gw.x)), hv[j][1] * rs * l0[1] * gelu_tanh(bfhi(gw.x))); yw.y = pk2(hv[j][2] * rs * l0[2] * gelu_tanh(bflo(gw.y)), hv[j][3] * rs * l0[3] * gelu_tanh(bfhi(gw.y)));
                yw.z = pk2(hv[j][4] * rs * l1[0] * gelu_tanh(bflo(gw.z)), hv[j][5] * rs * l1[1] * gelu_tanh(bfhi(gw.z))); yw.w = pk2(hv[j][6] * rs * l1[2] * gelu_tanh(bflo(gw.w)), hv[j][7] * rs * l1[3] * gelu_tanh(bfhi(gw.w)));
                *(GAS v4u*)(Y + row * D + HW + ch) = yw; } }
        WG_SYNC();
    }
}

#ifndef PHASE_MASK
#define PHASE_MASK 0xFFFFFFFF
#endif
#ifndef DUP_MASK
#define DUP_MASK 0
#endif
#define PH(k) if constexpr ((PHASE_MASK >> (k)) & 1) _Pragma("unroll") for (int rep_ = 0; rep_ < 1 + (int)((DUP_MASK >> (k)) & 1); ++rep_)
__global__ void __launch_bounds__(NWAVES * 64, 2) hymba_fwd(Args args) {
    extern __shared__ __attribute__((aligned(16))) unsigned char lds[];
    Frame F;
    F.lds = (LAS unsigned char*)lds;
    F.MISC = (volatile LAS unsigned*)(F.lds + MISC_OFF);
    F.tid = threadIdx.x; F.lane = F.tid & 63; F.wave = __builtin_amdgcn_readfirstlane(F.tid >> 6);
    F.G = gridDim.x; { const int bx = blockIdx.x; F.vcu = (F.G % 8 == 0) ? (bx % 8) * (F.G / 8) + bx / 8 : bx; }
    unsigned char* ws = args.ws;
    F.ctl = (gu32*)(ws + WS_CTL);
    for (int u = F.tid; u < (LDS_BYTES - LDSCTL_OFF) / 4; u += NWAVES * 64) ((LAS unsigned*)(F.lds + LDSCTL_OFF))[u] = 0u;
    __syncthreads();
    XcdBarrier bar = xcd_barrier_post((unsigned*)(F.ctl + CW_BAR), F.MISC + 8);
#define GRID_BAR() do { XcdBarrier b_ = bar; asm volatile("" : "+s"(b_.bar), "+s"(b_.x)); xcd_barrier(b_); } while (0)

    const float* x = args.in[0]; const float* meta = args.in[1];
    bf16* WGU1 = (bf16*)(ws + WS_WGU1); bf16* WD1 = (bf16*)(ws + WS_WD1); bf16* WIN = (bf16*)(ws + WS_WIN); bf16* WOUT = (bf16*)(ws + WS_WOUT);
    bf16* WGU2 = (bf16*)(ws + WS_WGU2); bf16* WD2 = (bf16*)(ws + WS_WD2); bf16* WLRU = (bf16*)(ws + WS_WLRU);
    bf16* U = (bf16*)(ws + WS_U); bf16* HID = (bf16*)(ws + WS_BIG); bf16* PROJ = (bf16*)(ws + WS_BIG);
    bf16* Fb = (bf16*)(ws + WS_F);
    float* HGs = (float*)(ws + WS_HG); float* HGs2 = (float*)(ws + WS_HG2); float* HDs = (float*)(ws + WS_HD); float* LC = (float*)(ws + WS_LC); bf16* HLOC = (bf16*)(ws + WS_HLOC); bf16* ACUM = (bf16*)(ws + WS_ACUM); bf16* Y = (bf16*)(ws + WS_Y); bf16* HB = (bf16*)(ws + WS_HB);
    float* out = args.out;
    const int gw = F.vcu * NWAVES + F.wave, NGW = F.G * NWAVES;

    PH(0) {
        LAS float* scr = (LAS float*)(F.lds + RING_OFF + F.wave * 16896); const int lane0 = opaque_lane();
        const int rows0 = p0_convert_all(args, WGU1, WD1, WIN, WOUT, WGU2, WD2, WLRU, scr, gw, NGW, lane0, U);
        for (int m = gw + rows0 * NGW; m < MT; m += NGW) rms_row_to_bf16(m < MR ? x + (size_t)m * D : meta + (size_t)(m - MR) * D, args.in[2], U, m, lane0);
    }
    GRID_BAR();

    PH(1) {
        skinny_phase<2, 3>(F, U, D, WGU1, D, D, FF / 16, MapGateUp{}, SkEpiSwiGLU{HID});
        pg8::Gemm g{U, WGU1, MR, 2 * FF, D, D, D, 0, 0}; pg8::StaticOrder S; S.init(MR, 2 * FF, F.G, (int)blockIdx.x);
        pg8::EpiSwiGLU E{HID, FF};
        pg8::gemm_phase<pg8::EpiSwiGLU, pg8::StaticOrder, true, true>(F.lds + RING_OFF, g, S, E, F.wave);
    }
    GRID_BAR();
    PH(2) {
        skinny_phase<1, 1>(F, HID, 0, WD1, FF, FF, D / 16, MapPlain{}, SkEpiBf16{Fb, D});
        pg8::Gemm g{HID, WD1, MR, D, FF, FF, FF, 0, 1}; pg8::StaticOrder S; S.init(MR, D, F.G, (int)blockIdx.x);
        pg8::EpiBf16 E{Fb, D};
        pg8::gemm_phase<pg8::EpiBf16, pg8::StaticOrder, true, true>(F.lds + RING_OFF, g, S, E, F.wave);
    }
    GRID_BAR();
    PH(3) { norm_rows<0>(Fb, x, meta, nullptr, HB, nullptr, U, args.in[6], args.in[7], 0.5f, MR, gw, NGW);
        for (int m = blockIdx.x; m < NMETA; m += F.G) norm_meta_row(F, m, Fb, meta, U, args.in[6], args.in[7], 0.5f); }
    GRID_BAR();
    PH(4) {
        skinny_phase<1, 3>(F, U, D, WIN, D, D, INC / 16, MapPlain{}, SkEpiBf16{PROJ, INC});
        pg8::Gemm g{U, WIN, MR, INC, D, D, D, 0, 0}; pg8::StaticOrder S; S.init(MR, INC, F.G, (int)blockIdx.x);
        pg8::EpiBf16 E{PROJ, INC};
        pg8::gemm_phase<pg8::EpiBf16, pg8::StaticOrder, true, true>(F.lds + RING_OFF, g, S, E, F.wave);
    }
    GRID_BAR();
    PH(5) {
        for (int u = blockIdx.x; u < 256; u += F.G) lru_unit(F, u, PROJ, WLRU, args.in[11], args.in[12], args.in[14], args.in[16], args.in[17], HLOC, ACUM, LC);
        for (int i = blockIdx.x; i < 512; i += F.G) { const int u = (i & ~255) | ((i + 4 + 4 * (i >> 8)) & 255); hgrn_unit<false>(F, u, PROJ, args.in[9], args.in[10], HGs, HDs, Y); }
    }
    GRID_BAR();
    PH(6) { hgrn_carry(F, HGs, HGs2, HDs); lru_finish(F, HLOC, ACUM, LC, PROJ, args.in[18], Y); }
    GRID_BAR();
    PH(7) { for (int i = blockIdx.x; i < 512; i += F.G) { const int u = (i & ~255) | ((i + 8 * (i >> 8)) & 255); hgrn_unit<true>(F, u, PROJ, args.in[9], args.in[10], HGs2, HDs, Y); } }
    GRID_BAR();
    PH(9) {
        pg8::Gemm g{Y, WOUT, MR, D, D, D, D, 0, 0}; pg8::StaticOrder S; S.init(MR, D, F.G, (int)blockIdx.x);
        pg8::EpiBf16 E{Fb, D};
        pg8::gemm_phase<pg8::EpiBf16, pg8::StaticOrder, true, true>(F.lds + RING_OFF, g, S, E, F.wave);
    }
    GRID_BAR();
    PH(10) norm_rows<1>(Fb, nullptr, nullptr, HB, HB, nullptr, U, args.in[20], args.in[21], 1.0f, MR, gw, NGW);
    GRID_BAR();
    PH(11) {
        pg8::Gemm g{U, WGU2, MR, 2 * FF, D, D, D, 0, 0}; pg8::StaticOrder S; S.init(MR, 2 * FF, F.G, (int)blockIdx.x);
        pg8::EpiSwiGLU E{HID, FF};
        pg8::gemm_phase<pg8::EpiSwiGLU, pg8::StaticOrder, true, true>(F.lds + RING_OFF, g, S, E, F.wave);
    }
    GRID_BAR();
    PH(12) {
        pg8::Gemm g{HID, WD2, MR, D, FF, FF, FF, 0, 1}; pg8::StaticOrder S; S.init(MR, D, F.G, (int)blockIdx.x);
        pg8::EpiBf16 E{Fb, D};
        pg8::gemm_phase<pg8::EpiBf16, pg8::StaticOrder, true, true>(F.lds + RING_OFF, g, S, E, F.wave);
    }
    GRID_BAR();
    PH(13) norm_rows<2>(Fb, nullptr, nullptr, HB, nullptr, out, nullptr, args.in[25], nullptr, 0.5f, MR, gw, NGW);
}

extern "C" void kernel_launch(void* const* d_in, const int* in_sizes, int n_in, void* d_out, int out_size, void* d_ws, size_t ws_size, hipStream_t stream) {
    static int grid = 0;
    if (grid == 0) {
        if (n_in != 26 || out_size != MR * D || ws_size < WS_END) { fprintf(stderr, "kernel_launch: unexpected shapes (n_in %d, out %d, ws %zu, need %zu)\n", n_in, out_size, ws_size, (size_t)WS_END); grid = -1; return; }
        int dev = 0, cus = 0, per_cu = 0;
        if (hipGetDevice(&dev) != hipSuccess || hipDeviceGetAttribute(&cus, hipDeviceAttributeMultiprocessorCount, dev) != hipSuccess) { grid = -1; return; }
        if (hipFuncSetAttribute((const void*)hymba_fwd, hipFuncAttributeMaxDynamicSharedMemorySize, LDS_BYTES) != hipSuccess) { fprintf(stderr, "kernel_launch: hipFuncSetAttribute failed\n"); grid = -1; return; }
        if (hipOccupancyMaxActiveBlocksPerMultiprocessor(&per_cu, (const void*)hymba_fwd, NWAVES * 64, LDS_BYTES) != hipSuccess || per_cu < 1) fprintf(stderr, "kernel_launch: occupancy query says %d\n", per_cu);
        (void)hipGetLastError();
        grid = cus;
    }
    if (grid < 0) return;
    if (hipMemsetAsync((char*)d_ws + WS_CTL, 0, CTL_ZERO_BYTES, stream) != hipSuccess) return;
    Args a{};
    for (int i = 0; i < 26; ++i) a.in[i] = (const float*)d_in[i];
    a.out = (float*)d_out; a.ws = (unsigned char*)d_ws;
    hipLaunchKernelGGL(hymba_fwd, dim3(grid), dim3(NWAVES * 64), LDS_BYTES, stream, a);
}
```

```cpp
#include <hip/hip_runtime.h>
#include <cstdio>
#include <cstdint>

namespace pg8 {
#define PG8_LAS __attribute__((address_space(3)))
typedef unsigned short bf16_t;
typedef short bf16x8 __attribute__((ext_vector_type(8)));
typedef float f32x4 __attribute__((ext_vector_type(4)));
typedef float f32x2 __attribute__((ext_vector_type(2)));
typedef unsigned u32x4 __attribute__((ext_vector_type(4)));
typedef unsigned u32x2 __attribute__((ext_vector_type(2)));
constexpr int BM = 256, BK = 64, HALF = 128, HTB = HALF * BK * 2, STAGE_BYTES = 8 * HTB, NXCD = 8, WGM = 8;

__host__ __device__ __forceinline__ int lds_byte(int r, int c) { const int st = (r >> 4) * 2 + (c >> 5), rr = r & 15, cc = c & 31, ob = rr * 64 + cc * 2; return st * 1024 + (ob ^ (((ob >> 9) & 1) << 5)); }
__host__ __device__ __forceinline__ void stage_rc(int b, int& R, int& C) { const int st = b / 1024, sb = b % 1024, swz = sb ^ (((sb >> 9) & 1) << 5); R = (st >> 1) * 16 + swz / 64; C = (st & 1) * 32 + (swz % 64) / 2; }
__host__ __device__ __forceinline__ int perm32(int rho) { const int n = rho >> 4, i = rho & 15; return 8 * (i >> 2) + 4 * n + (i & 3); }

struct Unit { int pm, pn; };
struct Gemm { const bf16_t* A; const bf16_t* Bt; int M, N, K, lda, ldb, agrp, ablk; };

struct StaticOrder {
    int nM, nN, nwg, G, c;
    __host__ __device__ void init(int M, int N, int G_, int c_) { nM = M / BM; nN = N / BM; nwg = nM * nN; G = G_; c = c_; }
    __host__ __device__ bool next(int i, Unit& u) const {
        const long L = (long)i * G + c; if (L >= nwg) return false;
        int wgid = (int)L; { const int q = nwg / NXCD, r = nwg % NXCD, xcd = wgid % NXCD, off = wgid / NXCD; wgid = (xcd < r ? xcd * (q + 1) : r * (q + 1) + (xcd - r) * q) + off; }
        const int nig = WGM * nN, gid = wgid / nig, fm = gid * WGM, gsz = (nM - fm) < WGM ? (nM - fm) : WGM;
        u.pm = fm + ((wgid % nig) % gsz); u.pn = (wgid % nig) / gsz; return true;
    }
    __device__ __forceinline__ void a_ready(const Unit&) const {}
    __device__ __forceinline__ void done(const Unit&) const {}
};

__device__ __forceinline__ unsigned cvt_pk_bf16(float lo, float hi) { unsigned r; asm volatile("v_cvt_pk_bf16_f32 %0, %1, %2" : "=v"(r) : "v"(lo), "v"(hi)); return r; }
__device__ __forceinline__ float fast_sigmoid(float x) { return __builtin_amdgcn_rcpf(1.0f + __builtin_amdgcn_exp2f(-1.44269504089f * x)); }
__device__ __forceinline__ float fast_silu(float x) { return x * fast_sigmoid(x); }

struct EpiF32 {
    static constexpr bool PERM = false, AFTER_DRAIN = false;
    float* C; int ldc;
    __device__ __forceinline__ void operator()(const f32x4 (&acc)[2][2][4][2], const Unit& u, int wr, int wc, int fr, int fq) const {
        const int row0 = u.pm * BM + wr * 64 + fr, col0 = u.pn * BM + wc * 32 + 4 * fq;
#pragma unroll
        for (int ai = 0; ai < 2; ++ai)
#pragma unroll
            for (int m = 0; m < 4; ++m) { float* rowp = C + (size_t)(row0 + ai * HALF + m * 16) * ldc + col0;
#pragma unroll
                for (int bj = 0; bj < 2; ++bj)
#pragma unroll
                    for (int n = 0; n < 2; ++n) *(f32x4*)(rowp + bj * HALF + n * 16) = acc[ai][bj][m][n]; }
    }
};
struct EpiBf16 {
    static constexpr bool PERM = true, AFTER_DRAIN = false;
    bf16_t* O; int ldc;
    __device__ __forceinline__ void operator()(const f32x4 (&acc)[2][2][4][2], const Unit& u, int wr, int wc, int fr, int fq) const {
        const int row0 = u.pm * BM + wr * 64 + fr, col0 = u.pn * BM + wc * 32 + 8 * fq;
#pragma unroll
        for (int ai = 0; ai < 2; ++ai)
#pragma unroll
            for (int m = 0; m < 4; ++m) { bf16_t* rowp = O + (size_t)(row0 + ai * HALF + m * 16) * ldc + col0;
#pragma unroll
                for (int bj = 0; bj < 2; ++bj) { const f32x4 v0 = acc[ai][bj][m][0], v1 = acc[ai][bj][m][1];
                    u32x4 w; w.x = cvt_pk_bf16(v0[0], v0[1]); w.y = cvt_pk_bf16(v0[2], v0[3]); w.z = cvt_pk_bf16(v1[0], v1[1]); w.w = cvt_pk_bf16(v1[2], v1[3]);
                    *(u32x4*)(rowp + bj * HALF) = w; } }
    }
};
struct EpiSwiGLU {
    static constexpr bool PERM = true, AFTER_DRAIN = false;
    bf16_t* O; int ldc;
    __device__ __forceinline__ void operator()(const f32x4 (&acc)[2][2][4][2], const Unit& u, int wr, int wc, int fr, int fq) const {
#pragma unroll
        for (int ai = 0; ai < 2; ++ai)
#pragma unroll
            for (int m = 0; m < 4; ++m) { bf16_t* rowp = O + ((((size_t)(u.pm * 16 + ai * 8 + wr * 4 + m)) * (ldc >> 5) + u.pn * 4 + wc) << 9) + fr * 32 + 8 * fq;
                const f32x4 g0 = acc[ai][0][m][0], g1 = acc[ai][0][m][1], u0 = acc[ai][1][m][0], u1 = acc[ai][1][m][1];
                f32x4 v0, v1;
#pragma unroll
                for (int e = 0; e < 4; ++e) { v0[e] = fast_silu(g0[e]) * u0[e]; v1[e] = fast_silu(g1[e]) * u1[e]; }
                u32x4 w; w.x = cvt_pk_bf16(v0[0], v0[1]); w.y = cvt_pk_bf16(v0[2], v0[3]); w.z = cvt_pk_bf16(v1[0], v1[1]); w.w = cvt_pk_bf16(v1[2], v1[3]);
                *(u32x4*)rowp = w; }
    }
};
__device__ __forceinline__ float softplus_neg(float lam) { const float y = __expf(-lam); return y < 0.05f ? y * (1.0f - y * (0.5f - y * (0.33333334f - y * 0.25f))) : __logf(1.0f + y); }
__device__ __forceinline__ float neg_expm1(float x) { const float s = -x * (1.0f + x * (0.5f + x * (0.16666667f + x * (0.041666668f + x * 0.0083333338f)))); return x > -0.1f ? s : 1.0f - __expf(x); }
__device__ __forceinline__ void lru_gate_math(float rp, float ip, float ba, float bx, float sp, float xcv, float& a, float& d) {
    const float r = fast_sigmoid(rp + ba), ig = fast_sigmoid(ip + bx);
    const float la = -8.0f * r * sp; a = __expf(la); const float x2 = 2.0f * la;
    const float ser = -x2 * (1.0f + x2 * (0.5f + x2 * (0.16666667f + x2 * (0.041666668f + x2 * 0.0083333338f))));
    d = __builtin_amdgcn_sqrtf(x2 > -0.1f ? ser : 1.0f - a * a) * (ig * xcv);
}
struct EpiLru {
    static constexpr bool PERM = false, AFTER_DRAIN = false;
    float* Aout; float* Dout; const bf16_t* XC; const float* b_a; const float* b_x; const float* lam;
    __device__ __forceinline__ void operator()(const f32x4 (&acc)[2][2][4][2], const Unit& u, int wr, int wc, int fr, int fq) const {
        const int chu = (u.pn >> 1) * 256 + (u.pn & 1) * 128 + wc * 32;
        const size_t rowu = (size_t)(u.pm * BM + wr * 64);
        const unsigned lo = (unsigned)(fr * 2048 + 4 * fq);
#pragma unroll
        for (int n = 0; n < 2; ++n) { const int ch = chu + n * 16 + 4 * fq;
            const f32x4 ba = *(const f32x4*)(b_a + ch), bx = *(const f32x4*)(b_x + ch), l = *(const f32x4*)(lam + ch); f32x4 sp;
#pragma unroll
            for (int e = 0; e < 4; ++e) sp[e] = softplus_neg(l[e]);
#pragma unroll
            for (int ai = 0; ai < 2; ++ai)
#pragma unroll
                for (int m = 0; m < 4; ++m) { const size_t ub = (rowu + ai * HALF + m * 16) * 2048 + chu + n * 16;
                    const u32x2 xw = *(const u32x2*)((const char*)(XC + ub) + lo * 2u);
                    const float xv[4] = {__uint_as_float(xw.x << 16), __uint_as_float(xw.x & 0xffff0000u), __uint_as_float(xw.y << 16), __uint_as_float(xw.y & 0xffff0000u)};
                    f32x4 av, dv;
#pragma unroll
                    for (int e = 0; e < 4; ++e) { float a, d; lru_gate_math(acc[ai][0][m][n][e], acc[ai][1][m][n][e], ba[e], bx[e], sp[e], xv[e], a, d); av[e] = a; dv[e] = d; }
                    *(f32x4*)((char*)(Aout + ub) + lo * 4u) = av; *(f32x4*)((char*)(Dout + ub) + lo * 4u) = dv;
                    asm volatile("" ::: "memory"); } }
    }
};

template <class Epi, class Sched, bool ALIGN_EPI = false, bool SP2 = false>
__device__ __forceinline__ void gemm_phase(PG8_LAS unsigned char* lds, const Gemm g, const Sched& S, const Epi& E, int wave_id) {
    int lane_; asm volatile("v_mbcnt_lo_u32_b32 %0, -1, 0\n\tv_mbcnt_hi_u32_b32 %0, -1, %0" : "=v"(lane_));
    const int wid = wave_id, lane = lane_, tid = wid * 64 + lane, wr = wid >> 2, wc = wid & 3, fr = lane & 15, fq = lane >> 4;
    const int K = g.K, nt = K / BK;
    unsigned voffA[2], voffB[2];
#pragma unroll
    for (int i = 0; i < 2; ++i) { int R, C; stage_rc(wid * 2048 + i * 1024 + lane * 16, R, C);
        voffB[i] = (unsigned)((((R >> 4) * (g.K >> 5) + (C >> 5)) << 10) + (R & 15) * 64 + (C & 31) * 2); voffA[i] = g.ablk ? voffB[i] : (unsigned)(R * g.lda + C) * 2u; }
    static_assert(Epi::PERM, "the blocked weight layout stores the rows in the PERM order");
    const size_t kstep = g.ablk ? (size_t)2048 : (size_t)(BK * 2), kstepB = 2048;
    const size_t hsA = (size_t)HALF * g.lda * 2, hsB = (size_t)HALF * g.K * 2;
    const size_t tsA = 2 * hsA, tsB = 2 * hsB;
    const size_t agb = g.agrp ? (size_t)K * 2 : 0;
    const unsigned ldsw = (unsigned)wid * 2048u;
    const int aoff = lds_byte(wr * 64 + fr, fq * 8), boff = lds_byte(wc * 32 + fr, fq * 8);
#define PG8_SA(b, h) (((b) * 2 + (h)) * HTB)
#define PG8_SB(b, h) ((4 + (b) * 2 + (h)) * HTB)
#define PG8_STAGE(bufoff, gbase, voff) do { _Pragma("unroll") for (int _i = 0; _i < 2; ++_i) \
        __builtin_amdgcn_global_load_lds((const unsigned*)((const char*)(gbase) + (voff)[_i]), (PG8_LAS unsigned*)(lds + (bufoff) + ldsw + _i * 1024), 16, 0, 0); } while (0)
#define PG8_LDA(dst, b, h) do { _Pragma("unroll") for (int m = 0; m < 4; ++m) _Pragma("unroll") for (int k = 0; k < 2; ++k) dst[m][k] = *(const PG8_LAS bf16x8*)(lds + PG8_SA(b, h) + aoff + m * 2048 + k * 1024); } while (0)
#define PG8_LDB(dst, b, h) do { _Pragma("unroll") for (int n = 0; n < 2; ++n) _Pragma("unroll") for (int k = 0; k < 2; ++k) dst[n][k] = *(const PG8_LAS bf16x8*)(lds + PG8_SB(b, h) + boff + n * 2048 + k * 1024); } while (0)
#define PG8_MMA(ai, bj, At, Bt) do { __builtin_amdgcn_s_setprio(1); _Pragma("unroll") for (int m = 0; m < 4; ++m) _Pragma("unroll") for (int n = 0; n < 2; ++n) _Pragma("unroll") for (int k = 0; k < 2; ++k) \
        acc[ai][bj][m][n] = __builtin_amdgcn_mfma_f32_16x16x32_bf16(Bt[n][k], At[m][k], acc[ai][bj][m][n], 0, 0, 0); __builtin_amdgcn_s_setprio(0); } while (0)
#define PG8_WAIT_V(n) asm volatile("s_waitcnt vmcnt(" #n ")" ::: "memory")
#define PG8_WAIT_L(n) asm volatile("s_waitcnt lgkmcnt(" #n ")" ::: "memory")
#define PG8_BAR __builtin_amdgcn_s_barrier()
#define PG8_SCHED __builtin_amdgcn_sched_barrier(0)
    Unit cur, nxt; int ui = 0;
    if (!S.next(0, cur)) return;
    f32x4 acc[2][2][4][2];
#pragma unroll
    for (int a = 0; a < 2; ++a)
#pragma unroll
        for (int b = 0; b < 2; ++b)
#pragma unroll
            for (int m = 0; m < 4; ++m)
#pragma unroll
                for (int n = 0; n < 2; ++n) acc[a][b][m][n] = (f32x4){0.f, 0.f, 0.f, 0.f};
    bf16x8 At[4][2], B0[2][2], B1[2][2];
    const char* cA = (const char*)g.A + (size_t)cur.pm * tsA + (size_t)(cur.pn >> 1) * agb; const char* cB = (const char*)g.Bt + (size_t)cur.pn * tsB;
    S.a_ready(cur);
    if constexpr (SP2) {
        PG8_STAGE(PG8_SB(0, 0), cB, voffB); PG8_STAGE(PG8_SB(0, 1), cB + hsB, voffB); PG8_STAGE(PG8_SA(0, 0), cA, voffA); PG8_STAGE(PG8_SA(0, 1), cA + hsA, voffA);
        if (wr == 1) PG8_BAR;
        PG8_WAIT_V(2); PG8_BAR;
        PG8_STAGE(PG8_SB(1, 0), cB + kstepB, voffB); PG8_STAGE(PG8_SA(1, 0), cA + kstep, voffA); PG8_STAGE(PG8_SB(1, 1), cB + hsB + kstepB, voffB);
        PG8_WAIT_V(6); PG8_BAR;
    } else {
        PG8_STAGE(PG8_SB(0, 0), cB, voffB); PG8_STAGE(PG8_SA(0, 0), cA, voffA); PG8_STAGE(PG8_SB(0, 1), cB + hsB, voffB); PG8_STAGE(PG8_SA(0, 1), cA + hsA, voffA);
        if (wr == 1) PG8_BAR;
        PG8_WAIT_V(4); PG8_BAR;
        PG8_STAGE(PG8_SB(1, 0), cB + kstepB, voffB); PG8_STAGE(PG8_SA(1, 0), cA + kstep, voffA); PG8_STAGE(PG8_SB(1, 1), cB + hsB + kstepB, voffB);
        PG8_WAIT_V(6); PG8_BAR;
    }
    for (;;) {
        const bool has_next = S.next(ui + 1, nxt);
        const char* nA = has_next ? (const char*)g.A + (size_t)nxt.pm * tsA + (size_t)(nxt.pn >> 1) * agb : cA; const char* nB = has_next ? (const char*)g.Bt + (size_t)nxt.pn * tsB : cB;
        for (int t = 0; t < nt; t += 2) {
            const bool last = (t == nt - 2);
            const char* a1 = cA + (size_t)(t + 1) * kstep;
            const char* a2 = last ? nA : cA + (size_t)(t + 2) * kstep; const char* b2 = last ? nB : cB + (size_t)(t + 2) * kstepB;
            const char* a3 = a2 + kstep; const char* b3 = b2 + kstepB;
            if (last && has_next) S.a_ready(nxt);
            if constexpr (SP2) {
            PG8_LDB(B0, 0, 0); PG8_LDB(B1, 0, 1); PG8_SCHED; PG8_LDA(At, 0, 0); PG8_STAGE(PG8_SA(1, 1), a1 + hsA, voffA);
            PG8_WAIT_V(8); PG8_WAIT_L(0); PG8_BAR; PG8_MMA(0, 0, At, B0); PG8_MMA(0, 1, At, B1); PG8_BAR; PG8_SCHED;
            PG8_LDA(At, 0, 1); PG8_STAGE(PG8_SB(0, 0), b2, voffB); PG8_STAGE(PG8_SB(0, 1), b2 + hsB, voffB); PG8_STAGE(PG8_SA(0, 0), a2, voffA);
            PG8_WAIT_V(8); PG8_WAIT_L(0); PG8_BAR; PG8_MMA(1, 0, At, B0); PG8_MMA(1, 1, At, B1); PG8_BAR; PG8_SCHED;
            PG8_LDB(B0, 1, 0); PG8_LDB(B1, 1, 1); PG8_SCHED; PG8_LDA(At, 1, 0); PG8_STAGE(PG8_SA(0, 1), a2 + hsA, voffA);
            PG8_WAIT_V(8); PG8_WAIT_L(0); PG8_BAR; PG8_MMA(0, 0, At, B0); PG8_MMA(0, 1, At, B1); PG8_BAR; PG8_SCHED;
            PG8_LDA(At, 1, 1); PG8_STAGE(PG8_SB(1, 0), b3, voffB); PG8_STAGE(PG8_SB(1, 1), b3 + hsB, voffB); PG8_STAGE(PG8_SA(1, 0), a3, voffA);
            PG8_WAIT_V(8); PG8_WAIT_L(0); PG8_BAR; PG8_MMA(1, 0, At, B0); PG8_MMA(1, 1, At, B1); PG8_BAR; PG8_SCHED;
            } else {
            PG8_LDB(B0, 0, 0); PG8_SCHED; PG8_LDA(At, 0, 0); PG8_STAGE(PG8_SA(1, 1), a1 + hsA, voffA);
            PG8_WAIT_L(8); PG8_BAR; PG8_WAIT_L(0); PG8_MMA(0, 0, At, B0); PG8_BAR; PG8_SCHED;
            PG8_LDB(B1, 0, 1); PG8_STAGE(PG8_SB(0, 0), b2, voffB);
            PG8_BAR; PG8_WAIT_L(0); PG8_MMA(0, 1, At, B1); PG8_BAR;
            PG8_LDA(At, 0, 1); PG8_STAGE(PG8_SA(0, 0), a2, voffA);
            PG8_BAR; PG8_WAIT_L(0); PG8_MMA(1, 0, At, B0); PG8_BAR; PG8_SCHED;
            PG8_STAGE(PG8_SB(0, 1), b2 + hsB, voffB);
            PG8_WAIT_V(6); PG8_BAR; PG8_MMA(1, 1, At, B1); PG8_BAR;
            PG8_LDB(B0, 1, 0); PG8_SCHED; PG8_LDA(At, 1, 0); PG8_STAGE(PG8_SA(0, 1), a2 + hsA, voffA);
            PG8_WAIT_L(8); PG8_BAR; PG8_WAIT_L(0); PG8_MMA(0, 0, At, B0); PG8_BAR; PG8_SCHED;
            PG8_LDB(B1, 1, 1); PG8_STAGE(PG8_SB(1, 0), b3, voffB);
            PG8_BAR; PG8_WAIT_L(0); PG8_MMA(0, 1, At, B1); PG8_BAR;
            PG8_LDA(At, 1, 1); PG8_STAGE(PG8_SA(1, 0), a3, voffA);
            PG8_BAR; PG8_WAIT_L(0); PG8_MMA(1, 0, At, B0); PG8_BAR; PG8_SCHED;
            PG8_STAGE(PG8_SB(1, 1), b3 + hsB, voffB);
            PG8_WAIT_V(6); PG8_BAR; PG8_MMA(1, 1, At, B1); PG8_BAR;
            }
        }
        if constexpr (ALIGN_EPI) { if (wr == 0) PG8_BAR; }
        if constexpr (!Epi::AFTER_DRAIN) { E(acc, cur, wr, wc, fr, fq); S.done(cur); }
        if (!has_next) break;
#pragma unroll
        for (int a = 0; a < 2; ++a)
#pragma unroll
            for (int b = 0; b < 2; ++b)
#pragma unroll
                for (int m = 0; m < 4; ++m)
#pragma unroll
                    for (int n = 0; n < 2; ++n) acc[a][b][m][n] = (f32x4){0.f, 0.f, 0.f, 0.f};
        cur = nxt; cA = nA; cB = nB; ++ui;
        if constexpr (ALIGN_EPI) { if (wr == 1) PG8_BAR; }
    }
    PG8_WAIT_V(0);
    if constexpr (!ALIGN_EPI) { if (wr == 0) PG8_BAR; }
    PG8_BAR;
#undef PG8_SA
#undef PG8_SB
#undef PG8_STAGE
#undef PG8_LDA
#undef PG8_LDB
#undef PG8_MMA
#undef PG8_WAIT_V
#undef PG8_WAIT_L
#undef PG8_BAR
#undef PG8_SCHED
}
}

constexpr int NWAVES = 8;
constexpr int D = 4096, SEQ = 4096, NB = 2, NMETA = 16, FF = 11008, INC = 12288, HW = 2048, LW = 2048;
constexpr int MR = NB * SEQ;
constexpr int MT = MR + NMETA;
constexpr float EPS = 1e-6f;

constexpr size_t MiB = 1u << 20;
constexpr size_t WS_CTL = 0, CTL_ZERO_BYTES = 32768;
constexpr size_t WS_WGU1 = 1 * MiB;
constexpr size_t WS_WD1  = WS_WGU1 + 172 * MiB;
constexpr size_t WS_WIN  = WS_WD1 + 86 * MiB;
constexpr size_t WS_WOUT = WS_WIN + 96 * MiB;
constexpr size_t WS_WGU2 = WS_WOUT + 32 * MiB;
constexpr size_t WS_WD2  = WS_WGU2 + 172 * MiB;
constexpr size_t WS_WLRU = WS_WD2 + 86 * MiB;
constexpr size_t WS_U    = WS_WLRU + 2 * MiB;
constexpr size_t WS_BIG  = WS_U + 65 * MiB;
constexpr size_t WS_F    = WS_BIG + 193 * MiB;
constexpr size_t WS_HG   = WS_F + 130 * MiB;
constexpr size_t WS_HG2  = WS_HG + 32 * MiB;
constexpr size_t WS_HD   = WS_HG2 + 32 * MiB;
constexpr size_t WS_LC   = WS_HD + 1 * MiB;
constexpr size_t WS_HLOC = WS_LC + 1 * MiB;
constexpr size_t WS_ACUM = WS_HLOC + 32 * MiB;
constexpr size_t WS_Y    = WS_ACUM + 32 * MiB;
constexpr size_t WS_HB   = WS_Y + 64 * MiB;
constexpr size_t WS_END  = WS_HB + 64 * MiB;
static_assert((size_t)MT * INC * 2 <= 193 * MiB && (size_t)MT * D * 4 <= 130 * MiB && (size_t)MT * D * 2 <= 65 * MiB, "ws map");
constexpr int CW_BAR = 4096;

constexpr int RING_OFF = 0, RING_BYTES = 131072;
constexpr int LDS_BYTES = 163840;
constexpr int LDSCTL_OFF = LDS_BYTES - 1024, MISC_OFF = LDSCTL_OFF + 320;

#define GAS __attribute__((address_space(1)))
#define LAS __attribute__((address_space(3)))
typedef unsigned short bf16;
typedef unsigned v4u __attribute__((ext_vector_type(4)));
typedef unsigned v2u __attribute__((ext_vector_type(2)));
typedef float f32x4 __attribute__((ext_vector_type(4)));
typedef short bf16x8 __attribute__((ext_vector_type(8)));
typedef GAS unsigned gu32;
#define RLX_AGENT __ATOMIC_RELAXED, __HIP_MEMORY_SCOPE_AGENT
#define LDS_WAIT() asm volatile("s_waitcnt lgkmcnt(0)" ::: "memory")
#define VM_WAIT() asm volatile("s_waitcnt vmcnt(0)" ::: "memory")
__device__ __forceinline__ unsigned f2bf(float f) { unsigned u = __builtin_bit_cast(unsigned, f); return (u + 0x7fffu + ((u >> 16) & 1u)) >> 16; }
typedef float f32x2_t __attribute__((ext_vector_type(2)));
typedef __bf16 bf16x2_t __attribute__((ext_vector_type(2)));
__device__ __forceinline__ unsigned pk2(float lo, float hi) { const f32x2_t v = {lo, hi}; const bf16x2_t b = __builtin_convertvector(v, bf16x2_t); return __builtin_bit_cast(unsigned, b); }
__device__ __forceinline__ bf16 f2bf16(float x) { return (bf16)(pk2(x, x) & 0xffffu); }
__device__ __forceinline__ float bflo(unsigned w) { return __uint_as_float(w << 16); }
__device__ __forceinline__ float bfhi(unsigned w) { return __uint_as_float(w & 0xffff0000u); }
__device__ __forceinline__ float bf2f(bf16 v) { return __uint_as_float(((unsigned)v) << 16); }

#define XB_TMO      128
#define XB_XCNT(j)  (256  + 64 * (j))
#define XB_XSUB(j)  (1280 + 64 * (j))
#define XB_XGEN(j)  (2304 + 64 * (j))
#define XB_TOP      3328
#define XB_TOPGEN   3392
#define XCD_BAR_WORDS 3456
#define XB_SPIN_CAP (1u << 18)

__device__ __forceinline__ unsigned xb_ld(unsigned* p)              { return __hip_atomic_load(p, __ATOMIC_RELAXED, __HIP_MEMORY_SCOPE_AGENT); }
__device__ __forceinline__ unsigned xb_add(unsigned* p, unsigned v) { return __hip_atomic_fetch_add(p, v, __ATOMIC_RELAXED, __HIP_MEMORY_SCOPE_AGENT); }
__device__ __forceinline__ unsigned xb_xcc_id() { return (unsigned)__builtin_amdgcn_s_getreg((3 << 11) | 20) & 0xFu; }
#define XB_SPIN(cond, bar) do { unsigned _sp = 0; while (cond) { __builtin_amdgcn_s_sleep(1); \
    if ((++_sp & 255u) == 0u) { if (xb_ld(&(bar)[XB_TMO])) break; if (_sp > XB_SPIN_CAP) { atomicAdd(&(bar)[XB_TMO], 1u); break; } } } } while (0)

struct XcdBarrier {
    unsigned* bar; unsigned x;
    volatile LAS unsigned* st;
};
__device__ __forceinline__ XcdBarrier xcd_barrier_post(unsigned* bar, volatile LAS unsigned* st) {
    XcdBarrier b; b.bar = bar; b.x = xb_xcc_id(); b.st = st;
    if (threadIdx.x == 0) (void)xb_add(&bar[XB_XCNT(b.x)], 1u);
    return b;
}
__device__ __forceinline__ void xcd_barrier_complete(unsigned* bar, unsigned x, unsigned& nloc, unsigned& nx) {
    const unsigned G = gridDim.x * gridDim.y * gridDim.z;
    unsigned sum, cnt, mine, sp = 0u;
    for (;;) {
        sum = 0u; cnt = 0u; mine = 0u;
#pragma unroll
        for (unsigned j = 0; j < 16; ++j) { const unsigned c = xb_ld(&bar[XB_XCNT(j)]); sum += c; cnt += (c > 0u) ? 1u : 0u; mine = (j == x) ? c : mine; }
        if (sum == G) break;
        __builtin_amdgcn_s_sleep(1);
        if ((++sp & 255u) == 0u) { if (xb_ld(&bar[XB_TMO])) break; if (sp > XB_SPIN_CAP) { atomicAdd(&bar[XB_TMO], 1u); break; } }
    }
    nloc = mine > 0u ? mine : 1u; nx = cnt > 0u ? cnt : 1u;
}
__device__ __forceinline__ void xcd_barrier(const XcdBarrier& b) {
    asm volatile("s_waitcnt vmcnt(0)" ::: "memory");
    __syncthreads();
    if (threadIdx.x == 0) {
        unsigned* bar = b.bar;
        __builtin_amdgcn_s_waitcnt(0);
        unsigned nloc = b.st[0], nx = b.st[1];
        if (nloc == 0u) { xcd_barrier_complete(bar, b.x, nloc, nx); b.st[0] = nloc; b.st[1] = nx; }
        const unsigned old = xb_add(&bar[XB_XSUB(b.x)], 1u);
        const unsigned gen = old / nloc;
        if (old + 1u == (gen + 1u) * nloc) {
            __builtin_amdgcn_fence(__ATOMIC_RELEASE, "agent");
            asm volatile("s_waitcnt vmcnt(0)" ::: "memory");
            const unsigned og = xb_add(&bar[XB_TOP], 1u);
            const unsigned tg = og / nx;
            if (og + 1u == (tg + 1u) * nx) xb_add(&bar[XB_TOPGEN], 1u);
            else XB_SPIN(xb_ld(&bar[XB_TOPGEN]) == tg, bar);
            __builtin_amdgcn_fence(__ATOMIC_ACQUIRE, "agent");
            xb_add(&bar[XB_XGEN(b.x)], 1u);
            asm volatile("s_waitcnt vmcnt(0)" ::: "memory");
        } else {
            XB_SPIN(xb_ld(&bar[XB_XGEN(b.x)]) == gen, bar);
            __builtin_amdgcn_fence(__ATOMIC_ACQUIRE, "agent");
            asm volatile("s_waitcnt vmcnt(0)" ::: "memory");
        }
    }
    __syncthreads();
}


struct Frame {
    LAS unsigned char* lds;
    volatile LAS unsigned* MISC;
    gu32* ctl;
    int tid, lane, wave;
    int vcu, G;
};

__device__ __forceinline__ int opaque_lane() { int l; asm volatile("v_mbcnt_lo_u32_b32 %0, -1, 0\n\tv_mbcnt_hi_u32_b32 %0, -1, %0" : "=v"(l)); return l; }
#define opaque_tid() ((F.wave << 6) + opaque_lane())
__device__ __forceinline__ float wave_sum(float v) {
#pragma unroll
    for (int o = 1; o < 64; o <<= 1) v += __shfl_xor(v, o);
    return v;
}
__device__ __forceinline__ float sigmoidf_(float x) { return __builtin_amdgcn_rcpf(1.0f + __builtin_amdgcn_exp2f(-1.44269504089f * x)); }
__device__ __forceinline__ float siluf_(float x) { return x * sigmoidf_(x); }
__device__ __forceinline__ float gelu_tanh(float x) { const float z = 0.7978845608028654f * (x + 0.044715f * x * x * x); const float t = __builtin_amdgcn_exp2f(2.88539008178f * z); return x * (1.0f - __builtin_amdgcn_rcpf(t + 1.0f)); }

constexpr int TP = 65;
__device__ __forceinline__ void p0_item_load(f32x4 (&v)[16], const float* W, int N, int k0, int n0, int lane) {
    const int rq = lane >> 4, cq = 4 * (lane & 15);
#pragma unroll
    for (int i = 0; i < 16; ++i) v[i] = __builtin_nontemporal_load((const GAS f32x4*)(W + (size_t)(k0 + 4 * i + rq) * N + n0 + cq));
}
__device__ __forceinline__ void p0_item_store(const f32x4 (&v)[16], bf16* WT, int ldo, int out_row0, int k0, LAS float* scr, int lane) {
    const int rq = lane >> 4, cq = 4 * (lane & 15);
#pragma unroll
    for (int i = 0; i < 16; ++i) { LAS float* d = scr + (4 * i + rq) * TP + cq; d[0] = v[i].x; d[1] = v[i].y; d[2] = v[i].z; d[3] = v[i].w; }
    LDS_WAIT(); asm volatile("" ::: "memory");
    const int c = lane & 7;
#pragma unroll
    for (int j = 0; j < 8; ++j) { const int n = (lane >> 3) + 8 * j; const LAS float* sp = scr + (8 * c) * TP + n;
        v4u o; o.x = pk2(sp[0 * TP], sp[1 * TP]); o.y = pk2(sp[2 * TP], sp[3 * TP]); o.z = pk2(sp[4 * TP], sp[5 * TP]); o.w = pk2(sp[6 * TP], sp[7 * TP]);
        __builtin_nontemporal_store(o, (GAS v4u*)(WT + (size_t)(out_row0 + n) * ldo + k0 + 8 * c)); }
    LDS_WAIT(); asm volatile("" ::: "memory");
}
__device__ __forceinline__ void p0_item_store_blk(const f32x4 (&v)[16], bf16* WT, int K, int out_row0, int k0, LAS float* scr, int lane) {
    const int rq = lane >> 4, cq = 4 * (lane & 15);
#pragma unroll
    for (int i = 0; i < 16; ++i) { LAS float* d = scr + (4 * i + rq) * TP + cq; d[0] = v[i].x; d[1] = v[i].y; d[2] = v[i].z; d[3] = v[i].w; }
    LDS_WAIT(); asm volatile("" ::: "memory");
    const int bi = lane >> 2, ch = lane & 3;
#pragma unroll
    for (int s8 = 0; s8 < 8; ++s8) { const int rbl = s8 >> 1, kbl = s8 & 1; const int n = 32 * (rbl >> 1) + 8 * (bi >> 2) + 4 * (rbl & 1) + (bi & 3);
        const LAS float* sa = scr + (32 * kbl + 8 * ch + 4 * (ch & 1)) * TP + n; const LAS float* sb = scr + (32 * kbl + 8 * ch + 4 - 4 * (ch & 1)) * TP + n;
        const unsigned p0 = pk2(sa[0 * TP], sa[1 * TP]), p1 = pk2(sa[2 * TP], sa[3 * TP]), p2 = pk2(sb[0 * TP], sb[1 * TP]), p3 = pk2(sb[2 * TP], sb[3 * TP]);
        const bool od = ch & 1; v4u o; o.x = od ? p2 : p0; o.y = od ? p3 : p1; o.z = od ? p0 : p2; o.w = od ? p1 : p3;
        *(GAS v4u*)(WT + ((size_t)((out_row0 >> 4) + rbl) * (K >> 5) + (k0 >> 5) + kbl) * 512 + bi * 32 + 8 * ch) = o; }
    LDS_WAIT(); asm volatile("" ::: "memory");
}
__device__ __forceinline__ void p0_transpose_matrix(const float* W, int K, int N, bf16* WT, int mode, int row_base, LAS float* scr, int gw, int NGW, int lane) {
    const int nblk = N / 64, nitems = (K / 64) * nblk;
    int it = gw; if (it >= nitems) return;
    f32x4 v[16], w[16];
    p0_item_load(v, W, N, 64 * (it / nblk), 64 * (it % nblk), lane);
    for (;;) {
        const int nx = it + NGW; const bool more = nx < nitems;
        if (more) p0_item_load(w, W, N, 64 * (nx / nblk), 64 * (nx % nblk), lane);
        { const int n0 = 64 * (it % nblk); const int r0 = row_base + (mode == 0 ? n0 : (256 * (n0 >> 7) + (n0 & 127) + (mode == 2 ? 128 : 0)));
          p0_item_store(v, WT, K, r0, 64 * (it / nblk), scr, lane); }
        if (!more) break;
#pragma unroll
        for (int i = 0; i < 16; ++i) v[i] = w[i];
        it = nx;
    }
}

struct Args { const float* in[26]; float* out; unsigned char* ws; };
struct P0Item { const float* W; bf16* WT; int K, N, mode, row_base, local; };
constexpr int P0_FFN = (D / 64) * (FF / 64), P0_IN = (D / 64) * (INC / 64), P0_OUT = (D / 64) * (D / 64), P0_LRU = 16 * 16;
constexpr int P0_TOTAL = 6 * P0_FFN + P0_IN + P0_OUT + P0_LRU;
__device__ __forceinline__ P0Item p0_decode(int g, const Args& args, bf16* WGU1, bf16* WD1, bf16* WIN, bf16* WOUT, bf16* WGU2, bf16* WD2, bf16* WLRU) {
    P0Item t;
    if (g < P0_FFN)               { t.W = args.in[3];  t.WT = WGU1; t.K = D;  t.N = FF;  t.mode = 1; t.row_base = 0; t.local = g; return t; } g -= P0_FFN;
    if (g < P0_FFN)               { t.W = args.in[4];  t.WT = WGU1; t.K = D;  t.N = FF;  t.mode = 2; t.row_base = 0; t.local = g; return t; } g -= P0_FFN;
    if (g < P0_FFN)               { t.W = args.in[5];  t.WT = WD1;  t.K = FF; t.N = D;   t.mode = 0; t.row_base = 0; t.local = g; return t; } g -= P0_FFN;
    if (g < P0_IN)                { t.W = args.in[8];  t.WT = WIN;  t.K = D;  t.N = INC; t.mode = 0; t.row_base = 0; t.local = g; return t; } g -= P0_IN;
    if (g < P0_OUT)               { t.W = args.in[19]; t.WT = WOUT; t.K = D;  t.N = D;   t.mode = 0; t.row_base = 0; t.local = g; return t; } g -= P0_OUT;
    if (g < P0_FFN)               { t.W = args.in[22]; t.WT = WGU2; t.K = D;  t.N = FF;  t.mode = 1; t.row_base = 0; t.local = g; return t; } g -= P0_FFN;
    if (g < P0_FFN)               { t.W = args.in[23]; t.WT = WGU2; t.K = D;  t.N = FF;  t.mode = 2; t.row_base = 0; t.local = g; return t; } g -= P0_FFN;
    if (g < P0_FFN)               { t.W = args.in[24]; t.WT = WD2;  t.K = FF; t.N = D;   t.mode = 0; t.row_base = 0; t.local = g; return t; } g -= P0_FFN;
    { const int hd = g >> 5, which = (g >> 4) & 1; t.W = (which ? args.in[15] : args.in[13]) + (size_t)hd * 65536; t.WT = WLRU; t.K = 256; t.N = 256; t.mode = 1 + which; t.row_base = 512 * hd; t.local = g & 15; return t; }
}
__device__ __forceinline__ void p0_convert_all(const Args& args, bf16* WGU1, bf16* WD1, bf16* WIN, bf16* WOUT, bf16* WGU2, bf16* WD2, bf16* WLRU, LAS float* scr, int gw, int NGW, int lane) {
    int it = gw; if (it >= P0_TOTAL) return;
    f32x4 v[16], w[16];
    P0Item cur = p0_decode(it, args, WGU1, WD1, WIN, WOUT, WGU2, WD2, WLRU), nxt = cur;
    { const int nnb = cur.N / 64; p0_item_load(v, cur.W, cur.N, 64 * (cur.local / nnb), 64 * (cur.local % nnb), lane); }
    for (;;) {
        const int nx = it + NGW; const bool more = nx < P0_TOTAL;
        if (more) { nxt = p0_decode(nx, args, WGU1, WD1, WIN, WOUT, WGU2, WD2, WLRU); const int nnb = nxt.N / 64; p0_item_load(w, nxt.W, nxt.N, 64 * (nxt.local / nnb), 64 * (nxt.local % nnb), lane); }
        { const int nnb = cur.N / 64, n0 = 64 * (cur.local % nnb); const int r0 = cur.row_base + (cur.mode == 0 ? n0 : (256 * (n0 >> 7) + (n0 & 127) + (cur.mode == 2 ? 128 : 0)));
          if (cur.K == 256) p0_item_store(v, cur.WT, cur.K, r0, 64 * (cur.local / nnb), scr, lane);
          else p0_item_store_blk(v, cur.WT, cur.K, r0, 64 * (cur.local / nnb), scr, lane); }
        if (!more) break;
#pragma unroll
        for (int i = 0; i < 16; ++i) v[i] = w[i];
        cur = nxt; it = nx;
    }
}

__device__ __forceinline__ size_t blk_off(int m, int c, int Kd) { return (((size_t)(m >> 4) * (Kd >> 5) + (c >> 5)) << 9) + ((m & 15) << 5) + (c & 31); }
__device__ __forceinline__ void rms_row_to_bf16(const float* xrow, const float* gain, bf16* Ub, int m, int lane) {
    f32x4 v[16]; float s = 0.f;
#pragma unroll
    for (int j = 0; j < 8; ++j) { const GAS f32x4* xp = (const GAS f32x4*)(xrow + 8 * (lane + 64 * j)); v[2 * j] = xp[0]; v[2 * j + 1] = xp[1]; }
#pragma unroll
    for (int j = 0; j < 16; ++j) s += (v[j].x * v[j].x + v[j].y * v[j].y) + (v[j].z * v[j].z + v[j].w * v[j].w);
    const float rs = __builtin_amdgcn_rsqf(wave_sum(s) * (1.f / D) + EPS);
#pragma unroll
    for (int j = 0; j < 8; ++j) { const GAS f32x4* gp = (const GAS f32x4*)(gain + 8 * (lane + 64 * j)); const f32x4 g0 = gp[0], g1 = gp[1], a = v[2 * j], b = v[2 * j + 1];
        v4u w; w.x = pk2(a.x * rs * g0.x, a.y * rs * g0.y); w.y = pk2(a.z * rs * g0.z, a.w * rs * g0.w); w.z = pk2(b.x * rs * g1.x, b.y * rs * g1.y); w.w = pk2(b.z * rs * g1.z, b.w * rs * g1.w);
        *(GAS v4u*)(Ub + (size_t)m * D + 8 * (lane + 64 * j)) = w; }
}

__device__ __forceinline__ void unpack8(const v4u w, f32x4& a, f32x4& b) { a = (f32x4){bflo(w.x), bfhi(w.x), bflo(w.y), bfhi(w.y)}; b = (f32x4){bflo(w.z), bfhi(w.z), bflo(w.w), bfhi(w.w)}; }
template <int HMODE>
__device__ __forceinline__ void norm_rows(const bf16* f, const float* hin_real, const float* hin_meta, const bf16* hin_b, bf16* hout_b, float* hout_f, bf16* uout, const float* gpost, const float* gpre, float coef, int nrows, int gw, int NGW) {
    int lane = opaque_lane();
    for (int row = gw; row < nrows; row += NGW) {
        asm volatile("" : "+v"(lane));
        const size_t ro = (size_t)row * D + 8 * lane;
        f32x4 v[16]; float s = 0.f;
#pragma unroll
        for (int j = 0; j < 8; ++j) { const v4u w = *(const GAS v4u*)(f + ro + 512 * j); unpack8(w, v[2 * j], v[2 * j + 1]); }
#pragma unroll
        for (int j = 0; j < 16; ++j) s += (v[j].x * v[j].x + v[j].y * v[j].y) + (v[j].z * v[j].z + v[j].w * v[j].w);
        const float rs = coef * __builtin_amdgcn_rsqf(wave_sum(s) * (1.f / D) + EPS);
        float s2 = 0.f;
#pragma unroll
        for (int j = 0; j < 8; ++j) { const GAS f32x4* gp = (const GAS f32x4*)(gpost + 8 * lane + 512 * j); const f32x4 g0 = gp[0], g1 = gp[1]; f32x4 h0, h1;
            if (HMODE == 0) { const GAS f32x4* hp = (const GAS f32x4*)((row < MR ? hin_real + (size_t)row * D : hin_meta + (size_t)(row - MR) * D) + 8 * lane + 512 * j); h0 = hp[0]; h1 = hp[1]; }
            else { const v4u hw = *(const GAS v4u*)(hin_b + ro + 512 * j); unpack8(hw, h0, h1); }
            v[2 * j] = h0 + v[2 * j] * rs * g0; v[2 * j + 1] = h1 + v[2 * j + 1] * rs * g1; }
#pragma unroll
        for (int j = 0; j < 16; ++j) s2 += (v[j].x * v[j].x + v[j].y * v[j].y) + (v[j].z * v[j].z + v[j].w * v[j].w);
        if (HMODE == 2) {
#pragma unroll
            for (int j = 0; j < 8; ++j) { GAS f32x4* op = (GAS f32x4*)(hout_f + ro + 512 * j); op[0] = v[2 * j]; op[1] = v[2 * j + 1]; }
        } else if (row < MR) {
#pragma unroll
            for (int j = 0; j < 8; ++j) { const f32x4 a = v[2 * j], b = v[2 * j + 1]; v4u w; w.x = pk2(a.x, a.y); w.y = pk2(a.z, a.w); w.z = pk2(b.x, b.y); w.w = pk2(b.z, b.w); *(GAS v4u*)(hout_b + ro + 512 * j) = w; } }
        if (uout != nullptr) { const float rs2 = __builtin_amdgcn_rsqf(wave_sum(s2) * (1.f / D) + EPS);
#pragma unroll
            for (int j = 0; j < 8; ++j) { const GAS f32x4* gp = (const GAS f32x4*)(gpre + 8 * lane + 512 * j); const f32x4 g0 = gp[0], g1 = gp[1], a = v[2 * j], b = v[2 * j + 1];
                v4u w; w.x = pk2(a.x * rs2 * g0.x, a.y * rs2 * g0.y); w.y = pk2(a.z * rs2 * g0.z, a.w * rs2 * g0.w); w.z = pk2(b.x * rs2 * g1.x, b.y * rs2 * g1.y); w.w = pk2(b.z * rs2 * g1.z, b.w * rs2 * g1.w);
                *(GAS v4u*)(uout + ro + 512 * j) = w; } }
    }
}

#define MFMA_SETTLE1(a) asm volatile("s_nop 7\n\ts_nop 7" : "+v"(a))
#define MFMA_SETTLE2(a, b) asm volatile("s_nop 7\n\ts_nop 7" : "+v"(a), "+v"(b))
#define MFMA_SETTLE4(a, b, c, d) asm volatile("s_nop 7\n\ts_nop 7" : "+v"(a), "+v"(b), "+v"(c), "+v"(d))
#define MFMA_SETTLE8(a, b, c, d, e, f, g, h) asm volatile("s_nop 7\n\ts_nop 7" : "+v"(a), "+v"(b), "+v"(c), "+v"(d), "+v"(e), "+v"(f), "+v"(g), "+v"(h))
template <int NACC, int T, class Map, class Epi>
__device__ __forceinline__ void skinny_phase(Frame& F, const bf16* A, int lda, const bf16* Bt, int ldb, int K, int ntiles, const Map& mp, const Epi& epi) {
    LAS f32x4* red = (LAS f32x4*)(F.lds + RING_OFF);
    const int lane = opaque_lane();
    const int ks = K / 8, k_lo = F.wave * ks, r = lane & 15, q = lane >> 4;
    const int rot = 32 * (int)((blockIdx.x * 7u + F.wave * 3u) % (unsigned)(ks / 32));
    for (int t0 = blockIdx.x; t0 < ntiles; t0 += F.G * T) {
        int brow[T][NACC], acol = 0; bool valid[T];
#pragma unroll
        for (int j = 0; j < T; ++j) { const int tj = t0 + j * F.G; valid[j] = tj < ntiles; mp(valid[j] ? tj : t0, brow[j], acol); }
        f32x4 acc[T][NACC];
#pragma unroll
        for (int j = 0; j < T; ++j)
#pragma unroll
            for (int i = 0; i < NACC; ++i) acc[j][i] = (f32x4){0.f, 0.f, 0.f, 0.f};
        const bf16* ap = lda == 0 ? A + (((size_t)(MR >> 4) * (K >> 5) + (k_lo >> 5)) << 9) + r * 32 + 8 * q : A + (size_t)(MR + r) * lda + k_lo + 8 * q;
        const int astep = lda == 0 ? 16 : 1;
        const bf16* bp[T][NACC];
#pragma unroll
        for (int j = 0; j < T; ++j)
#pragma unroll
            for (int i = 0; i < NACC; ++i) bp[j][i] = Bt + ((size_t)brow[j][i] * (K >> 5) + (k_lo >> 5)) * 512 + r * 32 + 8 * q;
#pragma unroll 4
        for (int k0 = 0; k0 < ks; k0 += 32) {
            int k = k0 + rot; k = k >= ks ? k - ks : k;
            const bf16x8 a = *(const GAS bf16x8*)(ap + k * astep);
#pragma unroll
            for (int j = 0; j < T; ++j)
#pragma unroll
                for (int i = 0; i < NACC; ++i) { const bf16x8 b = *(const GAS bf16x8*)(bp[j][i] + k * 16); acc[j][i] = __builtin_amdgcn_mfma_f32_16x16x32_bf16(b, a, acc[j][i], 0, 0, 0); }
        }
#pragma unroll
        for (int j = 0; j < T; ++j)
#pragma unroll
            for (int i = 0; i < NACC; ++i) MFMA_SETTLE1(acc[j][i]);
#pragma unroll
        for (int j = 0; j < T; ++j)
#pragma unroll
            for (int i = 0; i < NACC; ++i) red[((F.wave * T + j) * NACC + i) * 64 + lane] = acc[j][i];
        LDS_WAIT(); __syncthreads();
#pragma unroll
        for (int j = 0; j < T; ++j) if (F.wave == j && valid[j]) {
            f32x4 sred[NACC];
#pragma unroll
            for (int i = 0; i < NACC; ++i) { sred[i] = red[(j * NACC + i) * 64 + lane];
#pragma unroll
                for (int w = 1; w < 8; ++w) sred[i] += red[((w * T + j) * NACC + i) * 64 + lane]; }
            epi(t0 + j * F.G, r, q, sred);
        }
        __syncthreads();
    }
}
struct MapPlain { __device__ __forceinline__ void operator()(int tile, int (&brow)[1], int& acol) const { brow[0] = tile; acol = 0; } };
struct MapGateUp { __device__ __forceinline__ void operator()(int tile, int (&brow)[2], int& acol) const { const int j0 = 32 * (tile >> 1); brow[0] = ((256 * (j0 >> 7) + (j0 & 127)) >> 4) + (tile & 1); brow[1] = brow[0] + 8; acol = 0; } };
struct MapLru { __device__ __forceinline__ void operator()(int tile, int (&brow)[2], int& acol) const { const int c0 = 16 * tile, head = c0 >> 8, w = c0 & 255; brow[0] = 256 * (2 * head + (w >> 7)) + (w & 127); brow[1] = brow[0] + 128; acol = head * 256; } };
struct SkEpiSwiGLU { bf16* O; __device__ __forceinline__ void operator()(int tile, int r, int q, const f32x4 (&s)[2]) const {
    v2u w; w.x = pk2(siluf_(s[0][0]) * s[1][0], siluf_(s[0][1]) * s[1][1]); w.y = pk2(siluf_(s[0][2]) * s[1][2], siluf_(s[0][3]) * s[1][3]);
    *(GAS v2u*)(O + ((((size_t)(MR >> 4)) * (FF >> 5) + (tile >> 1)) << 9) + r * 32 + 8 * q + 4 * (tile & 1)) = w; } };
struct SkEpiF32 { float* C; int ldc; __device__ __forceinline__ void operator()(int tile, int r, int q, const f32x4 (&s)[1]) const { *(GAS f32x4*)(C + (size_t)(MR + r) * ldc + 16 * tile + 4 * q) = s[0]; } };
struct SkEpiBf16 { bf16* O; int ldc; __device__ __forceinline__ void operator()(int tile, int r, int q, const f32x4 (&s)[1]) const {
    v2u w; w.x = pk2(s[0][0], s[0][1]); w.y = pk2(s[0][2], s[0][3]); *(GAS v2u*)(O + (size_t)(MR + r) * ldc + 32 * (tile >> 1) + 8 * q + 4 * (tile & 1)) = w; } };
struct SkEpiLru { float* Aout; float* Dout; const bf16* XC; const float* b_a; const float* b_x; const float* lam;
    __device__ __forceinline__ void operator()(int tile, int r, int q, const f32x4 (&s)[2]) const {
        const int ch = 16 * tile + 4 * q; const size_t ro = (size_t)(MR + r) * LW + ch; const v2u xw = *(const GAS v2u*)(XC + ro);
        const float xv[4] = {bflo(xw.x), bfhi(xw.x), bflo(xw.y), bfhi(xw.y)}; f32x4 av, dv;
#pragma unroll
        for (int e = 0; e < 4; ++e) { float a, d; pg8::lru_gate_math(s[0][e], s[1][e], b_a[ch + e], b_x[ch + e], pg8::softplus_neg(lam[ch + e]), xv[e], a, d); av[e] = a; dv[e] = d; }
        *(GAS f32x4*)(Aout + ro) = av; *(GAS f32x4*)(Dout + ro) = dv; } };

constexpr int HG_PQ = 136, HG_PT = 72;
constexpr int HG_Q = 0, HG_Q0 = HG_Q + 64 * HG_PQ * 2, HG_K = HG_Q0 + 64 * HG_PQ * 2, HG_KT = HG_K + 64 * HG_PQ * 2, HG_VT = HG_KT + 128 * HG_PT * 2,
              HG_P = HG_VT + 128 * HG_PT * 2, HG_ST = HG_P + 64 * HG_PT * 2, HG_PART = HG_ST + 128 * HG_PQ * 2, HG_EL = HG_PART + 8 * 128 * 4, HG_RS = HG_EL + 128 * 4, HG_END = HG_RS + 8 * 64 * 4;
static_assert(HG_END <= LDSCTL_OFF, "HGRN LDS map");
#define WG_SYNC() do { asm volatile("s_waitcnt vmcnt(0) lgkmcnt(0)" ::: "memory"); __builtin_amdgcn_s_barrier(); asm volatile("" ::: "memory"); } while (0)
#define LSYNC() do { asm volatile("s_waitcnt lgkmcnt(0)" ::: "memory"); __builtin_amdgcn_s_barrier(); asm volatile("" ::: "memory"); } while (0)
__device__ __forceinline__ void norm_meta_row(Frame& F, int m, const bf16* f, const float* meta, bf16* uout, const float* gpost, const float* gpre, float coef) {
    const int tid = opaque_tid(); LAS float* red = (LAS float*)F.lds;
    const size_t ro = (size_t)(MR + m) * D + 8 * tid;
    const v4u fw = *(const GAS v4u*)(f + ro);
    const f32x4 h0 = *(const GAS f32x4*)(meta + (size_t)m * D + 8 * tid), h1 = *(const GAS f32x4*)(meta + (size_t)m * D + 8 * tid + 4);
    const f32x4 g0 = *(const GAS f32x4*)(gpost + 8 * tid), g1 = *(const GAS f32x4*)(gpost + 8 * tid + 4), p0 = *(const GAS f32x4*)(gpre + 8 * tid), p1 = *(const GAS f32x4*)(gpre + 8 * tid + 4);
    float fv[8] = {bflo(fw.x), bfhi(fw.x), bflo(fw.y), bfhi(fw.y), bflo(fw.z), bfhi(fw.z), bflo(fw.w), bfhi(fw.w)};
    float s1 = 0.f;
#pragma unroll
    for (int e = 0; e < 8; ++e) s1 += fv[e] * fv[e];
    s1 = wave_sum(s1); if ((tid & 63) == 0) red[F.wave] = s1;
    WG_SYNC();
    float t1 = 0.f;
#pragma unroll
    for (int w = 0; w < 8; ++w) t1 += red[w];
    const float rs = coef * __builtin_amdgcn_rsqf(t1 * (1.f / D) + EPS);
    const float hv[8] = {h0.x + fv[0] * rs * g0.x, h0.y + fv[1] * rs * g0.y, h0.z + fv[2] * rs * g0.z, h0.w + fv[3] * rs * g0.w, h1.x + fv[4] * rs * g1.x, h1.y + fv[5] * rs * g1.y, h1.z + fv[6] * rs * g1.z, h1.w + fv[7] * rs * g1.w};
    float s2 = 0.f;
#pragma unroll
    for (int e = 0; e < 8; ++e) s2 += hv[e] * hv[e];
    s2 = wave_sum(s2); if ((tid & 63) == 0) red[8 + F.wave] = s2;
    WG_SYNC();
    float t2 = 0.f;
#pragma unroll
    for (int w = 0; w < 8; ++w) t2 += red[8 + w];
    const float rs2 = __builtin_amdgcn_rsqf(t2 * (1.f / D) + EPS);
    v4u o; o.x = pk2(hv[0] * rs2 * p0.x, hv[1] * rs2 * p0.y); o.y = pk2(hv[2] * rs2 * p0.z, hv[3] * rs2 * p0.w); o.z = pk2(hv[4] * rs2 * p1.x, hv[5] * rs2 * p1.y); o.w = pk2(hv[6] * rs2 * p1.z, hv[7] * rs2 * p1.w);
    *(GAS v4u*)(uout + ro) = o;
    WG_SYNC();
}

typedef LAS unsigned char* ldsp;
__device__ __forceinline__ bf16x8 lds_frag(ldsp base, int row, int pitch, int col) { return *(const LAS bf16x8*)(base + (row * pitch + col) * 2); }

template <bool PASS_C>
__device__ __forceinline__ void hgrn_unit(Frame& F, int unit, const bf16* proj, const float* lbl, const float* gn, float* HG, float* HD, bf16* Y) {
    const int tid = opaque_tid(), lane = tid & 63, w = F.wave, r = lane & 15, q = lane >> 4;
    const int b = unit >> 8, h = (unit >> 4) & 15, c = unit & 15;
    ldsp L = F.lds;
    const int ch0 = 2 * lane;
    const float lb0 = sigmoidf_(lbl[h * 128 + ch0] - lbl[HW + h * 128 + ch0]), lb1 = sigmoidf_(lbl[h * 128 + ch0 + 1] - lbl[HW + h * 128 + ch0 + 1]);
    f32x4 st[8];
    float* Gu = HG + (size_t)unit * 16384;
    if (PASS_C) {
#pragma unroll
        for (int tk = 0; tk < 8; ++tk)
#pragma unroll
            for (int e = 0; e < 4; ++e) st[tk][e] = Gu[(16 * w + 4 * q + e) * 128 + 16 * tk + r];
#pragma unroll
        for (int tk = 0; tk < 8; ++tk)
#pragma unroll
            for (int e = 0; e < 4; ++e) *(LAS bf16*)(L + HG_ST + ((16 * w + 4 * q + e) * HG_PQ + 16 * tk + r) * 2) = f2bf16(st[tk][e]);
    } else {
#pragma unroll
        for (int tk = 0; tk < 8; ++tk) st[tk] = (f32x4){0.f, 0.f, 0.f, 0.f};
    }
    float tl0 = 0.f, tl1 = 0.f;
    const int nch = (c == 0) ? 5 : 4;
    unsigned Lf[8], Lv[8], Lq[8];
#define HG_LOAD(cj) do { const bool mc_ = (c == 0 && (cj) == 0); const size_t r0_ = (size_t)b * SEQ + c * 256 + ((c == 0) ? (cj) - 1 : (cj)) * 64; \
        _Pragma("unroll") for (int i = 0; i < 8; ++i) { const int t = 8 * w + i; const size_t row = mc_ ? (size_t)(MR + (t < 48 ? 0 : t - 48)) : r0_ + t; const bf16* pr = proj + row * INC + h * 128 + ch0; \
            Lf[i] = *(const GAS unsigned*)(pr + HW); Lv[i] = *(const GAS unsigned*)(pr + 2 * HW); if (PASS_C) Lq[i] = *(const GAS unsigned*)pr; } } while (0)
    HG_LOAD(0);
    for (int ci = 0; ci < nch; ++ci) {
        const bool metac = (c == 0 && ci == 0);
        const int s = (c == 0) ? ci - 1 : ci;
        const size_t row0 = (size_t)b * SEQ + c * 256 + s * 64;
        float lc0[8], lc1[8], kk0[8], kk1[8], qa0[8], qa1[8]; unsigned vv[8];
        float run0 = 0.f, run1 = 0.f;
#pragma unroll
        for (int i = 0; i < 8; ++i) { const int t = 8 * w + i; const bool nul = metac && t < 48;
            const unsigned fw = Lf[i]; const unsigned vw = Lv[i];
            const float sg0 = sigmoidf_(bflo(fw)), sg1 = sigmoidf_(bfhi(fw));
            const float l0 = nul ? 0.f : __logf(lb0 + (1.f - lb0) * sg0), l1 = nul ? 0.f : __logf(lb1 + (1.f - lb1) * sg1);
            run0 += l0; run1 += l1; lc0[i] = run0; lc1[i] = run1;
            kk0[i] = nul ? 0.f : (1.f - lb0) * (1.f - sg0); kk1[i] = nul ? 0.f : (1.f - lb1) * (1.f - sg1); vv[i] = nul ? 0u : vw;
            if (PASS_C) { const unsigned qw = Lq[i]; qa0[i] = nul ? 0.f : siluf_(bflo(qw)); qa1[i] = nul ? 0.f : siluf_(bfhi(qw)); } }
        if (ci + 1 < nch) HG_LOAD(ci + 1);
        *(LAS float*)(L + HG_PART + (w * 128 + ch0) * 4) = run0; *(LAS float*)(L + HG_PART + (w * 128 + ch0 + 1) * 4) = run1;
        LSYNC();
        float pre0 = 0.f, pre1 = 0.f, mid0 = 0.f, mid1 = 0.f, last0 = 0.f, last1 = 0.f;
#pragma unroll
        for (int ww = 0; ww < 8; ++ww) { const float p0 = *(LAS float*)(L + HG_PART + (ww * 128 + ch0) * 4), p1 = *(LAS float*)(L + HG_PART + (ww * 128 + ch0 + 1) * 4);
            if (ww < w) { pre0 += p0; pre1 += p1; } if (ww < 4) { mid0 += p0; mid1 += p1; } last0 += p0; last1 += p1; }
        tl0 += last0; tl1 += last1;
        if (w == 0) { *(LAS float*)(L + HG_EL + ch0 * 4) = __expf(last0); *(LAS float*)(L + HG_EL + (ch0 + 1) * 4) = __expf(last1); }
        const float em0 = __expf(mid0), em1 = __expf(mid1), elm0 = __expf(last0 - mid0), elm1 = __expf(last1 - mid1);
        unsigned ktw0[4], ktw1[4], vtw0[4], vtw1[4];
#pragma unroll
        for (int i = 0; i < 8; i += 2) {
            float kl0[2], kl1[2];
#pragma unroll
            for (int j = 0; j < 2; ++j) { const int t = 8 * w + i + j; const float c0 = pre0 + lc0[i + j] - mid0, c1 = pre1 + lc1[i + j] - mid1;
                const float kt0 = kk0[i + j] * __expf(-c0), kt1 = kk1[i + j] * __expf(-c1);
                kl0[j] = kt0 * elm0; kl1[j] = kt1 * elm1;
                if (PASS_C) { const float qt0 = qa0[i + j] * __expf(c0), qt1 = qa1[i + j] * __expf(c1);
                    *(LAS unsigned*)(L + HG_Q + (t * HG_PQ + ch0) * 2) = pk2(qt0, qt1); *(LAS unsigned*)(L + HG_Q0 + (t * HG_PQ + ch0) * 2) = pk2(qt0 * em0, qt1 * em1);
                    *(LAS unsigned*)(L + HG_K + (t * HG_PQ + ch0) * 2) = pk2(kt0, kt1); } }
            ktw0[i >> 1] = pk2(kl0[0], kl0[1]); ktw1[i >> 1] = pk2(kl1[0], kl1[1]);
            vtw0[i >> 1] = (vv[i] & 0xffffu) | (vv[i + 1] << 16); vtw1[i >> 1] = (vv[i] >> 16) | (vv[i + 1] & 0xffff0000u); }
        *(LAS v4u*)(L + HG_KT + (ch0 * HG_PT + 8 * w) * 2) = (v4u){ktw0[0], ktw0[1], ktw0[2], ktw0[3]}; *(LAS v4u*)(L + HG_KT + ((ch0 + 1) * HG_PT + 8 * w) * 2) = (v4u){ktw1[0], ktw1[1], ktw1[2], ktw1[3]};
        *(LAS v4u*)(L + HG_VT + (ch0 * HG_PT + 8 * w) * 2) = (v4u){vtw0[0], vtw0[1], vtw0[2], vtw0[3]}; *(LAS v4u*)(L + HG_VT + ((ch0 + 1) * HG_PT + 8 * w) * 2) = (v4u){vtw1[0], vtw1[1], vtw1[2], vtw1[3]};
        LSYNC();
        const bool do_out = PASS_C && !metac;
        if (do_out) {
            v2u gwp[4];
#pragma unroll
            for (int ti2 = 0; ti2 < 4; ++ti2) gwp[ti2] = *(const GAS v2u*)(proj + (row0 + 16 * ti2 + r) * INC + 3 * HW + h * 128 + 16 * w + 4 * q);
            const int ti = w >> 1;
#pragma unroll
            for (int jj = 0; jj < 2; ++jj) { const int tj = 2 * (w & 1) + jj; f32x4 a4 = (f32x4){0.f, 0.f, 0.f, 0.f};
                if (tj <= ti) {
#pragma unroll
                    for (int ks = 0; ks < 4; ++ks) a4 = __builtin_amdgcn_mfma_f32_16x16x32_bf16(lds_frag(L + HG_K, 16 * tj + r, HG_PQ, 32 * ks + 8 * q), lds_frag(L + HG_Q, 16 * ti + r, HG_PQ, 32 * ks + 8 * q), a4, 0, 0, 0);
                    MFMA_SETTLE1(a4);
                    if (tj == ti) {
#pragma unroll
                        for (int e = 0; e < 4; ++e) a4[e] = (4 * q + e <= r) ? a4[e] : 0.f; } }
                *(LAS v2u*)(L + HG_P + ((16 * ti + r) * HG_PT + 16 * tj + 4 * q) * 2) = (v2u){pk2(a4[0], a4[1]), pk2(a4[2], a4[3])}; }
            LSYNC();
            f32x4 o[4];
#pragma unroll
            for (int ti2 = 0; ti2 < 4; ++ti2) o[ti2] = (f32x4){0.f, 0.f, 0.f, 0.f};
#pragma unroll
            for (int ks = 0; ks < 4; ++ks) { const bf16x8 a = lds_frag(L + HG_ST, 16 * w + r, HG_PQ, 32 * ks + 8 * q);
#pragma unroll
                for (int ti2 = 0; ti2 < 4; ++ti2) o[ti2] = __builtin_amdgcn_mfma_f32_16x16x32_bf16(a, lds_frag(L + HG_Q0, 16 * ti2 + r, HG_PQ, 32 * ks + 8 * q), o[ti2], 0, 0, 0); }
#pragma unroll
            for (int js = 0; js < 2; ++js) { const bf16x8 a = lds_frag(L + HG_VT, 16 * w + r, HG_PT, 32 * js + 8 * q);
#pragma unroll
                for (int ti2 = 0; ti2 < 4; ++ti2) o[ti2] = __builtin_amdgcn_mfma_f32_16x16x32_bf16(a, lds_frag(L + HG_P, 16 * ti2 + r, HG_PT, 32 * js + 8 * q), o[ti2], 0, 0, 0); }
            MFMA_SETTLE4(o[0], o[1], o[2], o[3]);
#pragma unroll
            for (int ti2 = 0; ti2 < 4; ++ti2) { float ss = (o[ti2][0] * o[ti2][0] + o[ti2][1] * o[ti2][1]) + (o[ti2][2] * o[ti2][2] + o[ti2][3] * o[ti2][3]);
                ss += __shfl_xor(ss, 16); ss += __shfl_xor(ss, 32);
                if (q == 0) *(LAS float*)(L + HG_RS + (w * 64 + 16 * ti2 + r) * 4) = ss; }
            LSYNC();
            const f32x4 g4 = *(const GAS f32x4*)(gn + h * 128 + 16 * w + 4 * q);
#pragma unroll
            for (int ti2 = 0; ti2 < 4; ++ti2) { float tot = 0.f;
#pragma unroll
                for (int ww = 0; ww < 8; ++ww) tot += *(LAS float*)(L + HG_RS + (ww * 64 + 16 * ti2 + r) * 4);
                const float rs = __builtin_amdgcn_rsqf(tot * (1.f / 128.f) + EPS);
                const size_t row = row0 + 16 * ti2 + r; const v2u gw = gwp[ti2];
                v2u yw; yw.x = pk2(o[ti2][0] * rs * g4[0] * siluf_(bflo(gw.x)), o[ti2][1] * rs * g4[1] * siluf_(bfhi(gw.x))); yw.y = pk2(o[ti2][2] * rs * g4[2] * siluf_(bflo(gw.y)), o[ti2][3] * rs * g4[3] * siluf_(bfhi(gw.y)));
                *(GAS v2u*)(Y + row * D + h * 128 + 16 * w + 4 * q) = yw; }
        }
        if (!(PASS_C && ci == nch - 1)) {
#pragma unroll
            for (int tk = 0; tk < 8; ++tk) { const float el = *(LAS float*)(L + HG_EL + (16 * tk + r) * 4); st[tk] = st[tk] * el; }
#pragma unroll
            for (int js = 0; js < 2; ++js) { const bf16x8 a = lds_frag(L + HG_VT, 16 * w + r, HG_PT, 32 * js + 8 * q);
#pragma unroll
                for (int tk = 0; tk < 8; ++tk) st[tk] = __builtin_amdgcn_mfma_f32_16x16x32_bf16(a, lds_frag(L + HG_KT, 16 * tk + r, HG_PT, 32 * js + 8 * q), st[tk], 0, 0, 0); }
            MFMA_SETTLE8(st[0], st[1], st[2], st[3], st[4], st[5], st[6], st[7]);
            if (PASS_C) {
#pragma unroll
                for (int tk = 0; tk < 8; ++tk)
#pragma unroll
                    for (int e = 0; e < 4; ++e) *(LAS bf16*)(L + HG_ST + ((16 * w + 4 * q + e) * HG_PQ + 16 * tk + r) * 2) = f2bf16(st[tk][e]);
            }
        }
    }
    if (!PASS_C) {
#pragma unroll
        for (int tk = 0; tk < 8; ++tk)
#pragma unroll
            for (int e = 0; e < 4; ++e) Gu[(16 * w + 4 * q + e) * 128 + 16 * tk + r] = st[tk][e];
        if (w == 0) { HD[unit * 128 + ch0] = __expf(tl0); HD[unit * 128 + ch0 + 1] = __expf(tl1); }
    }
    WG_SYNC();
}
__device__ __forceinline__ void hgrn_carry(Frame& F, const float* HG, float* HG2, const float* HD) {
    const int tid = opaque_tid();
    for (int idx = blockIdx.x * 512 + tid; idx < 32 * 16384; idx += F.G * 512) {
        const int bh = idx >> 14, e = idx & 16383, k = e & 127; float S = 0.f;
        float g[16], dk[16];
#pragma unroll
        for (int c = 0; c < 16; ++c) { g[c] = HG[(size_t)(bh * 16 + c) * 16384 + e]; dk[c] = HD[(bh * 16 + c) * 128 + k]; }
#pragma unroll
        for (int c = 0; c < 16; ++c) { HG2[(size_t)(bh * 16 + c) * 16384 + e] = S; S = dk[c] * S + g[c]; }
    }
}

constexpr int LR_P = 264;
constexpr int LR_XC = 0, LR_OH = LR_XC + 64 * LR_P * 2, LR_OA = LR_OH + 64 * LR_P * 2, LR_END = LR_OA + 64 * LR_P * 2;
static_assert(LR_END <= LDSCTL_OFF, "LRU LDS map");
__device__ __forceinline__ void lru_unit(Frame& F, int unit, const bf16* proj, const bf16* WL, const float* cw, const float* cb, const float* b_a, const float* b_x, const float* lam,
                                         bf16* HLOC, bf16* ACUM, float* LC) {
    const int tid = opaque_tid(), lane = tid & 63, w = F.wave, r = lane & 15, q = lane >> 4;
    const int b = unit >> 7, hd = (unit >> 4) & 7, c = unit & 15;
    ldsp L = F.lds;
    const int c8 = tid & 31, tg = tid >> 5;
    float ba[2], bx[2], sp[2], hc[2] = {0.f, 0.f}, pc[2] = {1.f, 1.f};
#pragma unroll
    for (int ct = 0; ct < 2; ++ct) { const int ch = hd * 256 + 32 * w + 16 * ct + r; ba[ct] = b_a[ch]; bx[ct] = b_x[ch]; sp[ct] = pg8::softplus_neg(lam[ch]); }
    const int nsc = (c == 0) ? 5 : 4;
    const int chg = hd * 256 + 8 * c8;
    float wv[4][8], bv[8];
#pragma unroll
    for (int e = 0; e < 8; ++e) { bv[e] = cb[chg + e];
#pragma unroll
        for (int k = 0; k < 4; ++k) wv[k][e] = cw[k * LW + chg + e]; }
    v4u xw[7];
#define LR_LOAD(sj) do { const bool mc_ = (c == 0 && (sj) == 0); const int p0_ = (mc_ ? 0 : NMETA + c * 256 + ((c == 0) ? (sj) - 1 : (sj)) * 64) + 4 * tg - 3; \
        if (tg < (mc_ ? 4 : 16)) { _Pragma("unroll") for (int d = 0; d < 7; ++d) { const int p = p0_ + d; \
            if (p >= 0) { const size_t row = p < NMETA ? (size_t)(MR + p) : (size_t)b * SEQ + p - NMETA; xw[d] = *(const GAS v4u*)(proj + row * INC + 4 * HW + chg); } \
            else xw[d] = (v4u){0u, 0u, 0u, 0u}; } } } while (0)
    LR_LOAD(0);
    for (int si = 0; si < nsc; ++si) {
        const bool metac = (c == 0 && si == 0);
        const int ntt = metac ? 1 : 4;
        const int pos0 = metac ? 0 : NMETA + c * 256 + ((c == 0) ? si - 1 : si) * 64;
        if (tg < 4 * ntt) {
            float xr[7][8];
#pragma unroll
            for (int d = 0; d < 7; ++d) { xr[d][0] = bflo(xw[d].x); xr[d][1] = bfhi(xw[d].x); xr[d][2] = bflo(xw[d].y); xr[d][3] = bfhi(xw[d].y); xr[d][4] = bflo(xw[d].z); xr[d][5] = bfhi(xw[d].z); xr[d][6] = bflo(xw[d].w); xr[d][7] = bfhi(xw[d].w); }
#pragma unroll
            for (int i = 0; i < 4; ++i) { float xo[8];
#pragma unroll
                for (int e = 0; e < 8; ++e) xo[e] = bv[e] + xr[i][e] * wv[0][e] + xr[i + 1][e] * wv[1][e] + xr[i + 2][e] * wv[2][e] + xr[i + 3][e] * wv[3][e];
                *(LAS v4u*)(L + LR_XC + ((4 * tg + i) * LR_P + 8 * c8) * 2) = (v4u){pk2(xo[0], xo[1]), pk2(xo[2], xo[3]), pk2(xo[4], xo[5]), pk2(xo[6], xo[7])}; }
        }
        LSYNC();
        f32x4 ar[2][4], ai[2][4];
#pragma unroll
        for (int ct = 0; ct < 2; ++ct)
#pragma unroll
            for (int tt = 0; tt < 4; ++tt) { ar[ct][tt] = (f32x4){0.f, 0.f, 0.f, 0.f}; ai[ct][tt] = (f32x4){0.f, 0.f, 0.f, 0.f}; }
        const bf16* wrow = WL + (size_t)(512 * hd + 256 * (w >> 2) + 32 * (w & 3) + r) * 256 + 8 * q;
#pragma unroll 4
        for (int ks = 0; ks < 8; ++ks) {
            bf16x8 br[2], bi[2];
#pragma unroll
            for (int ct = 0; ct < 2; ++ct) { br[ct] = *(const GAS bf16x8*)(wrow + (size_t)(16 * ct) * 256 + 32 * ks); bi[ct] = *(const GAS bf16x8*)(wrow + (size_t)(16 * ct + 128) * 256 + 32 * ks); }
#pragma unroll
            for (int tt = 0; tt < 4; ++tt) { if (tt < ntt) { const bf16x8 a = lds_frag(L + LR_XC, 16 * tt + r, LR_P, 32 * ks + 8 * q);
#pragma unroll
                for (int ct = 0; ct < 2; ++ct) { ar[ct][tt] = __builtin_amdgcn_mfma_f32_16x16x32_bf16(a, br[ct], ar[ct][tt], 0, 0, 0); ai[ct][tt] = __builtin_amdgcn_mfma_f32_16x16x32_bf16(a, bi[ct], ai[ct][tt], 0, 0, 0); } } }
        }
        MFMA_SETTLE8(ar[0][0], ar[0][1], ar[0][2], ar[0][3], ar[1][0], ar[1][1], ar[1][2], ar[1][3]); MFMA_SETTLE8(ai[0][0], ai[0][1], ai[0][2], ai[0][3], ai[1][0], ai[1][1], ai[1][2], ai[1][3]);
        if (si + 1 < nsc) LR_LOAD(si + 1);
#pragma unroll
        for (int ct = 0; ct < 2; ++ct) {
#pragma unroll
            for (int tt = 0; tt < 4; ++tt) { if (tt < ntt) {
                float al[4], hl[4]; float P = 1.f, H = 0.f;
#pragma unroll
                for (int e = 0; e < 4; ++e) { const int t = 16 * tt + 4 * q + e; const float xcv = bf2f(*(LAS bf16*)(L + LR_XC + (t * LR_P + 32 * w + 16 * ct + r) * 2));
                    float a, d; pg8::lru_gate_math(ar[ct][tt][e], ai[ct][tt][e], ba[ct], bx[ct], sp[ct], xcv, a, d); H = a * H + d; P *= a; al[e] = P; hl[e] = H; }
                float Pi = P, Hi = H;
                { const float Pp = __shfl(Pi, lane - 16), Hp = __shfl(Hi, lane - 16); if (q >= 1) { Hi = Pi * Hp + Hi; Pi = Pp * Pi; } }
                { const float Pp = __shfl(Pi, lane - 32), Hp = __shfl(Hi, lane - 32); if (q >= 2) { Hi = Pi * Hp + Hi; Pi = Pp * Pi; } }
                float Pe = __shfl(Pi, lane - 16), He = __shfl(Hi, lane - 16); if (q == 0) { Pe = 1.f; He = 0.f; }
                const float Pt = __shfl(Pi, 48 + r), Ht = __shfl(Hi, 48 + r);
                const float hin = Pe * hc[ct] + He, pin = pc[ct] * Pe;
                if (!metac) {
#pragma unroll
                    for (int e = 0; e < 4; ++e) { const int t = 16 * tt + 4 * q + e; const int o = (t * LR_P + 32 * w + 16 * ct + r) * 2;
                        *(LAS bf16*)(L + LR_OH + o) = f2bf16(al[e] * hin + hl[e]); *(LAS bf16*)(L + LR_OA + o) = f2bf16(pin * al[e]); } }
                hc[ct] = Pt * hc[ct] + Ht; pc[ct] = pc[ct] * Pt; } }
        }
        LSYNC();
        if (!metac) {
            const size_t rowb = (size_t)b * SEQ + pos0 - NMETA;
#pragma unroll
            for (int i = 0; i < 4; ++i) { const int t = 4 * tg + i; const size_t go = (rowb + t) * LW + hd * 256 + 8 * c8;
                *(GAS v4u*)(HLOC + go) = *(LAS v4u*)(L + LR_OH + (t * LR_P + 8 * c8) * 2); *(GAS v4u*)(ACUM + go) = *(LAS v4u*)(L + LR_OA + (t * LR_P + 8 * c8) * 2); }
        }
    }
    if (q == 0) {
#pragma unroll
        for (int ct = 0; ct < 2; ++ct) { const int ch = hd * 256 + 32 * w + 16 * ct + r; LC[(size_t)((b * 16 + c) * 2 + 0) * LW + ch] = pc[ct]; LC[(size_t)((b * 16 + c) * 2 + 1) * LW + ch] = hc[ct]; }
    }
    WG_SYNC();
}
__device__ __forceinline__ void lru_finish(Frame& F, const bf16* HLOC, const bf16* ACUM, const float* LC, const bf16* proj, const float* ln, bf16* Y) {
    const int tid = opaque_tid(), lane = tid & 63, w = F.wave;
    LAS float* HIN = (LAS float*)(F.lds);
    for (int item = blockIdx.x; item < 256; item += F.G) {
        const int b = item >> 7, c = (item >> 3) & 15, sub = item & 7;
        { f32x4 hin = (f32x4){0.f, 0.f, 0.f, 0.f};
#pragma unroll
          for (int c0 = 0; c0 < 16; c0 += 8) { if (c0 < c) { f32x4 P[8], H[8];
#pragma unroll
              for (int j = 0; j < 8; ++j) { const int cs = (c0 + j < c) ? c0 + j : 0; P[j] = *(const GAS f32x4*)(LC + (size_t)((b * 16 + cs) * 2 + 0) * LW + 4 * tid); H[j] = *(const GAS f32x4*)(LC + (size_t)((b * 16 + cs) * 2 + 1) * LW + 4 * tid); }
#pragma unroll
              for (int j = 0; j < 8; ++j) { if (c0 + j < c) hin = P[j] * hin + H[j]; } } }
          *(LAS f32x4*)(HIN + 4 * tid) = hin; }
        WG_SYNC();
#pragma unroll 1
        for (int rr = 0; rr < 4; ++rr) { const size_t row = (size_t)b * SEQ + c * 256 + sub * 32 + w * 4 + rr;
            float hv[4][8]; float ss = 0.f;
#pragma unroll
            for (int j = 0; j < 4; ++j) { const int ch = (lane + 64 * j) * 8; const v4u hw = *(const GAS v4u*)(HLOC + row * LW + ch), aw = *(const GAS v4u*)(ACUM + row * LW + ch);
                const f32x4 i0 = *(LAS f32x4*)(HIN + ch), i1 = *(LAS f32x4*)(HIN + ch + 4);
                hv[j][0] = bflo(hw.x) + bflo(aw.x) * i0[0]; hv[j][1] = bfhi(hw.x) + bfhi(aw.x) * i0[1]; hv[j][2] = bflo(hw.y) + bflo(aw.y) * i0[2]; hv[j][3] = bfhi(hw.y) + bfhi(aw.y) * i0[3];
                hv[j][4] = bflo(hw.z) + bflo(aw.z) * i1[0]; hv[j][5] = bfhi(hw.z) + bfhi(aw.z) * i1[1]; hv[j][6] = bflo(hw.w) + bflo(aw.w) * i1[2]; hv[j][7] = bfhi(hw.w) + bfhi(aw.w) * i1[3];
#pragma unroll
                for (int e = 0; e < 8; ++e) ss += hv[j][e] * hv[j][e]; }
            const float rs = __builtin_amdgcn_rsqf(wave_sum(ss) * (1.f / LW) + EPS);
#pragma unroll
            for (int j = 0; j < 4; ++j) { const int ch = (lane + 64 * j) * 8; const v4u gw = *(const GAS v4u*)(proj + row * INC + 4 * HW + LW + ch);
                const f32x4 l0 = *(const GAS f32x4*)(ln + ch), l1 = *(const GAS f32x4*)(ln + ch + 4);
                v4u yw; yw.x = pk2(hv[j][0] * rs * l0[0] * gelu_tanh(bflo(gw.x)), hv[j][1] * rs * l0[1] * gelu_tanh(bfhi(gw.x))); yw.y = pk2(hv[j][2] * rs * l0[2] * gelu_tanh(bflo(gw.y)), hv[j][3] * rs * l0[3] * gelu_tanh(bfhi(gw.y)));
                yw.z = pk2(hv[j][4] * rs * l1[0] * gelu_tanh(bflo(gw.z)), hv[j][5] * rs * l1[1] * gelu_tanh(bfhi(gw.z))); yw.w = pk2(hv[j][6] * rs * l1[2] * gelu_tanh(bflo(gw.w)), hv[j][7] * rs * l1[3] * gelu_tanh(bfhi(gw.w)));
                *(GAS v4u*)(Y + row * D + HW + ch) = yw; } }
        WG_SYNC();
    }
}

#ifndef PHASE_MASK
#define PHASE_MASK 0xFFFFFFFF
#endif
#ifndef DUP_MASK
#define DUP_MASK 0
#endif
#define PH(k) if constexpr ((PHASE_MASK >> (k)) & 1) _Pragma("unroll") for (int rep_ = 0; rep_ < 1 + (int)((DUP_MASK >> (k)) & 1); ++rep_)
__global__ void __launch_bounds__(NWAVES * 64, 2) hymba_fwd(Args args) {
    extern __shared__ __attribute__((aligned(16))) unsigned char lds[];
    Frame F;
    F.lds = (LAS unsigned char*)lds;
    F.MISC = (volatile LAS unsigned*)(F.lds + MISC_OFF);
    F.tid = threadIdx.x; F.lane = F.tid & 63; F.wave = __builtin_amdgcn_readfirstlane(F.tid >> 6);
    F.G = gridDim.x; { const int bx = blockIdx.x; F.vcu = (F.G % 8 == 0) ? (bx % 8) * (F.G / 8) + bx / 8 : bx; }
    unsigned char* ws = args.ws;
    F.ctl = (gu32*)(ws + WS_CTL);
    for (int u = F.tid; u < (LDS_BYTES - LDSCTL_OFF) / 4; u += NWAVES * 64) ((LAS unsigned*)(F.lds + LDSCTL_OFF))[u] = 0u;
    __syncthreads();
    XcdBarrier bar = xcd_barrier_post((unsigned*)(F.ctl + CW_BAR), F.MISC + 8);
#define GRID_BAR() do { XcdBarrier b_ = bar; asm volatile("" : "+s"(b_.bar), "+s"(b_.x)); xcd_barrier(b_); } while (0)

    const float* x = args.in[0]; const float* meta = args.in[1];
    bf16* WGU1 = (bf16*)(ws + WS_WGU1); bf16* WD1 = (bf16*)(ws + WS_WD1); bf16* WIN = (bf16*)(ws + WS_WIN); bf16* WOUT = (bf16*)(ws + WS_WOUT);
    bf16* WGU2 = (bf16*)(ws + WS_WGU2); bf16* WD2 = (bf16*)(ws + WS_WD2); bf16* WLRU = (bf16*)(ws + WS_WLRU);
    bf16* U = (bf16*)(ws + WS_U); bf16* HID = (bf16*)(ws + WS_BIG); bf16* PROJ = (bf16*)(ws + WS_BIG);
    bf16* Fb = (bf16*)(ws + WS_F);
    float* HGs = (float*)(ws + WS_HG); float* HGs2 = (float*)(ws + WS_HG2); float* HDs = (float*)(ws + WS_HD); float* LC = (float*)(ws + WS_LC); bf16* HLOC = (bf16*)(ws + WS_HLOC); bf16* ACUM = (bf16*)(ws + WS_ACUM); bf16* Y = (bf16*)(ws + WS_Y); bf16* HB = (bf16*)(ws + WS_HB);
    float* out = args.out;
    const int gw = F.vcu * NWAVES + F.wave, NGW = F.G * NWAVES;

    PH(0) {
        LAS float* scr = (LAS float*)(F.lds + RING_OFF + F.wave * 16896); const int lane0 = opaque_lane();
        p0_convert_all(args, WGU1, WD1, WIN, WOUT, WGU2, WD2, WLRU, scr, gw, NGW, lane0);
        for (int m = gw; m < MT; m += NGW) rms_row_to_bf16(m < MR ? x + (size_t)m * D : meta + (size_t)(m - MR) * D, args.in[2], U, m, lane0);
    }
    GRID_BAR();

    PH(1) {
        skinny_phase<2, 3>(F, U, D, WGU1, D, D, FF / 16, MapGateUp{}, SkEpiSwiGLU{HID});
        pg8::Gemm g{U, WGU1, MR, 2 * FF, D, D, D, 0, 0}; pg8::StaticOrder S; S.init(MR, 2 * FF, F.G, (int)blockIdx.x);
        pg8::EpiSwiGLU E{HID, FF};
        pg8::gemm_phase<pg8::EpiSwiGLU, pg8::StaticOrder, true, true>(F.lds + RING_OFF, g, S, E, F.wave);
    }
    GRID_BAR();
    PH(2) {
        skinny_phase<1, 1>(F, HID, 0, WD1, FF, FF, D / 16, MapPlain{}, SkEpiBf16{Fb, D});
        pg8::Gemm g{HID, WD1, MR, D, FF, FF, FF, 0, 1}; pg8::StaticOrder S; S.init(MR, D, F.G, (int)blockIdx.x);
        pg8::EpiBf16 E{Fb, D};
        pg8::gemm_phase<pg8::EpiBf16, pg8::StaticOrder, true, true>(F.lds + RING_OFF, g, S, E, F.wave);
    }
    GRID_BAR();
    PH(3) { norm_rows<0>(Fb, x, meta, nullptr, HB, nullptr, U, args.in[6], args.in[7], 0.5f, MR, gw, NGW);
        for (int m = blockIdx.x; m < NMETA; m += F.G) norm_meta_row(F, m, Fb, meta, U, args.in[6], args.in[7], 0.5f); }
    GRID_BAR();
    PH(4) {
        skinny_phase<1, 3>(F, U, D, WIN, D, D, INC / 16, MapPlain{}, SkEpiBf16{PROJ, INC});
        pg8::Gemm g{U, WIN, MR, INC, D, D, D, 0, 0}; pg8::StaticOrder S; S.init(MR, INC, F.G, (int)blockIdx.x);
        pg8::EpiBf16 E{PROJ, INC};
        pg8::gemm_phase<pg8::EpiBf16, pg8::StaticOrder, true, true>(F.lds + RING_OFF, g, S, E, F.wave);
    }
    GRID_BAR();
    PH(5) {
        for (int u = blockIdx.x; u < 256; u += F.G) lru_unit(F, u, PROJ, WLRU, args.in[11], args.in[12], args.in[14], args.in[16], args.in[17], HLOC, ACUM, LC);
        for (int i = blockIdx.x; i < 512; i += F.G) { const int u = (i & ~255) | ((i + 4 + 4 * (i >> 8)) & 255); hgrn_unit<false>(F, u, PROJ, args.in[9], args.in[10], HGs, HDs, Y); }
    }
    GRID_BAR();
    PH(6) { hgrn_carry(F, HGs, HGs2, HDs); lru_finish(F, HLOC, ACUM, LC, PROJ, args.in[18], Y); }
    GRID_BAR();
    PH(7) { for (int i = blockIdx.x; i < 512; i += F.G) { const int u = (i & ~255) | ((i + 8 * (i >> 8)) & 255); hgrn_unit<true>(F, u, PROJ, args.in[9], args.in[10], HGs2, HDs, Y); } }
    GRID_BAR();
    PH(9) {
        pg8::Gemm g{Y, WOUT, MR, D, D, D, D, 0, 0}; pg8::StaticOrder S; S.init(MR, D, F.G, (int)blockIdx.x);
        pg8::EpiBf16 E{Fb, D};
        pg8::gemm_phase<pg8::EpiBf16, pg8::StaticOrder, true, true>(F.lds + RING_OFF, g, S, E, F.wave);
    }
    GRID_BAR();
    PH(10) norm_rows<1>(Fb, nullptr, nullptr, HB, HB, nullptr, U, args.in[20], args.in[21], 1.0f, MR, gw, NGW);
    GRID_BAR();
    PH(11) {
        pg8::Gemm g{U, WGU2, MR, 2 * FF, D, D, D, 0, 0}; pg8::StaticOrder S; S.init(MR, 2 * FF, F.G, (int)blockIdx.x);
        pg8::EpiSwiGLU E{HID, FF};
        pg8::gemm_phase<pg8::EpiSwiGLU, pg8::StaticOrder, true, true>(F.lds + RING_OFF, g, S, E, F.wave);
    }
    GRID_BAR();
    PH(12) {
        pg8::Gemm g{HID, WD2, MR, D, FF, FF, FF, 0, 1}; pg8::StaticOrder S; S.init(MR, D, F.G, (int)blockIdx.x);
        pg8::EpiBf16 E{Fb, D};
        pg8::gemm_phase<pg8::EpiBf16, pg8::StaticOrder, true, true>(F.lds + RING_OFF, g, S, E, F.wave);
    }
    GRID_BAR();
    PH(13) norm_rows<2>(Fb, nullptr, nullptr, HB, nullptr, out, nullptr, args.in[25], nullptr, 0.5f, MR, gw, NGW);
}

extern "C" void kernel_launch(void* const* d_in, const int* in_sizes, int n_in, void* d_out, int out_size, void* d_ws, size_t ws_size, hipStream_t stream) {
    static int grid = 0;
    if (grid == 0) {
        if (n_in != 26 || out_size != MR * D || ws_size < WS_END) { fprintf(stderr, "kernel_launch: unexpected shapes (n_in %d, out %d, ws %zu, need %zu)\n", n_in, out_size, ws_size, (size_t)WS_END); grid = -1; return; }
        int dev = 0, cus = 0, per_cu = 0;
        if (hipGetDevice(&dev) != hipSuccess || hipDeviceGetAttribute(&cus, hipDeviceAttributeMultiprocessorCount, dev) != hipSuccess) { grid = -1; return; }
        if (hipFuncSetAttribute((const void*)hymba_fwd, hipFuncAttributeMaxDynamicSharedMemorySize, LDS_BYTES) != hipSuccess) { fprintf(stderr, "kernel_launch: hipFuncSetAttribute failed\n"); grid = -1; return; }
        if (hipOccupancyMaxActiveBlocksPerMultiprocessor(&per_cu, (const void*)hymba_fwd, NWAVES * 64, LDS_BYTES) != hipSuccess || per_cu < 1) fprintf(stderr, "kernel_launch: occupancy query says %d\n", per_cu);
        (void)hipGetLastError();
        grid = cus;
    }
    if (grid < 0) return;
    if (hipMemsetAsync((char*)d_ws + WS_CTL, 0, CTL_ZERO_BYTES, stream) != hipSuccess) return;
    Args a{};
    for (int i = 0; i < 26; ++i) a.in[i] = (const float*)d_in[i];
    a.out = (float*)d_out; a.ws = (unsigned char*)d_ws;
    hipLaunchKernelGGL(hymba_fwd, dim3(grid), dim3(NWAVES * 64), LDS_BYTES, stream, a);
}
```

```cpp
#include <hip/hip_runtime.h>
#include <cstdio>
#include <cstdint>

namespace pg8 {
#define PG8_LAS __attribute__((address_space(3)))
typedef unsigned short bf16_t;
typedef short bf16x8 __attribute__((ext_vector_type(8)));
typedef float f32x4 __attribute__((ext_vector_type(4)));
typedef float f32x2 __attribute__((ext_vector_type(2)));
typedef unsigned u32x4 __attribute__((ext_vector_type(4)));
typedef unsigned u32x2 __attribute__((ext_vector_type(2)));
constexpr int BM = 256, BK = 64, HALF = 128, HTB = HALF * BK * 2, STAGE_BYTES = 8 * HTB, NXCD = 8, WGM = 8;

__host__ __device__ __forceinline__ int lds_byte(int r, int c) { const int st = (r >> 4) * 2 + (c >> 5), rr = r & 15, cc = c & 31, ob = rr * 64 + cc * 2; return st * 1024 + (ob ^ (((ob >> 9) & 1) << 5)); }
__host__ __device__ __forceinline__ void stage_rc(int b, int& R, int& C) { const int st = b / 1024, sb = b % 1024, swz = sb ^ (((sb >> 9) & 1) << 5); R = (st >> 1) * 16 + swz / 64; C = (st & 1) * 32 + (swz % 64) / 2; }
__host__ __device__ __forceinline__ int perm32(int rho) { const int n = rho >> 4, i = rho & 15; return 8 * (i >> 2) + 4 * n + (i & 3); }

struct Unit { int pm, pn; };
struct Gemm { const bf16_t* A; const bf16_t* Bt; int M, N, K, lda, ldb, agrp, ablk; };

struct StaticOrder {
    int nM, nN, nwg, G, c;
    __host__ __device__ void init(int M, int N, int G_, int c_) { nM = M / BM; nN = N / BM; nwg = nM * nN; G = G_; c = c_; }
    __host__ __device__ bool next(int i, Unit& u) const {
        const long L = (long)i * G + c; if (L >= nwg) return false;
        int wgid = (int)L; { const int q = nwg / NXCD, r = nwg % NXCD, xcd = wgid % NXCD, off = wgid / NXCD; wgid = (xcd < r ? xcd * (q + 1) : r * (q + 1) + (xcd - r) * q) + off; }
        const int nig = WGM * nN, gid = wgid / nig, fm = gid * WGM, gsz = (nM - fm) < WGM ? (nM - fm) : WGM;
        u.pm = fm + ((wgid % nig) % gsz); u.pn = (wgid % nig) / gsz; return true;
    }
    __device__ __forceinline__ void a_ready(const Unit&) const {}
    __device__ __forceinline__ void done(const Unit&) const {}
};

__device__ __forceinline__ unsigned cvt_pk_bf16(float lo, float hi) { unsigned r; asm volatile("v_cvt_pk_bf16_f32 %0, %1, %2" : "=v"(r) : "v"(lo), "v"(hi)); return r; }
__device__ __forceinline__ float fast_sigmoid(float x) { return __builtin_amdgcn_rcpf(1.0f + __builtin_amdgcn_exp2f(-1.44269504089f * x)); }
__device__ __forceinline__ float fast_silu(float x) { return x * fast_sigmoid(x); }

struct EpiF32 {
    static constexpr bool PERM = false, AFTER_DRAIN = false;
    float* C; int ldc;
    __device__ __forceinline__ void operator()(const f32x4 (&acc)[2][2][4][2], const Unit& u, int wr, int wc, int fr, int fq) const {
        const int row0 = u.pm * BM + wr * 64 + fr, col0 = u.pn * BM + wc * 32 + 4 * fq;
#pragma unroll
        for (int ai = 0; ai < 2; ++ai)
#pragma unroll
            for (int m = 0; m < 4; ++m) { float* rowp = C + (size_t)(row0 + ai * HALF + m * 16) * ldc + col0;
#pragma unroll
                for (int bj = 0; bj < 2; ++bj)
#pragma unroll
                    for (int n = 0; n < 2; ++n) *(f32x4*)(rowp + bj * HALF + n * 16) = acc[ai][bj][m][n]; }
    }
};
struct EpiBf16 {
    static constexpr bool PERM = true, AFTER_DRAIN = false;
    bf16_t* O; int ldc;
    __device__ __forceinline__ void operator()(const f32x4 (&acc)[2][2][4][2], const Unit& u, int wr, int wc, int fr, int fq) const {
        const int row0 = u.pm * BM + wr * 64 + fr, col0 = u.pn * BM + wc * 32 + 8 * fq;
#pragma unroll
        for (int ai = 0; ai < 2; ++ai)
#pragma unroll
            for (int m = 0; m < 4; ++m) { bf16_t* rowp = O + (size_t)(row0 + ai * HALF + m * 16) * ldc + col0;
#pragma unroll
                for (int bj = 0; bj < 2; ++bj) { const f32x4 v0 = acc[ai][bj][m][0], v1 = acc[ai][bj][m][1];
                    u32x4 w; w.x = cvt_pk_bf16(v0[0], v0[1]); w.y = cvt_pk_bf16(v0[2], v0[3]); w.z = cvt_pk_bf16(v1[0], v1[1]); w.w = cvt_pk_bf16(v1[2], v1[3]);
                    *(u32x4*)(rowp + bj * HALF) = w; } }
    }
};
struct EpiSwiGLU {
    static constexpr bool PERM = true, AFTER_DRAIN = false;
    bf16_t* O; int ldc;
    __device__ __forceinline__ void operator()(const f32x4 (&acc)[2][2][4][2], const Unit& u, int wr, int wc, int fr, int fq) const {
#pragma unroll
        for (int ai = 0; ai < 2; ++ai)
#pragma unroll
            for (int m = 0; m < 4; ++m) { bf16_t* rowp = O + ((((size_t)(u.pm * 16 + ai * 8 + wr * 4 + m)) * (ldc >> 5) + u.pn * 4 + wc) << 9) + fr * 32 + 8 * fq;
                const f32x4 g0 = acc[ai][0][m][0], g1 = acc[ai][0][m][1], u0 = acc[ai][1][m][0], u1 = acc[ai][1][m][1];
                f32x4 v0, v1;
#pragma unroll
                for (int e = 0; e < 4; ++e) { v0[e] = fast_silu(g0[e]) * u0[e]; v1[e] = fast_silu(g1[e]) * u1[e]; }
                u32x4 w; w.x = cvt_pk_bf16(v0[0], v0[1]); w.y = cvt_pk_bf16(v0[2], v0[3]); w.z = cvt_pk_bf16(v1[0], v1[1]); w.w = cvt_pk_bf16(v1[2], v1[3]);
                *(u32x4*)rowp = w; }
    }
};
__device__ __forceinline__ float softplus_neg(float lam) { const float y = __expf(-lam); return y < 0.05f ? y * (1.0f - y * (0.5f - y * (0.33333334f - y * 0.25f))) : __logf(1.0f + y); }
__device__ __forceinline__ float neg_expm1(float x) { const float s = -x * (1.0f + x * (0.5f + x * (0.16666667f + x * (0.041666668f + x * 0.0083333338f)))); return x > -0.1f ? s : 1.0f - __expf(x); }
__device__ __forceinline__ void lru_gate_math(float rp, float ip, float ba, float bx, float sp, float xcv, float& a, float& d) {
    const float r = fast_sigmoid(rp + ba), ig = fast_sigmoid(ip + bx);
    const float la = -8.0f * r * sp; a = __expf(la); const float x2 = 2.0f * la;
    const float ser = -x2 * (1.0f + x2 * (0.5f + x2 * (0.16666667f + x2 * (0.041666668f + x2 * 0.0083333338f))));
    d = __builtin_amdgcn_sqrtf(x2 > -0.1f ? ser : 1.0f - a * a) * (ig * xcv);
}
struct EpiLru {
    static constexpr bool PERM = false, AFTER_DRAIN = false;
    float* Aout; float* Dout; const bf16_t* XC; const float* b_a; const float* b_x; const float* lam;
    __device__ __forceinline__ void operator()(const f32x4 (&acc)[2][2][4][2], const Unit& u, int wr, int wc, int fr, int fq) const {
        const int chu = (u.pn >> 1) * 256 + (u.pn & 1) * 128 + wc * 32;
        const size_t rowu = (size_t)(u.pm * BM + wr * 64);
        const unsigned lo = (unsigned)(fr * 2048 + 4 * fq);
#pragma unroll
        for (int n = 0; n < 2; ++n) { const int ch = chu + n * 16 + 4 * fq;
            const f32x4 ba = *(const f32x4*)(b_a + ch), bx = *(const f32x4*)(b_x + ch), l = *(const f32x4*)(lam + ch); f32x4 sp;
#pragma unroll
            for (int e = 0; e < 4; ++e) sp[e] = softplus_neg(l[e]);
#pragma unroll
            for (int ai = 0; ai < 2; ++ai)
#pragma unroll
                for (int m = 0; m < 4; ++m) { const size_t ub = (rowu + ai * HALF + m * 16) * 2048 + chu + n * 16;
                    const u32x2 xw = *(const u32x2*)((const char*)(XC + ub) + lo * 2u);
                    const float xv[4] = {__uint_as_float(xw.x << 16), __uint_as_float(xw.x & 0xffff0000u), __uint_as_float(xw.y << 16), __uint_as_float(xw.y & 0xffff0000u)};
                    f32x4 av, dv;
#pragma unroll
                    for (int e = 0; e < 4; ++e) { float a, d; lru_gate_math(acc[ai][0][m][n][e], acc[ai][1][m][n][e], ba[e], bx[e], sp[e], xv[e], a, d); av[e] = a; dv[e] = d; }
                    *(f32x4*)((char*)(Aout + ub) + lo * 4u) = av; *(f32x4*)((char*)(Dout + ub) + lo * 4u) = dv;
                    asm volatile("" ::: "memory"); } }
    }
};

template <class Epi, class Sched, bool ALIGN_EPI = false, bool SP2 = false>
__device__ __forceinline__ void gemm_phase(PG8_LAS unsigned char* lds, const Gemm g, const Sched& S, const Epi& E, int wave_id) {
    int lane_; asm volatile("v_mbcnt_lo_u32_b32 %0, -1, 0\n\tv_mbcnt_hi_u32_b32 %0, -1, %0" : "=v"(lane_));
    const int wid = wave_id, lane = lane_, tid = wid * 64 + lane, wr = wid >> 2, wc = wid & 3, fr = lane & 15, fq = lane >> 4;
    const int K = g.K, nt = K / BK;
    unsigned voffA[2], voffB[2];
#pragma unroll
    for (int i = 0; i < 2; ++i) { int R, C; stage_rc(wid * 2048 + i * 1024 + lane * 16, R, C);
        voffB[i] = (unsigned)((((R >> 4) * (g.K >> 5) + (C >> 5)) << 10) + (R & 15) * 64 + (C & 31) * 2); voffA[i] = g.ablk ? voffB[i] : (unsigned)(R * g.lda + C) * 2u; }
    static_assert(Epi::PERM, "the blocked weight layout stores the rows in the PERM order");
    const size_t kstep = g.ablk ? (size_t)2048 : (size_t)(BK * 2), kstepB = 2048;
    const size_t hsA = (size_t)HALF * g.lda * 2, hsB = (size_t)HALF * g.K * 2;
    const size_t tsA = 2 * hsA, tsB = 2 * hsB;
    const size_t agb = g.agrp ? (size_t)K * 2 : 0;
    const unsigned ldsw = (unsigned)wid * 2048u;
    const int aoff = lds_byte(wr * 64 + fr, fq * 8), boff = lds_byte(wc * 32 + fr, fq * 8);
#define PG8_SA(b, h) (((b) * 2 + (h)) * HTB)
#define PG8_SB(b, h) ((4 + (b) * 2 + (h)) * HTB)
#define PG8_STAGE(bufoff, gbase, voff) do { _Pragma("unroll") for (int _i = 0; _i < 2; ++_i) \
        __builtin_amdgcn_global_load_lds((const unsigned*)((const char*)(gbase) + (voff)[_i]), (PG8_LAS unsigned*)(lds + (bufoff) + ldsw + _i * 1024), 16, 0, 0); } while (0)
#define PG8_LDA(dst, b, h) do { _Pragma("unroll") for (int m = 0; m < 4; ++m) _Pragma("unroll") for (int k = 0; k < 2; ++k) dst[m][k] = *(const PG8_LAS bf16x8*)(lds + PG8_SA(b, h) + aoff + m * 2048 + k * 1024); } while (0)
#define PG8_LDB(dst, b, h) do { _Pragma("unroll") for (int n = 0; n < 2; ++n) _Pragma("unroll") for (int k = 0; k < 2; ++k) dst[n][k] = *(const PG8_LAS bf16x8*)(lds + PG8_SB(b, h) + boff + n * 2048 + k * 1024); } while (0)
#define PG8_MMA(ai, bj, At, Bt) do { __builtin_amdgcn_s_setprio(1); _Pragma("unroll") for (int m = 0; m < 4; ++m) _Pragma("unroll") for (int n = 0; n < 2; ++n) _Pragma("unroll") for (int k = 0; k < 2; ++k) \
        acc[ai][bj][m][n] = __builtin_amdgcn_mfma_f32_16x16x32_bf16(Bt[n][k], At[m][k], acc[ai][bj][m][n], 0, 0, 0); __builtin_amdgcn_s_setprio(0); } while (0)
#define PG8_WAIT_V(n) asm volatile("s_waitcnt vmcnt(" #n ")" ::: "memory")
#define PG8_WAIT_L(n) asm volatile("s_waitcnt lgkmcnt(" #n ")" ::: "memory")
#define PG8_BAR __builtin_amdgcn_s_barrier()
#define PG8_SCHED __builtin_amdgcn_sched_barrier(0)
    Unit cur, nxt; int ui = 0;
    if (!S.next(0, cur)) return;
    f32x4 acc[2][2][4][2];
#pragma unroll
    for (int a = 0; a < 2; ++a)
#pragma unroll
        for (int b = 0; b < 2; ++b)
#pragma unroll
            for (int m = 0; m < 4; ++m)
#pragma unroll
                for (int n = 0; n < 2; ++n) acc[a][b][m][n] = (f32x4){0.f, 0.f, 0.f, 0.f};
    bf16x8 At[4][2], B0[2][2], B1[2][2];
    const char* cA = (const char*)g.A + (size_t)cur.pm * tsA + (size_t)(cur.pn >> 1) * agb; const char* cB = (const char*)g.Bt + (size_t)cur.pn * tsB;
    S.a_ready(cur);
    if constexpr (SP2) {
        PG8_STAGE(PG8_SB(0, 0), cB, voffB); PG8_STAGE(PG8_SB(0, 1), cB + hsB, voffB); PG8_STAGE(PG8_SA(0, 0), cA, voffA); PG8_STAGE(PG8_SA(0, 1), cA + hsA, voffA);
        if (wr == 1) PG8_BAR;
        PG8_WAIT_V(2); PG8_BAR;
        PG8_STAGE(PG8_SB(1, 0), cB + kstepB, voffB); PG8_STAGE(PG8_SA(1, 0), cA + kstep, voffA); PG8_STAGE(PG8_SB(1, 1), cB + hsB + kstepB, voffB);
        PG8_WAIT_V(6); PG8_BAR;
    } else {
        PG8_STAGE(PG8_SB(0, 0), cB, voffB); PG8_STAGE(PG8_SA(0, 0), cA, voffA); PG8_STAGE(PG8_SB(0, 1), cB + hsB, voffB); PG8_STAGE(PG8_SA(0, 1), cA + hsA, voffA);
        if (wr == 1) PG8_BAR;
        PG8_WAIT_V(4); PG8_BAR;
        PG8_STAGE(PG8_SB(1, 0), cB + kstepB, voffB); PG8_STAGE(PG8_SA(1, 0), cA + kstep, voffA); PG8_STAGE(PG8_SB(1, 1), cB + hsB + kstepB, voffB);
        PG8_WAIT_V(6); PG8_BAR;
    }
    for (;;) {
        const bool has_next = S.next(ui + 1, nxt);
        const char* nA = has_next ? (const char*)g.A + (size_t)nxt.pm * tsA + (size_t)(nxt.pn >> 1) * agb : cA; const char* nB = has_next ? (const char*)g.Bt + (size_t)nxt.pn * tsB : cB;
        for (int t = 0; t < nt; t += 2) {
            const bool last = (t == nt - 2);
            const char* a1 = cA + (size_t)(t + 1) * kstep;
            const char* a2 = last ? nA : cA + (size_t)(t + 2) * kstep; const char* b2 = last ? nB : cB + (size_t)(t + 2) * kstepB;
            const char* a3 = a2 + kstep; const char* b3 = b2 + kstepB;
            if (last && has_next) S.a_ready(nxt);
            if constexpr (SP2) {
            PG8_LDB(B0, 0, 0); PG8_LDB(B1, 0, 1); PG8_SCHED; PG8_LDA(At, 0, 0); PG8_STAGE(PG8_SA(1, 1), a1 + hsA, voffA);
            PG8_WAIT_V(8); PG8_WAIT_L(0); PG8_BAR; PG8_MMA(0, 0, At, B0); PG8_MMA(0, 1, At, B1); PG8_BAR; PG8_SCHED;
            PG8_LDA(At, 0, 1); PG8_STAGE(PG8_SB(0, 0), b2, voffB); PG8_STAGE(PG8_SB(0, 1), b2 + hsB, voffB); PG8_STAGE(PG8_SA(0, 0), a2, voffA);
            PG8_WAIT_V(8); PG8_WAIT_L(0); PG8_BAR; PG8_MMA(1, 0, At, B0); PG8_MMA(1, 1, At, B1); PG8_BAR; PG8_SCHED;
            PG8_LDB(B0, 1, 0); PG8_LDB(B1, 1, 1); PG8_SCHED; PG8_LDA(At, 1, 0); PG8_STAGE(PG8_SA(0, 1), a2 + hsA, voffA);
            PG8_WAIT_V(8); PG8_WAIT_L(0); PG8_BAR; PG8_MMA(0, 0, At, B0); PG8_MMA(0, 1, At, B1); PG8_BAR; PG8_SCHED;
            PG8_LDA(At, 1, 1); PG8_STAGE(PG8_SB(1, 0), b3, voffB); PG8_STAGE(PG8_SB(1, 1), b3 + hsB, voffB); PG8_STAGE(PG8_SA(1, 0), a3, voffA);
            PG8_WAIT_V(8); PG8_WAIT_L(0); PG8_BAR; PG8_MMA(1, 0, At, B0); PG8_MMA(1, 1, At, B1); PG8_BAR; PG8_SCHED;
            } else {
            PG8_LDB(B0, 0, 0); PG8_SCHED; PG8_LDA(At, 0, 0); PG8_STAGE(PG8_SA(1, 1), a1 + hsA, voffA);
            PG8_WAIT_L(8); PG8_BAR; PG8_WAIT_L(0); PG8_MMA(0, 0, At, B0); PG8_BAR; PG8_SCHED;
            PG8_LDB(B1, 0, 1); PG8_STAGE(PG8_SB(0, 0), b2, voffB);
            PG8_BAR; PG8_WAIT_L(0); PG8_MMA(0, 1, At, B1); PG8_BAR;
            PG8_LDA(At, 0, 1); PG8_STAGE(PG8_SA(0, 0), a2, voffA);
            PG8_BAR; PG8_WAIT_L(0); PG8_MMA(1, 0, At, B0); PG8_BAR; PG8_SCHED;
            PG8_STAGE(PG8_SB(0, 1), b2 + hsB, voffB);
            PG8_WAIT_V(6); PG8_BAR; PG8_MMA(1, 1, At, B1); PG8_BAR;
            PG8_LDB(B0, 1, 0); PG8_SCHED; PG8_LDA(At, 1, 0); PG8_STAGE(PG8_SA(0, 1), a2 + hsA, voffA);
            PG8_WAIT_L(8); PG8_BAR; PG8_WAIT_L(0); PG8_MMA(0, 0, At, B0); PG8_BAR; PG8_SCHED;
            PG8_LDB(B1, 1, 1); PG8_STAGE(PG8_SB(1, 0), b3, voffB);
            PG8_BAR; PG8_WAIT_L(0); PG8_MMA(0, 1, At, B1); PG8_BAR;
            PG8_LDA(At, 1, 1); PG8_STAGE(PG8_SA(1, 0), a3, voffA);
            PG8_BAR; PG8_WAIT_L(0); PG8_MMA(1, 0, At, B0); PG8_BAR; PG8_SCHED;
            PG8_STAGE(PG8_SB(1, 1), b3 + hsB, voffB);
            PG8_WAIT_V(6); PG8_BAR; PG8_MMA(1, 1, At, B1); PG8_BAR;
            }
        }
        if constexpr (ALIGN_EPI) { if (wr == 0) PG8_BAR; }
        if constexpr (!Epi::AFTER_DRAIN) { E(acc, cur, wr, wc, fr, fq); S.done(cur); }
        if (!has_next) break;
#pragma unroll
        for (int a = 0; a < 2; ++a)
#pragma unroll
            for (int b = 0; b < 2; ++b)
#pragma unroll
                for (int m = 0; m < 4; ++m)
#pragma unroll
                    for (int n = 0; n < 2; ++n) acc[a][b][m][n] = (f32x4){0.f, 0.f, 0.f, 0.f};
        cur = nxt; cA = nA; cB = nB; ++ui;
        if constexpr (ALIGN_EPI) { if (wr == 1) PG8_BAR; }
    }
    PG8_WAIT_V(0);
    if constexpr (!ALIGN_EPI) { if (wr == 0) PG8_BAR; }
    PG8_BAR;
#undef PG8_SA
#undef PG8_SB
#undef PG8_STAGE
#undef PG8_LDA
#undef PG8_LDB
#undef PG8_MMA
#undef PG8_WAIT_V
#undef PG8_WAIT_L
#undef PG8_BAR
#undef PG8_SCHED
}
}

constexpr int NWAVES = 8;
constexpr int D = 4096, SEQ = 4096, NB = 2, NMETA = 16, FF = 11008, INC = 12288, HW = 2048, LW = 2048;
constexpr int MR = NB * SEQ;
constexpr int MT = MR + NMETA;
constexpr float EPS = 1e-6f;

constexpr size_t MiB = 1u << 20;
constexpr size_t WS_CTL = 0, CTL_ZERO_BYTES = 32768;
constexpr size_t WS_WGU1 = 1 * MiB;
constexpr size_t WS_WD1  = WS_WGU1 + 172 * MiB;
constexpr size_t WS_WIN  = WS_WD1 + 86 * MiB;
constexpr size_t WS_WOUT = WS_WIN + 96 * MiB;
constexpr size_t WS_WGU2 = WS_WOUT + 32 * MiB;
constexpr size_t WS_WD2  = WS_WGU2 + 172 * MiB;
constexpr size_t WS_WLRU = WS_WD2 + 86 * MiB;
constexpr size_t WS_U    = WS_WLRU + 2 * MiB;
constexpr size_t WS_BIG  = WS_U + 65 * MiB;
constexpr size_t WS_F    = WS_BIG + 193 * MiB;
constexpr size_t WS_HG   = WS_F + 130 * MiB;
constexpr size_t WS_HG2  = WS_HG + 32 * MiB;
constexpr size_t WS_HD   = WS_HG2 + 32 * MiB;
constexpr size_t WS_LC   = WS_HD + 1 * MiB;
constexpr size_t WS_HLOC = WS_LC + 1 * MiB;
constexpr size_t WS_ACUM = WS_HLOC + 32 * MiB;
constexpr size_t WS_Y    = WS_ACUM + 32 * MiB;
constexpr size_t WS_HB   = WS_Y + 64 * MiB;
constexpr size_t WS_END  = WS_HB + 64 * MiB;
static_assert((size_t)MT * INC * 2 <= 193 * MiB && (size_t)MT * D * 4 <= 130 * MiB && (size_t)MT * D * 2 <= 65 * MiB, "ws map");
constexpr int CW_BAR = 4096;

constexpr int RING_OFF = 0, RING_BYTES = 131072;
constexpr int LDS_BYTES = 163840;
constexpr int LDSCTL_OFF = LDS_BYTES - 1024, MISC_OFF = LDSCTL_OFF + 320;

#define GAS __attribute__((address_space(1)))
#define LAS __attribute__((address_space(3)))
typedef unsigned short bf16;
typedef unsigned v4u __attribute__((ext_vector_type(4)));
typedef unsigned v2u __attribute__((ext_vector_type(2)));
typedef float f32x4 __attribute__((ext_vector_type(4)));
typedef short bf16x8 __attribute__((ext_vector_type(8)));
typedef GAS unsigned gu32;
#define RLX_AGENT __ATOMIC_RELAXED, __HIP_MEMORY_SCOPE_AGENT
#define LDS_WAIT() asm volatile("s_waitcnt lgkmcnt(0)" ::: "memory")
#define VM_WAIT() asm volatile("s_waitcnt vmcnt(0)" ::: "memory")
__device__ __forceinline__ unsigned f2bf(float f) { unsigned u = __builtin_bit_cast(unsigned, f); return (u + 0x7fffu + ((u >> 16) & 1u)) >> 16; }
typedef float f32x2_t __attribute__((ext_vector_type(2)));
typedef __bf16 bf16x2_t __attribute__((ext_vector_type(2)));
__device__ __forceinline__ unsigned pk2(float lo, float hi) { const f32x2_t v = {lo, hi}; const bf16x2_t b = __builtin_convertvector(v, bf16x2_t); return __builtin_bit_cast(unsigned, b); }
__device__ __forceinline__ bf16 f2bf16(float x) { return (bf16)(pk2(x, x) & 0xffffu); }
__device__ __forceinline__ float bflo(unsigned w) { return __uint_as_float(w << 16); }
__device__ __forceinline__ float bfhi(unsigned w) { return __uint_as_float(w & 0xffff0000u); }
__device__ __forceinline__ float bf2f(bf16 v) { return __uint_as_float(((unsigned)v) << 16); }

#define XB_TMO      128
#define XB_XCNT(j)  (256  + 64 * (j))
#define XB_XSUB(j)  (1280 + 64 * (j))
#define XB_XGEN(j)  (2304 + 64 * (j))
#define XB_TOP      3328
#define XB_TOPGEN   3392
#define XCD_BAR_WORDS 3456
#define XB_SPIN_CAP (1u << 18)

__device__ __forceinline__ unsigned xb_ld(unsigned* p)              { return __hip_atomic_load(p, __ATOMIC_RELAXED, __HIP_MEMORY_SCOPE_AGENT); }
__device__ __forceinline__ unsigned xb_add(unsigned* p, unsigned v) { return __hip_atomic_fetch_add(p, v, __ATOMIC_RELAXED, __HIP_MEMORY_SCOPE_AGENT); }
__device__ __forceinline__ unsigned xb_xcc_id() { return (unsigned)__builtin_amdgcn_s_getreg((3 << 11) | 20) & 0xFu; }
#define XB_SPIN(cond, bar) do { unsigned _sp = 0; while (cond) { __builtin_amdgcn_s_sleep(1); \
    if ((++_sp & 255u) == 0u) { if (xb_ld(&(bar)[XB_TMO])) break; if (_sp > XB_SPIN_CAP) { atomicAdd(&(bar)[XB_TMO], 1u); break; } } } } while (0)

struct XcdBarrier {
    unsigned* bar; unsigned x;
    volatile LAS unsigned* st;
};
__device__ __forceinline__ XcdBarrier xcd_barrier_post(unsigned* bar, volatile LAS unsigned* st) {
    XcdBarrier b; b.bar = bar; b.x = xb_xcc_id(); b.st = st;
    if (threadIdx.x == 0) (void)xb_add(&bar[XB_XCNT(b.x)], 1u);
    return b;
}
__device__ __forceinline__ void xcd_barrier_complete(unsigned* bar, unsigned x, unsigned& nloc, unsigned& nx) {
    const unsigned G = gridDim.x * gridDim.y * gridDim.z;
    unsigned sum, cnt, mine, sp = 0u;
    for (;;) {
        sum = 0u; cnt = 0u; mine = 0u;
#pragma unroll
        for (unsigned j = 0; j < 16; ++j) { const unsigned c = xb_ld(&bar[XB_XCNT(j)]); sum += c; cnt += (c > 0u) ? 1u : 0u; mine = (j == x) ? c : mine; }
        if (sum == G) break;
        __builtin_amdgcn_s_sleep(1);
        if ((++sp & 255u) == 0u) { if (xb_ld(&bar[XB_TMO])) break; if (sp > XB_SPIN_CAP) { atomicAdd(&bar[XB_TMO], 1u); break; } }
    }
    nloc = mine > 0u ? mine : 1u; nx = cnt > 0u ? cnt : 1u;
}
__device__ __forceinline__ void xcd_barrier(const XcdBarrier& b) {
    asm volatile("s_waitcnt vmcnt(0)" ::: "memory");
    __syncthreads();
    if (threadIdx.x == 0) {
        unsigned* bar = b.bar;
        __builtin_amdgcn_s_waitcnt(0);
        unsigned nloc = b.st[0], nx = b.st[1];
        if (nloc == 0u) { xcd_barrier_complete(bar, b.x, nloc, nx); b.st[0] = nloc; b.st[1] = nx; }
        const unsigned old = xb_add(&bar[XB_XSUB(b.x)], 1u);
        const unsigned gen = old / nloc;
        if (old + 1u == (gen + 1u) * nloc) {
            __builtin_amdgcn_fence(__ATOMIC_RELEASE, "agent");
            asm volatile("s_waitcnt vmcnt(0)" ::: "memory");
            const unsigned og = xb_add(&bar[XB_TOP], 1u);
            const unsigned tg = og / nx;
            if (og + 1u == (tg + 1u) * nx) xb_add(&bar[XB_TOPGEN], 1u);
            else XB_SPIN(xb_ld(&bar[XB_TOPGEN]) == tg, bar);
            __builtin_amdgcn_fence(__ATOMIC_ACQUIRE, "agent");
            xb_add(&bar[XB_XGEN(b.x)], 1u);
            asm volatile("s_waitcnt vmcnt(0)" ::: "memory");
        } else {
            XB_SPIN(xb_ld(&bar[XB_XGEN(b.x)]) == gen, bar);
            __builtin_amdgcn_fence(__ATOMIC_ACQUIRE, "agent");
            asm volatile("s_waitcnt vmcnt(0)" ::: "memory");
        }
    }
    __syncthreads();
}


struct Frame {
    LAS unsigned char* lds;
    volatile LAS unsigned* MISC;
    gu32* ctl;
    int tid, lane, wave;
    int vcu, G;
};

__device__ __forceinline__ int opaque_lane() { int l; asm volatile("v_mbcnt_lo_u32_b32 %0, -1, 0\n\tv_mbcnt_hi_u32_b32 %0, -1, %0" : "=v"(l)); return l; }
#define opaque_tid() ((F.wave << 6) + opaque_lane())
__device__ __forceinline__ float wave_sum(float v) {
#pragma unroll
    for (int o = 1; o < 64; o <<= 1) v += __shfl_xor(v, o);
    return v;
}
__device__ __forceinline__ float sigmoidf_(float x) { return __builtin_amdgcn_rcpf(1.0f + __builtin_amdgcn_exp2f(-1.44269504089f * x)); }
__device__ __forceinline__ float siluf_(float x) { return x * sigmoidf_(x); }
__device__ __forceinline__ float gelu_tanh(float x) { const float z = 0.7978845608028654f * (x + 0.044715f * x * x * x); const float t = __builtin_amdgcn_exp2f(2.88539008178f * z); return x * (1.0f - __builtin_amdgcn_rcpf(t + 1.0f)); }

constexpr int TP = 65;
__device__ __forceinline__ void p0_item_load(f32x4 (&v)[16], const float* W, int N, int k0, int n0, int lane) {
    const int rq = lane >> 4, cq = 4 * (lane & 15);
#pragma unroll
    for (int i = 0; i < 16; ++i) v[i] = __builtin_nontemporal_load((const GAS f32x4*)(W + (size_t)(k0 + 4 * i + rq) * N + n0 + cq));
}
__device__ __forceinline__ void p0_item_store(const f32x4 (&v)[16], bf16* WT, int ldo, int out_row0, int k0, LAS float* scr, int lane) {
    const int rq = lane >> 4, cq = 4 * (lane & 15);
#pragma unroll
    for (int i = 0; i < 16; ++i) { LAS float* d = scr + (4 * i + rq) * TP + cq; d[0] = v[i].x; d[1] = v[i].y; d[2] = v[i].z; d[3] = v[i].w; }
    LDS_WAIT(); asm volatile("" ::: "memory");
    const int c = lane & 7;
#pragma unroll
    for (int j = 0; j < 8; ++j) { const int n = (lane >> 3) + 8 * j; const LAS float* sp = scr + (8 * c) * TP + n;
        v4u o; o.x = pk2(sp[0 * TP], sp[1 * TP]); o.y = pk2(sp[2 * TP], sp[3 * TP]); o.z = pk2(sp[4 * TP], sp[5 * TP]); o.w = pk2(sp[6 * TP], sp[7 * TP]);
        __builtin_nontemporal_store(o, (GAS v4u*)(WT + (size_t)(out_row0 + n) * ldo + k0 + 8 * c)); }
    LDS_WAIT(); asm volatile("" ::: "memory");
}
__device__ __forceinline__ void p0_item_store_blk(const f32x4 (&v)[16], bf16* WT, int K, int out_row0, int k0, LAS float* scr, int lane) {
    const int rq = lane >> 4, cq = 4 * (lane & 15);
#pragma unroll
    for (int i = 0; i < 16; ++i) { LAS float* d = scr + (4 * i + rq) * TP + cq; d[0] = v[i].x; d[1] = v[i].y; d[2] = v[i].z; d[3] = v[i].w; }
    LDS_WAIT(); asm volatile("" ::: "memory");
    const int bi = lane >> 2, ch = lane & 3;
#pragma unroll
    for (int s8 = 0; s8 < 8; ++s8) { const int rbl = s8 >> 1, kbl = s8 & 1; const int n = 32 * (rbl >> 1) + 8 * (bi >> 2) + 4 * (rbl & 1) + (bi & 3);
        const LAS float* sa = scr + (32 * kbl + 8 * ch + 4 * (ch & 1)) * TP + n; const LAS float* sb = scr + (32 * kbl + 8 * ch + 4 - 4 * (ch & 1)) * TP + n;
        const unsigned p0 = pk2(sa[0 * TP], sa[1 * TP]), p1 = pk2(sa[2 * TP], sa[3 * TP]), p2 = pk2(sb[0 * TP], sb[1 * TP]), p3 = pk2(sb[2 * TP], sb[3 * TP]);
        const bool od = ch & 1; v4u o; o.x = od ? p2 : p0; o.y = od ? p3 : p1; o.z = od ? p0 : p2; o.w = od ? p1 : p3;
        *(GAS v4u*)(WT + ((size_t)((out_row0 >> 4) + rbl) * (K >> 5) + (k0 >> 5) + kbl) * 512 + bi * 32 + 8 * ch) = o; }
    LDS_WAIT(); asm volatile("" ::: "memory");
}
__device__ __forceinline__ void p0_transpose_matrix(const float* W, int K, int N, bf16* WT, int mode, int row_base, LAS float* scr, int gw, int NGW, int lane) {
    const int nblk = N / 64, nitems = (K / 64) * nblk;
    int it = gw; if (it >= nitems) return;
    f32x4 v[16], w[16];
    p0_item_load(v, W, N, 64 * (it / nblk), 64 * (it % nblk), lane);
    for (;;) {
        const int nx = it + NGW; const bool more = nx < nitems;
        if (more) p0_item_load(w, W, N, 64 * (nx / nblk), 64 * (nx % nblk), lane);
        { const int n0 = 64 * (it % nblk); const int r0 = row_base + (mode == 0 ? n0 : (256 * (n0 >> 7) + (n0 & 127) + (mode == 2 ? 128 : 0)));
          p0_item_store(v, WT, K, r0, 64 * (it / nblk), scr, lane); }
        if (!more) break;
#pragma unroll
        for (int i = 0; i < 16; ++i) v[i] = w[i];
        it = nx;
    }
}

struct Args { const float* in[26]; float* out; unsigned char* ws; };
struct P0Item { const float* W; bf16* WT; int K, N, mode, row_base, local; };
constexpr int P0_FFN = (D / 64) * (FF / 64), P0_IN = (D / 64) * (INC / 64), P0_OUT = (D / 64) * (D / 64), P0_LRU = 16 * 16;
constexpr int P0_TOTAL = 6 * P0_FFN + P0_IN + P0_OUT + P0_LRU;
__device__ __forceinline__ P0Item p0_decode(int g, const Args& args, bf16* WGU1, bf16* WD1, bf16* WIN, bf16* WOUT, bf16* WGU2, bf16* WD2, bf16* WLRU) {
    P0Item t;
    if (g < P0_FFN)               { t.W = args.in[3];  t.WT = WGU1; t.K = D;  t.N = FF;  t.mode = 1; t.row_base = 0; t.local = g; return t; } g -= P0_FFN;
    if (g < P0_FFN)               { t.W = args.in[4];  t.WT = WGU1; t.K = D;  t.N = FF;  t.mode = 2; t.row_base = 0; t.local = g; return t; } g -= P0_FFN;
    if (g < P0_FFN)               { t.W = args.in[5];  t.WT = WD1;  t.K = FF; t.N = D;   t.mode = 0; t.row_base = 0; t.local = g; return t; } g -= P0_FFN;
    if (g < P0_IN)                { t.W = args.in[8];  t.WT = WIN;  t.K = D;  t.N = INC; t.mode = 0; t.row_base = 0; t.local = g; return t; } g -= P0_IN;
    if (g < P0_OUT)               { t.W = args.in[19]; t.WT = WOUT; t.K = D;  t.N = D;   t.mode = 0; t.row_base = 0; t.local = g; return t; } g -= P0_OUT;
    if (g < P0_FFN)               { t.W = args.in[22]; t.WT = WGU2; t.K = D;  t.N = FF;  t.mode = 1; t.row_base = 0; t.local = g; return t; } g -= P0_FFN;
    if (g < P0_FFN)               { t.W = args.in[23]; t.WT = WGU2; t.K = D;  t.N = FF;  t.mode = 2; t.row_base = 0; t.local = g; return t; } g -= P0_FFN;
    if (g < P0_FFN)               { t.W = args.in[24]; t.WT = WD2;  t.K = FF; t.N = D;   t.mode = 0; t.row_base = 0; t.local = g; return t; } g -= P0_FFN;
    { const int hd = g >> 5, which = (g >> 4) & 1; t.W = (which ? args.in[15] : args.in[13]) + (size_t)hd * 65536; t.WT = WLRU; t.K = 256; t.N = 256; t.mode = 1 + which; t.row_base = 512 * hd; t.local = g & 15; return t; }
}
__device__ __forceinline__ void p0_convert_all(const Args& args, bf16* WGU1, bf16* WD1, bf16* WIN, bf16* WOUT, bf16* WGU2, bf16* WD2, bf16* WLRU, LAS float* scr, int gw, int NGW, int lane) {
    int it = gw; if (it >= P0_TOTAL) return;
    f32x4 v[16], w[16];
    P0Item cur = p0_decode(it, args, WGU1, WD1, WIN, WOUT, WGU2, WD2, WLRU), nxt = cur;
    { const int nnb = cur.N / 64; p0_item_load(v, cur.W, cur.N, 64 * (cur.local / nnb), 64 * (cur.local % nnb), lane); }
    for (;;) {
        const int nx = it + NGW; const bool more = nx < P0_TOTAL;
        if (more) { nxt = p0_decode(nx, args, WGU1, WD1, WIN, WOUT, WGU2, WD2, WLRU); const int nnb = nxt.N / 64; p0_item_load(w, nxt.W, nxt.N, 64 * (nxt.local / nnb), 64 * (nxt.local % nnb), lane); }
        { const int nnb = cur.N / 64, n0 = 64 * (cur.local % nnb); const int r0 = cur.row_base + (cur.mode == 0 ? n0 : (256 * (n0 >> 7) + (n0 & 127) + (cur.mode == 2 ? 128 : 0)));
          if (cur.K == 256) p0_item_store(v, cur.WT, cur.K, r0, 64 * (cur.local / nnb), scr, lane);
          else p0_item_store_blk(v, cur.WT, cur.K, r0, 64 * (cur.local / nnb), scr, lane); }
        if (!more) break;
#pragma unroll
        for (int i = 0; i < 16; ++i) v[i] = w[i];
        cur = nxt; it = nx;
    }
}

__device__ __forceinline__ size_t blk_off(int m, int c, int Kd) { return (((size_t)(m >> 4) * (Kd >> 5) + (c >> 5)) << 9) + ((m & 15) << 5) + (c & 31); }
__device__ __forceinline__ void rms_row_to_bf16(const float* xrow, const float* gain, bf16* Ub, int m, int lane) {
    f32x4 v[16]; float s = 0.f;
#pragma unroll
    for (int j = 0; j < 8; ++j) { const GAS f32x4* xp = (const GAS f32x4*)(xrow + 8 * (lane + 64 * j)); v[2 * j] = xp[0]; v[2 * j + 1] = xp[1]; }
#pragma unroll
    for (int j = 0; j < 16; ++j) s += (v[j].x * v[j].x + v[j].y * v[j].y) + (v[j].z * v[j].z + v[j].w * v[j].w);
    const float rs = __builtin_amdgcn_rsqf(wave_sum(s) * (1.f / D) + EPS);
#pragma unroll
    for (int j = 0; j < 8; ++j) { const GAS f32x4* gp = (const GAS f32x4*)(gain + 8 * (lane + 64 * j)); const f32x4 g0 = gp[0], g1 = gp[1], a = v[2 * j], b = v[2 * j + 1];
        v4u w; w.x = pk2(a.x * rs * g0.x, a.y * rs * g0.y); w.y = pk2(a.z * rs * g0.z, a.w * rs * g0.w); w.z = pk2(b.x * rs * g1.x, b.y * rs * g1.y); w.w = pk2(b.z * rs * g1.z, b.w * rs * g1.w);
        *(GAS v4u*)(Ub + (size_t)m * D + 8 * (lane + 64 * j)) = w; }
}

__device__ __forceinline__ void unpack8(const v4u w, f32x4& a, f32x4& b) { a = (f32x4){bflo(w.x), bfhi(w.x), bflo(w.y), bfhi(w.y)}; b = (f32x4){bflo(w.z), bfhi(w.z), bflo(w.w), bfhi(w.w)}; }
template <int HMODE>
__device__ __forceinline__ void norm_rows(const bf16* f, const float* hin_real, const float* hin_meta, const bf16* hin_b, bf16* hout_b, float* hout_f, bf16* uout, const float* gpost, const float* gpre, float coef, int nrows, int gw, int NGW) {
    int lane = opaque_lane();
    for (int row = gw; row < nrows; row += NGW) {
        asm volatile("" : "+v"(lane));
        const size_t ro = (size_t)row * D + 8 * lane;
        f32x4 v[16]; float s = 0.f;
#pragma unroll
        for (int j = 0; j < 8; ++j) { const v4u w = *(const GAS v4u*)(f + ro + 512 * j); unpack8(w, v[2 * j], v[2 * j + 1]); }
#pragma unroll
        for (int j = 0; j < 16; ++j) s += (v[j].x * v[j].x + v[j].y * v[j].y) + (v[j].z * v[j].z + v[j].w * v[j].w);
        const float rs = coef * __builtin_amdgcn_rsqf(wave_sum(s) * (1.f / D) + EPS);
        float s2 = 0.f;
#pragma unroll
        for (int j = 0; j < 8; ++j) { const GAS f32x4* gp = (const GAS f32x4*)(gpost + 8 * lane + 512 * j); const f32x4 g0 = gp[0], g1 = gp[1]; f32x4 h0, h1;
            if (HMODE == 0) { const GAS f32x4* hp = (const GAS f32x4*)((row < MR ? hin_real + (size_t)row * D : hin_meta + (size_t)(row - MR) * D) + 8 * lane + 512 * j); h0 = hp[0]; h1 = hp[1]; }
            else { const v4u hw = *(const GAS v4u*)(hin_b + ro + 512 * j); unpack8(hw, h0, h1); }
            v[2 * j] = h0 + v[2 * j] * rs * g0; v[2 * j + 1] = h1 + v[2 * j + 1] * rs * g1; }
#pragma unroll
        for (int j = 0; j < 16; ++j) s2 += (v[j].x * v[j].x + v[j].y * v[j].y) + (v[j].z * v[j].z + v[j].w * v[j].w);
        if (HMODE == 2) {
#pragma unroll
            for (int j = 0; j < 8; ++j) { GAS f32x4* op = (GAS f32x4*)(hout_f + ro + 512 * j); op[0] = v[2 * j]; op[1] = v[2 * j + 1]; }
        } else if (row < MR) {
#pragma unroll
            for (int j = 0; j < 8; ++j) { const f32x4 a = v[2 * j], b = v[2 * j + 1]; v4u w; w.x = pk2(a.x, a.y); w.y = pk2(a.z, a.w); w.z = pk2(b.x, b.y); w.w = pk2(b.z, b.w); *(GAS v4u*)(hout_b + ro + 512 * j) = w; } }
        if (uout != nullptr) { const float rs2 = __builtin_amdgcn_rsqf(wave_sum(s2) * (1.f / D) + EPS);
#pragma unroll
            for (int j = 0; j < 8; ++j) { const GAS f32x4* gp = (const GAS f32x4*)(gpre + 8 * lane + 512 * j); const f32x4 g0 = gp[0], g1 = gp[1], a = v[2 * j], b = v[2 * j + 1];
                v4u w; w.x = pk2(a.x * rs2 * g0.x, a.y * rs2 * g0.y); w.y = pk2(a.z * rs2 * g0.z, a.w * rs2 * g0.w); w.z = pk2(b.x * rs2 * g1.x, b.y * rs2 * g1.y); w.w = pk2(b.z * rs2 * g1.z, b.w * rs2 * g1.w);
                *(GAS v4u*)(uout + ro + 512 * j) = w; } }
    }
}

#define MFMA_SETTLE1(a) asm volatile("s_nop 7\n\ts_nop 7" : "+v"(a))
#define MFMA_SETTLE2(a, b) asm volatile("s_nop 7\n\ts_nop 7" : "+v"(a), "+v"(b))
#define MFMA_SETTLE4(a, b, c, d) asm volatile("s_nop 7\n\ts_nop 7" : "+v"(a), "+v"(b), "+v"(c), "+v"(d))
#define MFMA_SETTLE8(a, b, c, d, e, f, g, h) asm volatile("s_nop 7\n\ts_nop 7" : "+v"(a), "+v"(b), "+v"(c), "+v"(d), "+v"(e), "+v"(f), "+v"(g), "+v"(h))
template <int NACC, int T, class Map, class Epi>
__device__ __forceinline__ void skinny_phase(Frame& F, const bf16* A, int lda, const bf16* Bt, int ldb, int K, int ntiles, const Map& mp, const Epi& epi) {
    LAS f32x4* red = (LAS f32x4*)(F.lds + RING_OFF);
    const int lane = opaque_lane();
    const int ks = K / 8, k_lo = F.wave * ks, r = lane & 15, q = lane >> 4;
    const int rot = 32 * (int)((blockIdx.x * 7u + F.wave * 3u) % (unsigned)(ks / 32));
    for (int t0 = blockIdx.x; t0 < ntiles; t0 += F.G * T) {
        int brow[T][NACC], acol = 0; bool valid[T];
#pragma unroll
        for (int j = 0; j < T; ++j) { const int tj = t0 + j * F.G; valid[j] = tj < ntiles; mp(valid[j] ? tj : t0, brow[j], acol); }
        f32x4 acc[T][NACC];
#pragma unroll
        for (int j = 0; j < T; ++j)
#pragma unroll
            for (int i = 0; i < NACC; ++i) acc[j][i] = (f32x4){0.f, 0.f, 0.f, 0.f};
        const bf16* ap = lda == 0 ? A + (((size_t)(MR >> 4) * (K >> 5) + (k_lo >> 5)) << 9) + r * 32 + 8 * q : A + (size_t)(MR + r) * lda + k_lo + 8 * q;
        const int astep = lda == 0 ? 16 : 1;
        const bf16* bp[T][NACC];
#pragma unroll
        for (int j = 0; j < T; ++j)
#pragma unroll
            for (int i = 0; i < NACC; ++i) bp[j][i] = Bt + ((size_t)brow[j][i] * (K >> 5) + (k_lo >> 5)) * 512 + r * 32 + 8 * q;
#pragma unroll 4
        for (int k0 = 0; k0 < ks; k0 += 32) {
            int k = k0 + rot; k = k >= ks ? k - ks : k;
            const bf16x8 a = *(const GAS bf16x8*)(ap + k * astep);
#pragma unroll
            for (int j = 0; j < T; ++j)
#pragma unroll
                for (int i = 0; i < NACC; ++i) { const bf16x8 b = *(const GAS bf16x8*)(bp[j][i] + k * 16); acc[j][i] = __builtin_amdgcn_mfma_f32_16x16x32_bf16(b, a, acc[j][i], 0, 0, 0); }
        }
#pragma unroll
        for (int j = 0; j < T; ++j)
#pragma unroll
            for (int i = 0; i < NACC; ++i) MFMA_SETTLE1(acc[j][i]);
#pragma unroll
        for (int j = 0; j < T; ++j)
#pragma unroll
            for (int i = 0; i < NACC; ++i) red[((F.wave * T + j) * NACC + i) * 64 + lane] = acc[j][i];
        LDS_WAIT(); __syncthreads();
#pragma unroll
        for (int j = 0; j < T; ++j) if (F.wave == j && valid[j]) {
            f32x4 sred[NACC];
#pragma unroll
            for (int i = 0; i < NACC; ++i) { sred[i] = red[(j * NACC + i) * 64 + lane];
#pragma unroll
                for (int w = 1; w < 8; ++w) sred[i] += red[((w * T + j) * NACC + i) * 64 + lane]; }
            epi(t0 + j * F.G, r, q, sred);
        }
        __syncthreads();
    }
}
struct MapPlain { __device__ __forceinline__ void operator()(int tile, int (&brow)[1], int& acol) const { brow[0] = tile; acol = 0; } };
struct MapGateUp { __device__ __forceinline__ void operator()(int tile, int (&brow)[2], int& acol) const { const int j0 = 32 * (tile >> 1); brow[0] = ((256 * (j0 >> 7) + (j0 & 127)) >> 4) + (tile & 1); brow[1] = brow[0] + 8; acol = 0; } };
struct MapLru { __device__ __forceinline__ void operator()(int tile, int (&brow)[2], int& acol) const { const int c0 = 16 * tile, head = c0 >> 8, w = c0 & 255; brow[0] = 256 * (2 * head + (w >> 7)) + (w & 127); brow[1] = brow[0] + 128; acol = head * 256; } };
struct SkEpiSwiGLU { bf16* O; __device__ __forceinline__ void operator()(int tile, int r, int q, const f32x4 (&s)[2]) const {
    v2u w; w.x = pk2(siluf_(s[0][0]) * s[1][0], siluf_(s[0][1]) * s[1][1]); w.y = pk2(siluf_(s[0][2]) * s[1][2], siluf_(s[0][3]) * s[1][3]);
    *(GAS v2u*)(O + ((((size_t)(MR >> 4)) * (FF >> 5) + (tile >> 1)) << 9) + r * 32 + 8 * q + 4 * (tile & 1)) = w; } };
struct SkEpiF32 { float* C; int ldc; __device__ __forceinline__ void operator()(int tile, int r, int q, const f32x4 (&s)[1]) const { *(GAS f32x4*)(C + (size_t)(MR + r) * ldc + 16 * tile + 4 * q) = s[0]; } };
struct SkEpiBf16 { bf16* O; int ldc; __device__ __forceinline__ void operator()(int tile, int r, int q, const f32x4 (&s)[1]) const {
    v2u w; w.x = pk2(s[0][0], s[0][1]); w.y = pk2(s[0][2], s[0][3]); *(GAS v2u*)(O + (size_t)(MR + r) * ldc + 32 * (tile >> 1) + 8 * q + 4 * (tile & 1)) = w; } };
struct SkEpiLru { float* Aout; float* Dout; const bf16* XC; const float* b_a; const float* b_x; const float* lam;
    __device__ __forceinline__ void operator()(int tile, int r, int q, const f32x4 (&s)[2]) const {
        const int ch = 16 * tile + 4 * q; const size_t ro = (size_t)(MR + r) * LW + ch; const v2u xw = *(const GAS v2u*)(XC + ro);
        const float xv[4] = {bflo(xw.x), bfhi(xw.x), bflo(xw.y), bfhi(xw.y)}; f32x4 av, dv;
#pragma unroll
        for (int e = 0; e < 4; ++e) { float a, d; pg8::lru_gate_math(s[0][e], s[1][e], b_a[ch + e], b_x[ch + e], pg8::softplus_neg(lam[ch + e]), xv[e], a, d); av[e] = a; dv[e] = d; }
        *(GAS f32x4*)(Aout + ro) = av; *(GAS f32x4*)(Dout + ro) = dv; } };

constexpr int HG_PQ = 136, HG_PT = 72;
constexpr int HG_Q = 0, HG_Q0 = HG_Q + 64 * HG_PQ * 2, HG_K = HG_Q0 + 64 * HG_PQ * 2, HG_KT = HG_K + 64 * HG_PQ * 2, HG_VT = HG_KT + 128 * HG_PT * 2,
              HG_P = HG_VT + 128 * HG_PT * 2, HG_ST = HG_P + 64 * HG_PT * 2, HG_PART = HG_ST + 128 * HG_PQ * 2, HG_EL = HG_PART + 8 * 128 * 4, HG_RS = HG_EL + 128 * 4, HG_END = HG_RS + 8 * 64 * 4;
static_assert(HG_END <= LDSCTL_OFF, "HGRN LDS map");
#define WG_SYNC() do { asm volatile("s_waitcnt vmcnt(0) lgkmcnt(0)" ::: "memory"); __builtin_amdgcn_s_barrier(); asm volatile("" ::: "memory"); } while (0)
#define LSYNC() do { asm volatile("s_waitcnt lgkmcnt(0)" ::: "memory"); __builtin_amdgcn_s_barrier(); asm volatile("" ::: "memory"); } while (0)
__device__ __forceinline__ void norm_meta_row(Frame& F, int m, const bf16* f, const float* meta, bf16* uout, const float* gpost, const float* gpre, float coef) {
    const int tid = opaque_tid(); LAS float* red = (LAS float*)F.lds;
    const size_t ro = (size_t)(MR + m) * D + 8 * tid;
    const v4u fw = *(const GAS v4u*)(f + ro);
    const f32x4 h0 = *(const GAS f32x4*)(meta + (size_t)m * D + 8 * tid), h1 = *(const GAS f32x4*)(meta + (size_t)m * D + 8 * tid + 4);
    const f32x4 g0 = *(const GAS f32x4*)(gpost + 8 * tid), g1 = *(const GAS f32x4*)(gpost + 8 * tid + 4), p0 = *(const GAS f32x4*)(gpre + 8 * tid), p1 = *(const GAS f32x4*)(gpre + 8 * tid + 4);
    float fv[8] = {bflo(fw.x), bfhi(fw.x), bflo(fw.y), bfhi(fw.y), bflo(fw.z), bfhi(fw.z), bflo(fw.w), bfhi(fw.w)};
    float s1 = 0.f;
#pragma unroll
    for (int e = 0; e < 8; ++e) s1 += fv[e] * fv[e];
    s1 = wave_sum(s1); if ((tid & 63) == 0) red[F.wave] = s1;
    WG_SYNC();
    float t1 = 0.f;
#pragma unroll
    for (int w = 0; w < 8; ++w) t1 += red[w];
    const float rs = coef * __builtin_amdgcn_rsqf(t1 * (1.f / D) + EPS);
    const float hv[8] = {h0.x + fv[0] * rs * g0.x, h0.y + fv[1] * rs * g0.y, h0.z + fv[2] * rs * g0.z, h0.w + fv[3] * rs * g0.w, h1.x + fv[4] * rs * g1.x, h1.y + fv[5] * rs * g1.y, h1.z + fv[6] * rs * g1.z, h1.w + fv[7] * rs * g1.w};
    float s2 = 0.f;
#pragma unroll
    for (int e = 0; e < 8; ++e) s2 += hv[e] * hv[e];
    s2 = wave_sum(s2); if ((tid & 63) == 0) red[8 + F.wave] = s2;
    WG_SYNC();
    float t2 = 0.f;
#pragma unroll
    for (int w = 0; w < 8; ++w) t2 += red[8 + w];
    const float rs2 = __builtin_amdgcn_rsqf(t2 * (1.f / D) + EPS);
    v4u o; o.x = pk2(hv[0] * rs2 * p0.x, hv[1] * rs2 * p0.y); o.y = pk2(hv[2] * rs2 * p0.z, hv[3] * rs2 * p0.w); o.z = pk2(hv[4] * rs2 * p1.x, hv[5] * rs2 * p1.y); o.w = pk2(hv[6] * rs2 * p1.z, hv[7] * rs2 * p1.w);
    *(GAS v4u*)(uout + ro) = o;
    WG_SYNC();
}

typedef LAS unsigned char* ldsp;
__device__ __forceinline__ bf16x8 lds_frag(ldsp base, int row, int pitch, int col) { return *(const LAS bf16x8*)(base + (row * pitch + col) * 2); }

template <bool PASS_C>
__device__ __forceinline__ void hgrn_unit(Frame& F, int unit, const bf16* proj, const float* lbl, const float* gn, float* HG, float* HD, bf16* Y) {
    const int tid = opaque_tid(), lane = tid & 63, w = F.wave, r = lane & 15, q = lane >> 4;
    const int b = unit >> 8, h = (unit >> 4) & 15, c = unit & 15;
    ldsp L = F.lds;
    const int ch0 = 2 * lane;
    const float lb0 = sigmoidf_(lbl[h * 128 + ch0] - lbl[HW + h * 128 + ch0]), lb1 = sigmoidf_(lbl[h * 128 + ch0 + 1] - lbl[HW + h * 128 + ch0 + 1]);
    f32x4 st[8];
    float* Gu = HG + (size_t)unit * 16384;
    if (PASS_C) {
#pragma unroll
        for (int tk = 0; tk < 8; ++tk)
#pragma unroll
            for (int e = 0; e < 4; ++e) st[tk][e] = Gu[(16 * w + 4 * q + e) * 128 + 16 * tk + r];
#pragma unroll
        for (int tk = 0; tk < 8; ++tk)
#pragma unroll
            for (int e = 0; e < 4; ++e) *(LAS bf16*)(L + HG_ST + ((16 * w + 4 * q + e) * HG_PQ + 16 * tk + r) * 2) = f2bf16(st[tk][e]);
    } else {
#pragma unroll
        for (int tk = 0; tk < 8; ++tk) st[tk] = (f32x4){0.f, 0.f, 0.f, 0.f};
    }
    float tl0 = 0.f, tl1 = 0.f;
    const int nch = (c == 0) ? 5 : 4;
    unsigned Lf[8], Lv[8], Lq[8];
#define HG_LOAD(cj) do { const bool mc_ = (c == 0 && (cj) == 0); const size_t r0_ = (size_t)b * SEQ + c * 256 + ((c == 0) ? (cj) - 1 : (cj)) * 64; \
        _Pragma("unroll") for (int i = 0; i < 8; ++i) { const int t = 8 * w + i; const size_t row = mc_ ? (size_t)(MR + (t < 48 ? 0 : t - 48)) : r0_ + t; const bf16* pr = proj + row * INC + h * 128 + ch0; \
            Lf[i] = *(const GAS unsigned*)(pr + HW); Lv[i] = *(const GAS unsigned*)(pr + 2 * HW); if (PASS_C) Lq[i] = *(const GAS unsigned*)pr; } } while (0)
    HG_LOAD(0);
    for (int ci = 0; ci < nch; ++ci) {
        const bool metac = (c == 0 && ci == 0);
        const int s = (c == 0) ? ci - 1 : ci;
        const size_t row0 = (size_t)b * SEQ + c * 256 + s * 64;
        float lc0[8], lc1[8], kk0[8], kk1[8], qa0[8], qa1[8]; unsigned vv[8];
        float run0 = 0.f, run1 = 0.f;
#pragma unroll
        for (int i = 0; i < 8; ++i) { const int t = 8 * w + i; const bool nul = metac && t < 48;
            const unsigned fw = Lf[i]; const unsigned vw = Lv[i];
            const float sg0 = sigmoidf_(bflo(fw)), sg1 = sigmoidf_(bfhi(fw));
            const float l0 = nul ? 0.f : __logf(lb0 + (1.f - lb0) * sg0), l1 = nul ? 0.f : __logf(lb1 + (1.f - lb1) * sg1);
            run0 += l0; run1 += l1; lc0[i] = run0; lc1[i] = run1;
            kk0[i] = nul ? 0.f : (1.f - lb0) * (1.f - sg0); kk1[i] = nul ? 0.f : (1.f - lb1) * (1.f - sg1); vv[i] = nul ? 0u : vw;
            if (PASS_C) { const unsigned qw = Lq[i]; qa0[i] = nul ? 0.f : siluf_(bflo(qw)); qa1[i] = nul ? 0.f : siluf_(bfhi(qw)); } }
        if (ci + 1 < nch) HG_LOAD(ci + 1);
        *(LAS float*)(L + HG_PART + (w * 128 + ch0) * 4) = run0; *(LAS float*)(L + HG_PART + (w * 128 + ch0 + 1) * 4) = run1;
        LSYNC();
        float pre0 = 0.f, pre1 = 0.f, mid0 = 0.f, mid1 = 0.f, last0 = 0.f, last1 = 0.f;
#pragma unroll
        for (int ww = 0; ww < 8; ++ww) { const float p0 = *(LAS float*)(L + HG_PART + (ww * 128 + ch0) * 4), p1 = *(LAS float*)(L + HG_PART + (ww * 128 + ch0 + 1) * 4);
            if (ww < w) { pre0 += p0; pre1 += p1; } if (ww < 4) { mid0 += p0; mid1 += p1; } last0 += p0; last1 += p1; }
        tl0 += last0; tl1 += last1;
        if (w == 0) { *(LAS float*)(L + HG_EL + ch0 * 4) = __expf(last0); *(LAS float*)(L + HG_EL + (ch0 + 1) * 4) = __expf(last1); }
        const float em0 = __expf(mid0), em1 = __expf(mid1), elm0 = __expf(last0 - mid0), elm1 = __expf(last1 - mid1);
        unsigned ktw0[4], ktw1[4], vtw0[4], vtw1[4];
#pragma unroll
        for (int i = 0; i < 8; i += 2) {
            float kl0[2], kl1[2];
#pragma unroll
            for (int j = 0; j < 2; ++j) { const int t = 8 * w + i + j; const float c0 = pre0 + lc0[i + j] - mid0, c1 = pre1 + lc1[i + j] - mid1;
                const float kt0 = kk0[i + j] * __expf(-c0), kt1 = kk1[i + j] * __expf(-c1);
                kl0[j] = kt0 * elm0; kl1[j] = kt1 * elm1;
                if (PASS_C) { const float qt0 = qa0[i + j] * __expf(c0), qt1 = qa1[i + j] * __expf(c1);
                    *(LAS unsigned*)(L + HG_Q + (t * HG_PQ + ch0) * 2) = pk2(qt0, qt1); *(LAS unsigned*)(L + HG_Q0 + (t * HG_PQ + ch0) * 2) = pk2(qt0 * em0, qt1 * em1);
                    *(LAS unsigned*)(L + HG_K + (t * HG_PQ + ch0) * 2) = pk2(kt0, kt1); } }
            ktw0[i >> 1] = pk2(kl0[0], kl0[1]); ktw1[i >> 1] = pk2(kl1[0], kl1[1]);
            vtw0[i >> 1] = (vv[i] & 0xffffu) | (vv[i + 1] << 16); vtw1[i >> 1] = (vv[i] >> 16) | (vv[i + 1] & 0xffff0000u); }
        *(LAS v4u*)(L + HG_KT + (ch0 * HG_PT + 8 * w) * 2) = (v4u){ktw0[0], ktw0[1], ktw0[2], ktw0[3]}; *(LAS v4u*)(L + HG_KT + ((ch0 + 1) * HG_PT + 8 * w) * 2) = (v4u){ktw1[0], ktw1[1], ktw1[2], ktw1[3]};
        *(LAS v4u*)(L + HG_VT + (ch0 * HG_PT + 8 * w) * 2) = (v4u){vtw0[0], vtw0[1], vtw0[2], vtw0[3]}; *(LAS v4u*)(L + HG_VT + ((ch0 + 1) * HG_PT + 8 * w) * 2) = (v4u){vtw1[0], vtw1[1], vtw1[2], vtw1[3]};
        LSYNC();
        const bool do_out = PASS_C && !metac;
        if (do_out) {
            v2u gwp[4];
#pragma unroll
            for (int ti2 = 0; ti2 < 4; ++ti2) gwp[ti2] = *(const GAS v2u*)(proj + (row0 + 16 * ti2 + r) * INC + 3 * HW + h * 128 + 16 * w + 4 * q);
            const int ti = w >> 1;
#pragma unroll
            for (int jj = 0; jj < 2; ++jj) { const int tj = 2 * (w & 1) + jj; f32x4 a4 = (f32x4){0.f, 0.f, 0.f, 0.f};
                if (tj <= ti) {
#pragma unroll
                    for (int ks = 0; ks < 4; ++ks) a4 = __builtin_amdgcn_mfma_f32_16x16x32_bf16(lds_frag(L + HG_K, 16 * tj + r, HG_PQ, 32 * ks + 8 * q), lds_frag(L + HG_Q, 16 * ti + r, HG_PQ, 32 * ks + 8 * q), a4, 0, 0, 0);
                    MFMA_SETTLE1(a4);
                    if (tj == ti) {
#pragma unroll
                        for (int e = 0; e < 4; ++e) a4[e] = (4 * q + e <= r) ? a4[e] : 0.f; } }
                *(LAS v2u*)(L + HG_P + ((16 * ti + r) * HG_PT + 16 * tj + 4 * q) * 2) = (v2u){pk2(a4[0], a4[1]), pk2(a4[2], a4[3])}; }
            LSYNC();
            f32x4 o[4];
#pragma unroll
            for (int ti2 = 0; ti2 < 4; ++ti2) o[ti2] = (f32x4){0.f, 0.f, 0.f, 0.f};
#pragma unroll
            for (int ks = 0; ks < 4; ++ks) { const bf16x8 a = lds_frag(L + HG_ST, 16 * w + r, HG_PQ, 32 * ks + 8 * q);
#pragma unroll
                for (int ti2 = 0; ti2 < 4; ++ti2) o[ti2] = __builtin_amdgcn_mfma_f32_16x16x32_bf16(a, lds_frag(L + HG_Q0, 16 * ti2 + r, HG_PQ, 32 * ks + 8 * q), o[ti2], 0, 0, 0); }
#pragma unroll
            for (int js = 0; js < 2; ++js) { const bf16x8 a = lds_frag(L + HG_VT, 16 * w + r, HG_PT, 32 * js + 8 * q);
#pragma unroll
                for (int ti2 = 0; ti2 < 4; ++ti2) o[ti2] = __builtin_amdgcn_mfma_f32_16x16x32_bf16(a, lds_frag(L + HG_P, 16 * ti2 + r, HG_PT, 32 * js + 8 * q), o[ti2], 0, 0, 0); }
            MFMA_SETTLE4(o[0], o[1], o[2], o[3]);
#pragma unroll
            for (int ti2 = 0; ti2 < 4; ++ti2) { float ss = (o[ti2][0] * o[ti2][0] + o[ti2][1] * o[ti2][1]) + (o[ti2][2] * o[ti2][2] + o[ti2][3] * o[ti2][3]);
                ss += __shfl_xor(ss, 16); ss += __shfl_xor(ss, 32);
                if (q == 0) *(LAS float*)(L + HG_RS + (w * 64 + 16 * ti2 + r) * 4) = ss; }
            LSYNC();
            const f32x4 g4 = *(const GAS f32x4*)(gn + h * 128 + 16 * w + 4 * q);
#pragma unroll
            for (int ti2 = 0; ti2 < 4; ++ti2) { float tot = 0.f;
#pragma unroll
                for (int ww = 0; ww < 8; ++ww) tot += *(LAS float*)(L + HG_RS + (ww * 64 + 16 * ti2 + r) * 4);
                const float rs = __builtin_amdgcn_rsqf(tot * (1.f / 128.f) + EPS);
                const size_t row = row0 + 16 * ti2 + r; const v2u gw = gwp[ti2];
                v2u yw; yw.x = pk2(o[ti2][0] * rs * g4[0] * siluf_(bflo(gw.x)), o[ti2][1] * rs * g4[1] * siluf_(bfhi(gw.x))); yw.y = pk2(o[ti2][2] * rs * g4[2] * siluf_(bflo(gw.y)), o[ti2][3] * rs * g4[3] * siluf_(bfhi(gw.y)));
                *(GAS v2u*)(Y + row * D + h * 128 + 16 * w + 4 * q) = yw; }
        }
        if (!(PASS_C && ci == nch - 1)) {
#pragma unroll
            for (int tk = 0; tk < 8; ++tk) { const float el = *(LAS float*)(L + HG_EL + (16 * tk + r) * 4); st[tk] = st[tk] * el; }
#pragma unroll
            for (int js = 0; js < 2; ++js) { const bf16x8 a = lds_frag(L + HG_VT, 16 * w + r, HG_PT, 32 * js + 8 * q);
#pragma unroll
                for (int tk = 0; tk < 8; ++tk) st[tk] = __builtin_amdgcn_mfma_f32_16x16x32_bf16(a, lds_frag(L + HG_KT, 16 * tk + r, HG_PT, 32 * js + 8 * q), st[tk], 0, 0, 0); }
            MFMA_SETTLE8(st[0], st[1], st[2], st[3], st[4], st[5], st[6], st[7]);
            if (PASS_C) {
#pragma unroll
                for (int tk = 0; tk < 8; ++tk)
#pragma unroll
                    for (int e = 0; e < 4; ++e) *(LAS bf16*)(L + HG_ST + ((16 * w + 4 * q + e) * HG_PQ + 16 * tk + r) * 2) = f2bf16(st[tk][e]);
            }
        }
    }
    if (!PASS_C) {
#pragma unroll
        for (int tk = 0; tk < 8; ++tk)
#pragma unroll
            for (int e = 0; e < 4; ++e) Gu[(16 * w + 4 * q + e) * 128 + 16 * tk + r] = st[tk][e];
        if (w == 0) { HD[unit * 128 + ch0] = __expf(tl0); HD[unit * 128 + ch0 + 1] = __expf(tl1); }
    }
    WG_SYNC();
}
__device__ __forceinline__ void hgrn_carry(Frame& F, const float* HG, float* HG2, const float* HD) {
    const int tid = opaque_tid();
    for (int idx = blockIdx.x * 512 + tid; idx < 32 * 16384; idx += F.G * 512) {
        const int bh = idx >> 14, e = idx & 16383, k = e & 127; float S = 0.f;
        float g[16], dk[16];
#pragma unroll
        for (int c = 0; c < 16; ++c) { g[c] = HG[(size_t)(bh * 16 + c) * 16384 + e]; dk[c] = HD[(bh * 16 + c) * 128 + k]; }
#pragma unroll
        for (int c = 0; c < 16; ++c) { HG2[(size_t)(bh * 16 + c) * 16384 + e] = S; S = dk[c] * S + g[c]; }
    }
}

constexpr int LR_P = 264;
constexpr int LR_XC = 0, LR_OH = LR_XC + 64 * LR_P * 2, LR_OA = LR_OH + 64 * LR_P * 2, LR_END = LR_OA + 64 * LR_P * 2;
static_assert(LR_END <= LDSCTL_OFF, "LRU LDS map");
__device__ __forceinline__ void lru_unit(Frame& F, int unit, const bf16* proj, const bf16* WL, const float* cw, const float* cb, const float* b_a, const float* b_x, const float* lam,
                                         bf16* HLOC, bf16* ACUM, float* LC) {
    const int tid = opaque_tid(), lane = tid & 63, w = F.wave, r = lane & 15, q = lane >> 4;
    const int b = unit >> 7, hd = (unit >> 4) & 7, c = unit & 15;
    ldsp L = F.lds;
    const int c8 = tid & 31, tg = tid >> 5;
    float ba[2], bx[2], sp[2], hc[2] = {0.f, 0.f}, pc[2] = {1.f, 1.f};
#pragma unroll
    for (int ct = 0; ct < 2; ++ct) { const int ch = hd * 256 + 32 * w + 16 * ct + r; ba[ct] = b_a[ch]; bx[ct] = b_x[ch]; sp[ct] = pg8::softplus_neg(lam[ch]); }
    const int nsc = (c == 0) ? 5 : 4;
    const int chg = hd * 256 + 8 * c8;
    float wv[4][8], bv[8];
#pragma unroll
    for (int e = 0; e < 8; ++e) { bv[e] = cb[chg + e];
#pragma unroll
        for (int k = 0; k < 4; ++k) wv[k][e] = cw[k * LW + chg + e]; }
    v4u xw[7];
#define LR_LOAD(sj) do { const bool mc_ = (c == 0 && (sj) == 0); const int p0_ = (mc_ ? 0 : NMETA + c * 256 + ((c == 0) ? (sj) - 1 : (sj)) * 64) + 4 * tg - 3; \
        if (tg < (mc_ ? 4 : 16)) { _Pragma("unroll") for (int d = 0; d < 7; ++d) { const int p = p0_ + d; \
            if (p >= 0) { const size_t row = p < NMETA ? (size_t)(MR + p) : (size_t)b * SEQ + p - NMETA; xw[d] = *(const GAS v4u*)(proj + row * INC + 4 * HW + chg); } \
            else xw[d] = (v4u){0u, 0u, 0u, 0u}; } } } while (0)
    LR_LOAD(0);
    for (int si = 0; si < nsc; ++si) {
        const bool metac = (c == 0 && si == 0);
        const int ntt = metac ? 1 : 4;
        const int pos0 = metac ? 0 : NMETA + c * 256 + ((c == 0) ? si - 1 : si) * 64;
        if (tg < 4 * ntt) {
            float xr[7][8];
#pragma unroll
            for (int d = 0; d < 7; ++d) { xr[d][0] = bflo(xw[d].x); xr[d][1] = bfhi(xw[d].x); xr[d][2] = bflo(xw[d].y); xr[d][3] = bfhi(xw[d].y); xr[d][4] = bflo(xw[d].z); xr[d][5] = bfhi(xw[d].z); xr[d][6] = bflo(xw[d].w); xr[d][7] = bfhi(xw[d].w); }
#pragma unroll
            for (int i = 0; i < 4; ++i) { float xo[8];
#pragma unroll
                for (int e = 0; e < 8; ++e) xo[e] = bv[e] + xr[i][e] * wv[0][e] + xr[i + 1][e] * wv[1][e] + xr[i + 2][e] * wv[2][e] + xr[i + 3][e] * wv[3][e];
                *(LAS v4u*)(L + LR_XC + ((4 * tg + i) * LR_P + 8 * c8) * 2) = (v4u){pk2(xo[0], xo[1]), pk2(xo[2], xo[3]), pk2(xo[4], xo[5]), pk2(xo[6], xo[7])}; }
        }
        LSYNC();
        f32x4 ar[2][4], ai[2][4];
#pragma unroll
        for (int ct = 0; ct < 2; ++ct)
#pragma unroll
            for (int tt = 0; tt < 4; ++tt) { ar[ct][tt] = (f32x4){0.f, 0.f, 0.f, 0.f}; ai[ct][tt] = (f32x4){0.f, 0.f, 0.f, 0.f}; }
        const bf16* wrow = WL + (size_t)(512 * hd + 256 * (w >> 2) + 32 * (w & 3) + r) * 256 + 8 * q;
#pragma unroll 4
        for (int ks = 0; ks < 8; ++ks) {
            bf16x8 br[2], bi[2];
#pragma unroll
            for (int ct = 0; ct < 2; ++ct) { br[ct] = *(const GAS bf16x8*)(wrow + (size_t)(16 * ct) * 256 + 32 * ks); bi[ct] = *(const GAS bf16x8*)(wrow + (size_t)(16 * ct + 128) * 256 + 32 * ks); }
#pragma unroll
            for (int tt = 0; tt < 4; ++tt) { if (tt < ntt) { const bf16x8 a = lds_frag(L + LR_XC, 16 * tt + r, LR_P, 32 * ks + 8 * q);
#pragma unroll
                for (int ct = 0; ct < 2; ++ct) { ar[ct][tt] = __builtin_amdgcn_mfma_f32_16x16x32_bf16(a, br[ct], ar[ct][tt], 0, 0, 0); ai[ct][tt] = __builtin_amdgcn_mfma_f32_16x16x32_bf16(a, bi[ct], ai[ct][tt], 0, 0, 0); } } }
        }
        MFMA_SETTLE8(ar[0][0], ar[0][1], ar[0][2], ar[0][3], ar[1][0], ar[1][1], ar[1][2], ar[1][3]); MFMA_SETTLE8(ai[0][0], ai[0][1], ai[0][2], ai[0][3], ai[1][0], ai[1][1], ai[1][2], ai[1][3]);
        if (si + 1 < nsc) LR_LOAD(si + 1);
#pragma unroll
        for (int ct = 0; ct < 2; ++ct) {
#pragma unroll
            for (int tt = 0; tt < 4; ++tt) { if (tt < ntt) {
                float al[4], hl[4]; float P = 1.f, H = 0.f;
#pragma unroll
                for (int e = 0; e < 4; ++e) { const int t = 16 * tt + 4 * q + e; const float xcv = bf2f(*(LAS bf16*)(L + LR_XC + (t * LR_P + 32 * w + 16 * ct + r) * 2));
                    float a, d; pg8::lru_gate_math(ar[ct][tt][e], ai[ct][tt][e], ba[ct], bx[ct], sp[ct], xcv, a, d); H = a * H + d; P *= a; al[e] = P; hl[e] = H; }
                float Pi = P, Hi = H;
                { const float Pp = __shfl(Pi, lane - 16), Hp = __shfl(Hi, lane - 16); if (q >= 1) { Hi = Pi * Hp + Hi; Pi = Pp * Pi; } }
                { const float Pp = __shfl(Pi, lane - 32), Hp = __shfl(Hi, lane - 32); if (q >= 2) { Hi = Pi * Hp + Hi; Pi = Pp * Pi; } }
                float Pe = __shfl(Pi, lane - 16), He = __shfl(Hi, lane - 16); if (q == 0) { Pe = 1.f; He = 0.f; }
                const float Pt = __shfl(Pi, 48 + r), Ht = __shfl(Hi, 48 + r);
                const float hin = Pe * hc[ct] + He, pin = pc[ct] * Pe;
                if (!metac) {
#pragma unroll
                    for (int e = 0; e < 4; ++e) { const int t = 16 * tt + 4 * q + e; const int o = (t * LR_P + 32 * w + 16 * ct + r) * 2;
                        *(LAS bf16*)(L + LR_OH + o) = f2bf16(al[e] * hin + hl[e]); *(LAS bf16*)(L + LR_OA + o) = f2bf16(pin * al[e]); } }
                hc[ct] = Pt * hc[ct] + Ht; pc[ct] = pc[ct] * Pt; } }
        }
        LSYNC();
        if (!metac) {
            const size_t rowb = (size_t)b * SEQ + pos0 - NMETA;
#pragma unroll
            for (int i = 0; i < 4; ++i) { const int t = 4 * tg + i; const size_t go = (rowb + t) * LW + hd * 256 + 8 * c8;
                *(GAS v4u*)(HLOC + go) = *(LAS v4u*)(L + LR_OH + (t * LR_P + 8 * c8) * 2); *(GAS v4u*)(ACUM + go) = *(LAS v4u*)(L + LR_OA + (t * LR_P + 8 * c8) * 2); }
        }
    }
    if (q == 0) {
#pragma unroll
        for (int ct = 0; ct < 2; ++ct) { const int ch = hd * 256 + 32 * w + 16 * ct + r; LC[(size_t)((b * 16 + c) * 2 + 0) * LW + ch] = pc[ct]; LC[(size_t)((b * 16 + c) * 2 + 1) * LW + ch] = hc[ct]; }
    }
    WG_SYNC();
}
__device__ __forceinline__ void lru_finish(Frame& F, const bf16* HLOC, const bf16* ACUM, const float* LC, const bf16* proj, const float* ln, bf16* Y) {
    const int tid = opaque_tid(), lane = tid & 63, w = F.wave;
    LAS float* HIN = (LAS float*)(F.lds);
    for (int item = blockIdx.x; item < 256; item += F.G) {
        const int b = item >> 7, c = (item >> 3) & 15, sub = item & 7;
        { f32x4 hin = (f32x4){0.f, 0.f, 0.f, 0.f};
#pragma unroll
          for (int c0 = 0; c0 < 16; c0 += 8) { if (c0 < c) { f32x4 P[8], H[8];
#pragma unroll
              for (int j = 0; j < 8; ++j) { const int cs = (c0 + j < c) ? c0 + j : 0; P[j] = *(const GAS f32x4*)(LC + (size_t)((b * 16 + cs) * 2 + 0) * LW + 4 * tid); H[j] = *(const GAS f32x4*)(LC + (size_t)((b * 16 + cs) * 2 + 1) * LW + 4 * tid); }
#pragma unroll
              for (int j = 0; j < 8; ++j) { if (c0 + j < c) hin = P[j] * hin + H[j]; } } }
          *(LAS f32x4*)(HIN + 4 * tid) = hin; }
        WG_SYNC();
#pragma unroll 1
        for (int rr = 0; rr < 4; ++rr) { const size_t row = (size_t)b * SEQ + c * 256 + sub * 32 + w * 4 + rr;
            float hv[4][8]; float ss = 0.f;
#pragma unroll
            for (int j = 0; j < 4; ++j) { const int ch = (lane + 64 * j) * 8; const v4u hw = *(const GAS v4u*)(HLOC + row * LW + ch), aw = *(const GAS v4u*)(ACUM + row * LW + ch);
                const f32x4 i0 = *(LAS f32x4*)(HIN + ch), i1 = *(LAS f32x4*)(HIN + ch + 4);
                hv[j][0] = bflo(hw.x) + bflo(aw.x) * i0[0]; hv[j][1] = bfhi(hw.x) + bfhi(aw.x) * i0[1]; hv[j][2] = bflo(hw.y) + bflo(aw.y) * i0[2]; hv[j][3] = bfhi(hw.y) + bfhi(aw.y) * i0[3];
                hv[j][4] = bflo(hw.z) + bflo(aw.z) * i1[0]; hv[j][5] = bfhi(hw.z) + bfhi(aw.z) * i1[1]; hv[j][6] = bflo(hw.w) + bflo(aw.w) * i1[2]; hv[j][7] = bfhi(hw.w) + bfhi(aw.w) * i1[3];
#pragma unroll
                for (int e = 0; e < 8; ++e) ss += hv[j][e] * hv[j][e]; }
            const float rs = __builtin_amdgcn_rsqf(wave_sum(ss) * (1.f / LW) + EPS);
#pragma unroll
            for (int j = 0; j < 4; ++j) { const int ch = (lane + 64 * j) * 8; const v4u gw = *(const GAS v4u*)(proj + row * INC + 4 * HW + LW + ch);
                const f32x4 l0 = *(const GAS f32x4*)(ln + ch), l1 = *(const GAS f32x4*)(ln + ch + 4);
                v4u yw; yw.x = pk2(hv[j][0] * rs * l0[0] * gelu_tanh(bflo(gw.x)), hv[j][1] * rs * l0[1] * gelu_tanh(bfhi(gw.x))); yw.y = pk2(hv[j][2] * rs * l0[2] * gelu_tanh(bflo(gw.y)), hv[j][3] * rs * l0[3] * gelu_tanh(bfhi(gw.y)));
                yw.z = pk2(hv[j][4] * rs * l1[0] * gelu_tanh(bflo(gw.z)), hv[j][5] * rs * l1[1] * gelu_tanh(bfhi(gw.z))); yw.w = pk2(hv[j][6] * rs * l1[2] * gelu_tanh(bflo(gw.w)), hv[j][7] * rs * l1[3] * gelu_tanh(bfhi(gw.w)));
                *(GAS v4u*)(Y + row * D + HW + ch) = yw; } }
        WG_SYNC();
    }
}

#ifndef PHASE_MASK
#define PHASE_MASK 0xFFFFFFFF
#endif
#ifndef DUP_MASK
#define DUP_MASK 0
#endif
#define PH(k) if constexpr ((PHASE_MASK >> (k)) & 1) _Pragma("unroll") for (int rep_ = 0; rep_ < 1 + (int)((DUP_MASK >> (k)) & 1); ++rep_)
__global__ void __launch_bounds__(NWAVES * 64, 2) hymba_fwd(Args args) {
    extern __shared__ __attribute__((aligned(16))) unsigned char lds[];
    Frame F;
    F.lds = (LAS unsigned char*)lds;
    F.MISC = (volatile LAS unsigned*)(F.lds + MISC_OFF);
    F.tid = threadIdx.x; F.lane = F.tid & 63; F.wave = __builtin_amdgcn_readfirstlane(F.tid >> 6);
    F.G = gridDim.x; { const int bx = blockIdx.x; F.vcu = (F.G % 8 == 0) ? (bx % 8) * (F.G / 8) + bx / 8 : bx; }
    unsigned char* ws = args.ws;
    F.ctl = (gu32*)(ws + WS_CTL);
    for (int u = F.tid; u < (LDS_BYTES - LDSCTL_OFF) / 4; u += NWAVES * 64) ((LAS unsigned*)(F.lds + LDSCTL_OFF))[u] = 0u;
    __syncthreads();
    XcdBarrier bar = xcd_barrier_post((unsigned*)(F.ctl + CW_BAR), F.MISC + 8);
#define GRID_BAR() do { XcdBarrier b_ = bar; asm volatile("" : "+s"(b_.bar), "+s"(b_.x)); xcd_barrier(b_); } while (0)

    const float* x = args.in[0]; const float* meta = args.in[1];
    bf16* WGU1 = (bf16*)(ws + WS_WGU1); bf16* WD1 = (bf16*)(ws + WS_WD1); bf16* WIN = (bf16*)(ws + WS_WIN); bf16* WOUT = (bf16*)(ws + WS_WOUT);
    bf16* WGU2 = (bf16*)(ws + WS_WGU2); bf16* WD2 = (bf16*)(ws + WS_WD2); bf16* WLRU = (bf16*)(ws + WS_WLRU);
    bf16* U = (bf16*)(ws + WS_U); bf16* HID = (bf16*)(ws + WS_BIG); bf16* PROJ = (bf16*)(ws + WS_BIG);
    bf16* Fb = (bf16*)(ws + WS_F);
    float* HGs = (float*)(ws + WS_HG); float* HGs2 = (float*)(ws + WS_HG2); float* HDs = (float*)(ws + WS_HD); float* LC = (float*)(ws + WS_LC); bf16* HLOC = (bf16*)(ws + WS_HLOC); bf16* ACUM = (bf16*)(ws + WS_ACUM); bf16* Y = (bf16*)(ws + WS_Y); bf16* HB = (bf16*)(ws + WS_HB);
    float* out = args.out;
    const int gw = F.vcu * NWAVES + F.wave, NGW = F.G * NWAVES;

    PH(0) {
        LAS float* scr = (LAS float*)(F.lds + RING_OFF + F.wave * 16896); const int lane0 = opaque_lane();
        if (F.wave < 4) p0_convert_all(args, WGU1, WD1, WIN, WOUT, WGU2, WD2, WLRU, scr, F.vcu * 4 + F.wave, F.G * 4, lane0);
        else for (int m = F.vcu * 4 + F.wave - 4; m < MT; m += F.G * 4) rms_row_to_bf16(m < MR ? x + (size_t)m * D : meta + (size_t)(m - MR) * D, args.in[2], U, m, lane0);
    }
    GRID_BAR();

    PH(1) {
        skinny_phase<2, 3>(F, U, D, WGU1, D, D, FF / 16, MapGateUp{}, SkEpiSwiGLU{HID});
        pg8::Gemm g{U, WGU1, MR, 2 * FF, D, D, D, 0, 0}; pg8::StaticOrder S; S.init(MR, 2 * FF, F.G, (int)blockIdx.x);
        pg8::EpiSwiGLU E{HID, FF};
        pg8::gemm_phase<pg8::EpiSwiGLU, pg8::StaticOrder, true, true>(F.lds + RING_OFF, g, S, E, F.wave);
    }
    GRID_BAR();
    PH(2) {
        skinny_phase<1, 1>(F, HID, 0, WD1, FF, FF, D / 16, MapPlain{}, SkEpiBf16{Fb, D});
        pg8::Gemm g{HID, WD1, MR, D, FF, FF, FF, 0, 1}; pg8::StaticOrder S; S.init(MR, D, F.G, (int)blockIdx.x);
        pg8::EpiBf16 E{Fb, D};
        pg8::gemm_phase<pg8::EpiBf16, pg8::StaticOrder, true, true>(F.lds + RING_OFF, g, S, E, F.wave);
    }
    GRID_BAR();
    PH(3) { norm_rows<0>(Fb, x, meta, nullptr, HB, nullptr, U, args.in[6], args.in[7], 0.5f, MR, gw, NGW);
        for (int m = blockIdx.x; m < NMETA; m += F.G) norm_meta_row(F, m, Fb, meta, U, args.in[6], args.in[7], 0.5f); }
    GRID_BAR();
    PH(4) {
        skinny_phase<1, 3>(F, U, D, WIN, D, D, INC / 16, MapPlain{}, SkEpiBf16{PROJ, INC});
        pg8::Gemm g{U, WIN, MR, INC, D, D, D, 0, 0}; pg8::StaticOrder S; S.init(MR, INC, F.G, (int)blockIdx.x);
        pg8::EpiBf16 E{PROJ, INC};
        pg8::gemm_phase<pg8::EpiBf16, pg8::StaticOrder, true, true>(F.lds + RING_OFF, g, S, E, F.wave);
    }
    GRID_BAR();
    PH(5) {
        for (int u = blockIdx.x; u < 256; u += F.G) lru_unit(F, u, PROJ, WLRU, args.in[11], args.in[12], args.in[14], args.in[16], args.in[17], HLOC, ACUM, LC);
        for (int i = blockIdx.x; i < 512; i += F.G) { const int u = (i & ~255) | ((i + 4 + 4 * (i >> 8)) & 255); hgrn_unit<false>(F, u, PROJ, args.in[9], args.in[10], HGs, HDs, Y); }
    }
    GRID_BAR();
    PH(6) { hgrn_carry(F, HGs, HGs2, HDs); lru_finish(F, HLOC, ACUM, LC, PROJ, args.in[18], Y); }
    GRID_BAR();
    PH(7) { for (int i = blockIdx.x; i < 512; i += F.G) { const int u = (i & ~255) | ((i + 8 * (i >> 8)) & 255); hgrn_unit<true>(F, u, PROJ, args.in[9], args.in[10], HGs2, HDs, Y); } }
    GRID_BAR();
    PH(9) {
        pg8::Gemm g{Y, WOUT, MR, D, D, D, D, 0, 0}; pg8::StaticOrder S; S.init(MR, D, F.G, (int)blockIdx.x);
        pg8::EpiBf16 E{Fb, D};
        pg8::gemm_phase<pg8::EpiBf16, pg8::StaticOrder, true, true>(F.lds + RING_OFF, g, S, E, F.wave);
    }
    GRID_BAR();
    PH(10) norm_rows<1>(Fb, nullptr, nullptr, HB, HB, nullptr, U, args.in[20], args.in[21], 1.0f, MR, gw, NGW);
    GRID_BAR();
    PH(11) {
        pg8::Gemm g{U, WGU2, MR, 2 * FF, D, D, D, 0, 0}; pg8::StaticOrder S; S.init(MR, 2 * FF, F.G, (int)blockIdx.x);
        pg8::EpiSwiGLU E{HID, FF};
        pg8::gemm_phase<pg8::EpiSwiGLU, pg8::StaticOrder, true, true>(F.lds + RING_OFF, g, S, E, F.wave);
    }
    GRID_BAR();
    PH(12) {
        pg8::Gemm g{HID, WD2, MR, D, FF, FF, FF, 0, 1}; pg8::StaticOrder S; S.init(MR, D, F.G, (int)blockIdx.x);
        pg8::EpiBf16 E{Fb, D};
        pg8::gemm_phase<pg8::EpiBf16, pg8::StaticOrder, true, true>(F.lds + RING_OFF, g, S, E, F.wave);
    }
    GRID_BAR();
    PH(13) norm_rows<2>(Fb, nullptr, nullptr, HB, nullptr, out, nullptr, args.in[25], nullptr, 0.5f, MR, gw, NGW);
}

extern "C" void kernel_launch(void* const* d_in, const int* in_sizes, int n_in, void* d_out, int out_size, void* d_ws, size_t ws_size, hipStream_t stream) {
    static int grid = 0;
    if (grid == 0) {
        if (n_in != 26 || out_size != MR * D || ws_size < WS_END) { fprintf(stderr, "kernel_launch: unexpected shapes (n_in %d, out %d, ws %zu, need %zu)\n", n_in, out_size, ws_size, (size_t)WS_END); grid = -1; return; }
        int dev = 0, cus = 0, per_cu = 0;
        if (hipGetDevice(&dev) != hipSuccess || hipDeviceGetAttribute(&cus, hipDeviceAttributeMultiprocessorCount, dev) != hipSuccess) { grid = -1; return; }
        if (hipFuncSetAttribute((const void*)hymba_fwd, hipFuncAttributeMaxDynamicSharedMemorySize, LDS_BYTES) != hipSuccess) { fprintf(stderr, "kernel_launch: hipFuncSetAttribute failed\n"); grid = -1; return; }
        if (hipOccupancyMaxActiveBlocksPerMultiprocessor(&per_cu, (const void*)hymba_fwd, NWAVES * 64, LDS_BYTES) != hipSuccess || per_cu < 1) fprintf(stderr, "kernel_launch: occupancy query says %d\n", per_cu);
        (void)hipGetLastError();
        grid = cus;
    }
    if (grid < 0) return;
    if (hipMemsetAsync((char*)d_ws + WS_CTL, 0, CTL_ZERO_BYTES, stream) != hipSuccess) return;
    Args a{};
    for (int i = 0; i < 26; ++i) a.in[i] = (const float*)d_in[i];
    a.out = (float*)d_out; a.ws = (unsigned char*)d_ws;
    hipLaunchKernelGGL(hymba_fwd, dim3(grid), dim3(NWAVES * 64), LDS_BYTES, stream, a);
}
```
